# Optimizing an MI355X kernel written in HIP

```python
import math
import functools
import jax
import jax.numpy as jnp
from jax import lax
import numpy as np

D_MODEL = 1024
BATCH = 2
SEQ = 8192
DEPTH = 2

GRID_W = 64
CTX_LEN = 256
N_MOD = 9
D_FF = 2816
NORM_EPS = 1e-6
CONV_W = 5

SSD_D_INNER = 1024
SSD_HEAD_DIM = 64
SSD_HEADS = SSD_D_INNER // SSD_HEAD_DIM
SSD_GROUPS = 2
SSD_HPG = SSD_HEADS // SSD_GROUPS
SSD_STATE = 128
SSD_CHUNK = 128
SSD_CONV_DIM = SSD_D_INNER + 2 * SSD_GROUPS * SSD_STATE

GDN_HEADS = 8
GDN_DK = 128
GDN_DV = 128
GDN_CHUNK = 64
GDN_QKV_DIM = GDN_HEADS * (2 * GDN_DK + GDN_DV)

AB_IN_SIZES = (SSD_D_INNER, SSD_CONV_DIM, 2 * SSD_HEADS, GDN_QKV_DIM, GDN_HEADS * GDN_DV, 2 * GDN_HEADS, 2 * GDN_HEADS)
AB_IN_DIM = sum(AB_IN_SIZES)
AB_SPLITS = tuple(int(s) for s in np.cumsum(AB_IN_SIZES)[:-1])
AB_OUT_DIM = SSD_D_INNER + GDN_HEADS * GDN_DV

ATTN_Q_HEADS = 8
ATTN_KV_HEADS = 4
ATTN_GROUP = ATTN_Q_HEADS // ATTN_KV_HEADS
ATTN_HEAD_DIM = 128
ATTN_Q_BLOCK = 128
ATTN_QKV_DIM = (ATTN_Q_HEADS + 2 * ATTN_KV_HEADS) * ATTN_HEAD_DIM
ROPE_THETA = 10000.0
ROPE_AXIS_PAIRS = ATTN_HEAD_DIM // 4

kernel_name = 'hybrid_ssd_deltanet_gqa_dit_trunk'


def rmsnorm(t, g):
    tf = t.astype(jnp.float32)
    tf = tf * lax.rsqrt(jnp.mean(tf * tf, axis=-1, keepdims=True) + NORM_EPS)
    return tf.astype(t.dtype) * g


def l2norm(t):
    tf = t.astype(jnp.float32)
    return (tf * lax.rsqrt(jnp.sum(tf * tf, axis=-1, keepdims=True) + NORM_EPS)).astype(t.dtype)


def adaln_table(cvec, w_mod, b_mod):
    m = jax.nn.silu(cvec) @ w_mod + b_mod
    m = m.reshape(m.shape[:-1] + (N_MOD, D_MODEL))
    return jnp.moveaxis(m, -2, 0)[..., None, :]


def ada_norm(t, g, shift, scale):
    return rmsnorm(t, g) * (1.0 + scale) + shift


def swiglu(h, w_in, w_out):
    gate, up = jnp.split(h @ w_in, 2, axis=-1)
    return (jax.nn.silu(gate) * up) @ w_out


def dwconv_centred(t, w, b=None):
    pad = w.shape[0] // 2
    y = lax.conv_general_dilated(t, w[:, None, :], window_strides=(1,), padding=[(pad, pad)],
                                 dimension_numbers=('NWC', 'WIO', 'NWC'), feature_group_count=t.shape[-1])
    return y if b is None else y + b


def axial_rope(rows, dtype):
    row_id = jnp.repeat(jnp.arange(rows, dtype=jnp.float32), GRID_W)
    col_id = jnp.tile(jnp.arange(GRID_W, dtype=jnp.float32), rows)
    inv_freq = ROPE_THETA ** (-jnp.arange(ROPE_AXIS_PAIRS, dtype=jnp.float32) / ROPE_AXIS_PAIRS)
    ang = jnp.concatenate([row_id[:, None] * inv_freq, col_id[:, None] * inv_freq], axis=-1)
    return jnp.cos(ang).astype(dtype)[None, :, None, :], jnp.sin(ang).astype(dtype)[None, :, None, :]


def apply_rope(t, cos, sin):
    t1, t2 = jnp.split(t, 2, axis=-1)
    return jnp.concatenate([t1 * cos - t2 * sin, t2 * cos + t1 * sin], axis=-1)


def ssd_scan(args, s0, a):
    xs, dt, bm, cm = args
    bsz, n_tok = xs.shape[:2]
    nc = n_tok // SSD_CHUNK

    def chunks(t):
        t = t.astype(jnp.float32).reshape((bsz, nc, SSD_CHUNK) + t.shape[2:])
        return jnp.moveaxis(t, 1, 0)

    tri = jnp.tril(jnp.ones((SSD_CHUNK, SSD_CHUNK), dtype=bool))[None, :, :, None, None]

    def step(s, inp):
        xq, dtq, bq, cq = inp
        acum = jnp.cumsum(dtq * a, axis=1)
        seg = acum[:, :, None] - acum[:, None, :]
        decay = jnp.exp(jnp.where(tri, seg, -jnp.inf))
        cb = jnp.einsum('bign,bjgn->bijg', cq, bq)
        m = cb[..., None] * decay * dtq[:, None]
        y = jnp.einsum('bijgr,bjgrp->bigrp', m, xq)
        y = y + jnp.einsum('bign,bgrpn->bigrp', cq, s) * jnp.exp(acum)[..., None]
        last = acum[:, -1]
        xw = xq * (jnp.exp(last[:, None] - acum) * dtq)[..., None]
        s = s * jnp.exp(last)[..., None, None] + jnp.einsum('bjgn,bjgrp->bgrpn', bq, xw)
        return s, y

    s_fin, ys = lax.scan(step, s0, (chunks(xs), chunks(dt), chunks(bm), chunks(cm)))
    return jnp.moveaxis(ys, 0, 1).reshape(xs.shape), s_fin


def gdn_scan(args, s0):
    q, k, v, g, beta = args
    bsz, n_tok = q.shape[:2]
    nc = n_tok // GDN_CHUNK

    def chunks(t):
        t = t.astype(jnp.float32).reshape((bsz, nc, GDN_CHUNK) + t.shape[2:])
        return jnp.swapaxes(t, 2, 3)

    q, k, v, g, beta = (chunks(t) for t in (q, k, v, g, beta))
    gc = jnp.cumsum(g, axis=-1)
    idx = jnp.arange(GDN_CHUNK)
    incl = idx[:, None] >= idx[None, :]
    decay = jnp.exp(jnp.where(incl, gc[..., :, None] - gc[..., None, :], -jnp.inf))
    kb = k * beta[..., None]
    a_mat = jnp.where(idx[:, None] > idx[None, :], jnp.einsum('bnhid,bnhjd->bnhij', kb, k) * decay, 0.0)
    rhs = jnp.concatenate([v * beta[..., None], kb * jnp.exp(gc)[..., None]], axis=-1)
    sol = lax.linalg.triangular_solve(a_mat + jnp.eye(GDN_CHUNK, dtype=jnp.float32), rhs,
                                      left_side=True, lower=True, unit_diagonal=True)
    u, w = sol[..., :GDN_DV], sol[..., GDN_DV:]
    qk = jnp.einsum('bnhid,bnhjd->bnhij', q, k) * decay
    q_dec = q * jnp.exp(gc)[..., None]
    k_dec = k * jnp.exp(gc[..., -1:] - gc)[..., None]
    g_last = jnp.exp(gc[..., -1])

    def step(s, inp):
        u_c, w_c, qk_c, qd_c, kd_c, gl_c = inp
        v_new = u_c - jnp.einsum('bhid,bhde->bhie', w_c, s)
        o = jnp.einsum('bhid,bhde->bhie', qd_c, s) + jnp.einsum('bhij,bhje->bhie', qk_c, v_new)
        s = s * gl_c[..., None, None] + jnp.einsum('bhjd,bhje->bhde', kd_c, v_new)
        return s, o

    xs = tuple(jnp.moveaxis(t, 1, 0) for t in (u, w, qk, q_dec, k_dec, g_last))
    s_fin, o = lax.scan(step, s0, xs)
    o = jnp.swapaxes(jnp.moveaxis(o, 0, 1), 2, 3).reshape(bsz, n_tok, q.shape[2], GDN_DV)
    return o, s_fin


def prefix_bidirectional(scan_f, scan_b, ctx_dirs, lat_dirs, s0):
    def flip(args):
        return tuple(jnp.flip(t, axis=1) for t in args)
    yc_f, sc_f = scan_f(ctx_dirs[0], s0)
    yx_f, _ = scan_f(lat_dirs[0], sc_f)
    yc_b, sc_b = scan_b(flip(ctx_dirs[1]), s0)
    yx_b, _ = scan_b(flip(lat_dirs[1]), sc_b)
    return yc_f + jnp.flip(yc_b, axis=1), yx_f + jnp.flip(yx_b, axis=1)


def ab_mixer(hc, hx, w_in, ssd_conv_w, ssd_conv_b, ssd_a_log, ssd_dt_bias, ssd_d, ssd_norm,
             gdn_conv_w, gdn_a_log, gdn_dt_bias, gdn_norm, w_out, with_ctx_out):
    def project(h):
        bsz, n_tok = h.shape[:2]
        z, xbc, dt, qkv, gate, beta, alpha = jnp.split(h @ w_in, AB_SPLITS, axis=-1)
        xbc = jax.nn.silu(dwconv_centred(xbc, ssd_conv_w, ssd_conv_b))
        xs, bm, cm = jnp.split(xbc, (SSD_D_INNER, SSD_D_INNER + SSD_GROUPS * SSD_STATE), axis=-1)
        xs = xs.reshape(bsz, n_tok, SSD_GROUPS, SSD_HPG, SSD_HEAD_DIM)
        bm = bm.reshape(bsz, n_tok, SSD_GROUPS, SSD_STATE)
        cm = cm.reshape(bsz, n_tok, SSD_GROUPS, SSD_STATE)
        dt = jax.nn.softplus(dt.reshape(bsz, n_tok, 2, SSD_HEADS) + ssd_dt_bias)
        dt = dt.reshape(bsz, n_tok, 2, SSD_GROUPS, SSD_HPG)
        qkv = jax.nn.silu(dwconv_centred(qkv, gdn_conv_w))
        q, k, v = jnp.split(qkv, (GDN_HEADS * GDN_DK, 2 * GDN_HEADS * GDN_DK), axis=-1)
        q = l2norm(q.reshape(bsz, n_tok, GDN_HEADS, GDN_DK)) * (GDN_DK ** -0.5)
        k = l2norm(k.reshape(bsz, n_tok, GDN_HEADS, GDN_DK))
        v = v.reshape(bsz, n_tok, GDN_HEADS, GDN_DV)
        beta = jax.nn.sigmoid(beta.reshape(bsz, n_tok, 2, GDN_HEADS))
        g = -jnp.exp(gdn_a_log) * jax.nn.softplus(alpha.reshape(bsz, n_tok, 2, GDN_HEADS) + gdn_dt_bias)
        ssd_dirs = ((xs, dt[:, :, 0], bm, cm), (xs, dt[:, :, 1], bm, cm))
        gdn_dirs = ((q, k, v, g[:, :, 0], beta[:, :, 0]), (q, k, v, g[:, :, 1], beta[:, :, 1]))
        return ssd_dirs, gdn_dirs, (xs, z, gate)

    ssd_c, gdn_c, aux_c = project(hc)
    ssd_x, gdn_x, aux_x = project(hx)
    bsz = hx.shape[0]
    a_ssd = -jnp.exp(ssd_a_log.astype(jnp.float32)).reshape(2, SSD_GROUPS, SSD_HPG)
    s0_ssd = jnp.zeros((bsz, SSD_GROUPS, SSD_HPG, SSD_HEAD_DIM, SSD_STATE), jnp.float32)
    ys_c, ys_x = prefix_bidirectional(functools.partial(ssd_scan, a=a_ssd[0]),
                                      functools.partial(ssd_scan, a=a_ssd[1]), ssd_c, ssd_x, s0_ssd)
    s0_gdn = jnp.zeros((bsz, GDN_HEADS, GDN_DK, GDN_DV), jnp.float32)
    yg_c, yg_x = prefix_bidirectional(gdn_scan, gdn_scan, gdn_c, gdn_x, s0_gdn)

    def finish(y_ssd, y_gdn, aux):
        xs, z, gate = aux
        b_, n_tok = z.shape[:2]
        y_ssd = y_ssd.astype(z.dtype) + xs * ssd_d.reshape(SSD_GROUPS, SSD_HPG, 1)
        y_ssd = y_ssd.reshape(b_, n_tok, SSD_D_INNER) * jax.nn.silu(z)
        y_ssd = rmsnorm(y_ssd.reshape(b_, n_tok, SSD_GROUPS, SSD_D_INNER // SSD_GROUPS),
                        ssd_norm.reshape(SSD_GROUPS, SSD_D_INNER // SSD_GROUPS))
        y_gdn = rmsnorm(y_gdn.astype(z.dtype), gdn_norm) * jax.nn.silu(gate.reshape(b_, n_tok, GDN_HEADS, GDN_DV))
        y = jnp.concatenate([y_ssd.reshape(b_, n_tok, SSD_D_INNER),
                             y_gdn.reshape(b_, n_tok, GDN_HEADS * GDN_DV)], axis=-1)
        return y @ w_out

    out_c = finish(ys_c, yg_c, aux_c) if with_ctx_out else None
    return out_c, finish(ys_x, yg_x, aux_x)


def attn_mixer(hc, hx, rope_cos, rope_sin, w_qkv, q_norm, k_norm, w_out, with_ctx_out):
    qw = ATTN_Q_HEADS * ATTN_HEAD_DIM
    kw = ATTN_KV_HEADS * ATTN_HEAD_DIM
    bsz, n_tok = hx.shape[:2]

    def heads(t, n):
        return t.reshape(t.shape[:2] + (n, ATTN_HEAD_DIM))

    qx, kx, vx = jnp.split(hx @ w_qkv, (qw, qw + kw), axis=-1)
    qx = apply_rope(rmsnorm(heads(qx, ATTN_Q_HEADS), q_norm), rope_cos, rope_sin)
    kx = apply_rope(rmsnorm(heads(kx, ATTN_KV_HEADS), k_norm), rope_cos, rope_sin)
    vx = heads(vx, ATTN_KV_HEADS)
    kc, vc = jnp.split(hc @ w_qkv[:, qw:], (kw,), axis=-1)
    kc = rmsnorm(heads(kc, ATTN_KV_HEADS), k_norm)
    vc = heads(vc, ATTN_KV_HEADS)
    k_all = jnp.concatenate([kc, kx], axis=1)
    v_all = jnp.concatenate([vc, vx], axis=1)
    scale = ATTN_HEAD_DIM ** -0.5

    def attend(q, keys, vals):
        s = jnp.einsum('bqkgd,bskd->bkgqs', q, keys, preferred_element_type=jnp.float32) * scale
        p = jax.nn.softmax(s, axis=-1).astype(vals.dtype)
        return jnp.einsum('bkgqs,bskd->bqkgd', p, vals)

    nb = n_tok // ATTN_Q_BLOCK
    qb = jnp.moveaxis(qx.reshape(bsz, nb, ATTN_Q_BLOCK, ATTN_KV_HEADS, ATTN_GROUP, ATTN_HEAD_DIM), 1, 0)
    ox = lax.map(lambda qblk: attend(qblk, k_all, v_all), qb)
    ox = jnp.moveaxis(ox, 0, 1).reshape(bsz, n_tok, qw) @ w_out
    oc = None
    if with_ctx_out:
        n_ctx = hc.shape[1]
        qc = rmsnorm(heads(hc @ w_qkv[:, :qw], ATTN_Q_HEADS), q_norm)
        qc = qc.reshape(bsz, n_ctx, ATTN_KV_HEADS, ATTN_GROUP, ATTN_HEAD_DIM)
        oc = attend(qc, kc, vc).reshape(bsz, n_ctx, qw) @ w_out
    return oc, ox


def setup_inputs(seed: int = 0) -> dict:
    key = jax.random.key(seed)
    keys = iter(jax.random.split(key, 40))
    f32 = jnp.float32
    n_ab = (DEPTH + 1) // 2
    n_attn = DEPTH // 2

    def dense(shape, fan_in, gain=1.0):
        return gain * fan_in ** -0.5 * jax.random.normal(next(keys), shape, f32)

    def near_one(shape, scale=0.02):
        return 1.0 + scale * jax.random.normal(next(keys), shape, f32)

    def small(shape, scale=0.02):
        return scale * jax.random.normal(next(keys), shape, f32)

    def dt_bias(shape):
        dt = jnp.exp(jax.random.uniform(next(keys), shape, f32, minval=math.log(1e-3), maxval=math.log(1e-1)))
        return dt + jnp.log(-jnp.expm1(-dt))

    def a_log(shape):
        return jnp.log(jax.random.uniform(next(keys), shape, f32, minval=1.0, maxval=16.0))

    return {
        'x': jax.random.normal(next(keys), (BATCH, SEQ, D_MODEL), f32),
        'c': jax.random.normal(next(keys), (BATCH, D_MODEL), f32),
        'ctx': jax.random.normal(next(keys), (BATCH, CTX_LEN, D_MODEL), f32),
        'c_ctx': jax.random.normal(next(keys), (D_MODEL,), f32),
        'w_mod': dense((DEPTH, D_MODEL, N_MOD * D_MODEL), D_MODEL, 0.5),
        'b_mod': small((DEPTH, N_MOD * D_MODEL)),
        'norm_g': near_one((DEPTH, 3, D_MODEL)),
        'w_ff_in': dense((DEPTH, 2, D_MODEL, 2 * D_FF), D_MODEL),
        'w_ff_out': dense((DEPTH, 2, D_FF, D_MODEL), D_FF),
        'ab_w_in': dense((n_ab, D_MODEL, AB_IN_DIM), D_MODEL),
        'ssd_conv_w': dense((n_ab, CONV_W, SSD_CONV_DIM), CONV_W),
        'ssd_conv_b': small((n_ab, SSD_CONV_DIM)),
        'ssd_a_log': a_log((n_ab, 2, SSD_HEADS)),
        'ssd_dt_bias': dt_bias((n_ab, 2, SSD_HEADS)),
        'ssd_d': near_one((n_ab, SSD_HEADS), 0.1),
        'ssd_norm': near_one((n_ab, SSD_D_INNER)),
        'gdn_conv_w': dense((n_ab, CONV_W, GDN_QKV_DIM), CONV_W),
        'gdn_a_log': a_log((n_ab, 2, GDN_HEADS)),
        'gdn_dt_bias': dt_bias((n_ab, 2, GDN_HEADS)),
        'gdn_norm': near_one((n_ab, GDN_DV)),
        'ab_w_out': dense((n_ab, AB_OUT_DIM, D_MODEL), AB_OUT_DIM),
        'attn_w_qkv': dense((n_attn, D_MODEL, ATTN_QKV_DIM), D_MODEL),
        'attn_q_norm': near_one((n_attn, ATTN_HEAD_DIM)),
        'attn_k_norm': near_one((n_attn, ATTN_HEAD_DIM)),
        'attn_w_out': dense((n_attn, ATTN_Q_HEADS * ATTN_HEAD_DIM, D_MODEL), ATTN_Q_HEADS * ATTN_HEAD_DIM),
    }


def reference(x, c, ctx, c_ctx, w_mod, b_mod, norm_g, w_ff_in, w_ff_out, ab_w_in, ssd_conv_w, ssd_conv_b,
              ssd_a_log, ssd_dt_bias, ssd_d, ssd_norm, gdn_conv_w, gdn_a_log, gdn_dt_bias, gdn_norm, ab_w_out,
              attn_w_qkv, attn_q_norm, attn_k_norm, attn_w_out):
    ROWS = x.shape[1] // GRID_W
    rope_cos, rope_sin = axial_rope(ROWS, x.dtype)
    xc = ctx
    for i in range(DEPTH):
        last = i == DEPTH - 1
        j = i // 2
        mx = adaln_table(c, w_mod[i], b_mod[i])
        mc = adaln_table(c_ctx, w_mod[i], b_mod[i])
        x = x + 0.5 * mx[2] * swiglu(ada_norm(x, norm_g[i, 0], mx[0], mx[1]), w_ff_in[i, 0], w_ff_out[i, 0])
        xc = xc + 0.5 * mc[2] * swiglu(ada_norm(xc, norm_g[i, 0], mc[0], mc[1]), w_ff_in[i, 0], w_ff_out[i, 0])
        hx = ada_norm(x, norm_g[i, 1], mx[3], mx[4])
        hc = ada_norm(xc, norm_g[i, 1], mc[3], mc[4])
        if i % 2 == 0:
            yc, yx = ab_mixer(hc, hx, ab_w_in[j], ssd_conv_w[j], ssd_conv_b[j], ssd_a_log[j], ssd_dt_bias[j],
                              ssd_d[j], ssd_norm[j], gdn_conv_w[j], gdn_a_log[j], gdn_dt_bias[j], gdn_norm[j],
                              ab_w_out[j], not last)
        else:
            yc, yx = attn_mixer(hc, hx, rope_cos, rope_sin, attn_w_qkv[j], attn_q_norm[j], attn_k_norm[j],
                                attn_w_out[j], not last)
        x = x + mx[5] * yx
        x = x + 0.5 * mx[8] * swiglu(ada_norm(x, norm_g[i, 2], mx[6], mx[7]), w_ff_in[i, 1], w_ff_out[i, 1])
        if not last:
            xc = xc + mc[5] * yc
            xc = xc + 0.5 * mc[8] * swiglu(ada_norm(xc, norm_g[i, 2], mc[6], mc[7]), w_ff_in[i, 1], w_ff_out[i, 1])
    return x
```

```cpp
#include <hip/hip_runtime.h>
#include <cstdio>
#include <cstdint>

#define LAS __attribute__((address_space(3)))
typedef unsigned short bf16_t;
typedef short bf16x8 __attribute__((ext_vector_type(8)));
typedef short s16x4 __attribute__((ext_vector_type(4)));
typedef float f32x4 __attribute__((ext_vector_type(4)));
typedef float f32x8 __attribute__((ext_vector_type(8)));
typedef float f32x16 __attribute__((ext_vector_type(16)));
typedef unsigned u32x4 __attribute__((ext_vector_type(4)));

constexpr int DM = 1024, NBATCH = 2, SEQ = 8192, CTXL = 256, TB = SEQ + CTXL  , TT = NBATCH * TB, DFF = 2816;
constexpr int NTHREADS = 512;
constexpr float NEPS = 1e-6f;

constexpr size_t AL(size_t x) { return (x + 255) / 256 * 256; }
constexpr size_t WS_CTL = 0;
constexpr size_t CTL_BYTES = 65536;
constexpr size_t WS_MT = WS_CTL + CTL_BYTES;
constexpr size_t WS_XC = WS_MT + AL((size_t)2 * 3 * 9216 * 4);
constexpr size_t WS_HN = WS_XC + AL((size_t)2 * CTXL * DM * 4);
constexpr size_t WS_AR = WS_HN + AL((size_t)TT * DM * 2);
constexpr size_t AR_HID = WS_AR;
constexpr size_t AR_ABP = WS_AR;
constexpr size_t AR_ABS = AR_ABP + AL((size_t)TB * 6656 * 2);
constexpr size_t AR_CV  = AR_ABS + AL((size_t)TB * 64 * 4);
constexpr size_t AR_YACC = AR_CV + AL((size_t)TB * 4608 * 2);
constexpr size_t AR_Y   = AR_YACC + AL((size_t)TB * 2048 * 4);
constexpr size_t AR_END0 = AR_Y + AL((size_t)TB * 2048 * 2);
constexpr size_t AR_QKV = WS_AR;
constexpr size_t AR_AO  = AR_QKV + AL((size_t)TT * 2048 * 2);
constexpr size_t AR_END1 = AR_AO + AL((size_t)TT * DM * 2);
constexpr size_t WS_END = AR_END0 > AR_END1 ? AR_END0 : AR_END1;

__device__ __forceinline__ bf16_t f2bf(float f) { unsigned u = __float_as_uint(f); u += 0x7fffu + ((u >> 16) & 1u); return (bf16_t)(u >> 16); }
__device__ __forceinline__ float bf2f(bf16_t b) { return __uint_as_float(((unsigned)b) << 16); }
__device__ __forceinline__ float bflo(unsigned w) { return __uint_as_float(w << 16); }
__device__ __forceinline__ float bfhi(unsigned w) { return __uint_as_float(w & 0xffff0000u); }
__device__ __forceinline__ float silu_f(float x) { return x / (1.f + __expf(-x)); }
__device__ __forceinline__ float softplus_f(float x) { return fmaxf(x, 0.f) + log1pf(__expf(-fabsf(x))); }
__device__ __forceinline__ float sigmoid_f(float x) { return 1.f / (1.f + __expf(-x)); }
__device__ __forceinline__ float wave_sum(float v) {
#pragma unroll
    for (int o = 1; o < 64; o <<= 1) v += __shfl_xor(v, o);
    return v;
}

#define XB_TMO      128
#define XB_XCNT(j)  (256  + 64 * (j))
#define XB_XSUB(j)  (1280 + 64 * (j))
#define XB_XGEN(j)  (2304 + 64 * (j))
#define XB_TOP      3328
#define XB_TOPGEN   3392
#define XCD_BAR_WORDS 3456
#define XB_SPIN_CAP (1u << 24)
__device__ __forceinline__ unsigned xb_ld(unsigned* p)              { return __hip_atomic_load(p, __ATOMIC_RELAXED, __HIP_MEMORY_SCOPE_AGENT); }
__device__ __forceinline__ unsigned xb_add(unsigned* p, unsigned v) { return __hip_atomic_fetch_add(p, v, __ATOMIC_RELAXED, __HIP_MEMORY_SCOPE_AGENT); }
__device__ __forceinline__ unsigned xb_xcc_id() { return (unsigned)__builtin_amdgcn_s_getreg((3 << 11) | 20) & 0xFu; }
#define XB_SPIN(cond, bar) do { unsigned _sp = 0; while (cond) { __builtin_amdgcn_s_sleep(1); \
    if ((++_sp & 255u) == 0u) { if (xb_ld(&(bar)[XB_TMO])) break; if (_sp > XB_SPIN_CAP) { atomicAdd(&(bar)[XB_TMO], 1u); break; } } } } while (0)
struct XcdBarrier { unsigned* bar; unsigned x; volatile LAS unsigned* st; };
__device__ __forceinline__ XcdBarrier xcd_barrier_post(unsigned* bar, volatile LAS unsigned* st) {
    XcdBarrier b; b.bar = bar; b.x = xb_xcc_id(); b.st = st;
    if (threadIdx.x == 0) (void)xb_add(&bar[XB_XCNT(b.x)], 1u);
    return b;
}
__device__ __forceinline__ void xcd_barrier_complete(unsigned* bar, unsigned x, unsigned& nloc, unsigned& nx) {
    const unsigned G = gridDim.x * gridDim.y * gridDim.z;
    unsigned sum, cnt, mine, sp = 0u;
    for (;;) {
        sum = 0u; cnt = 0u; mine = 0u;
#pragma unroll
        for (unsigned j = 0; j < 16; ++j) { const unsigned c = xb_ld(&bar[XB_XCNT(j)]); sum += c; cnt += (c > 0u) ? 1u : 0u; mine = (j == x) ? c : mine; }
        if (sum == G) break;
        __builtin_amdgcn_s_sleep(1);
        if ((++sp & 255u) == 0u) { if (xb_ld(&bar[XB_TMO])) break; if (sp > XB_SPIN_CAP) { atomicAdd(&bar[XB_TMO], 1u); break; } }
    }
    nloc = mine > 0u ? mine : 1u; nx = cnt > 0u ? cnt : 1u;
}
__device__ __forceinline__ void xcd_barrier(const XcdBarrier& b) {
    asm volatile("s_waitcnt vmcnt(0)" ::: "memory");
    __syncthreads();
    if (threadIdx.x == 0) {
        unsigned* bar = b.bar;
        __builtin_amdgcn_s_waitcnt(0);
        unsigned nloc = b.st[0], nx = b.st[1];
        if (nloc == 0u) { xcd_barrier_complete(bar, b.x, nloc, nx); b.st[0] = nloc; b.st[1] = nx; }
        const unsigned old = xb_add(&bar[XB_XSUB(b.x)], 1u);
        const unsigned gen = old / nloc;
        if (old + 1u == (gen + 1u) * nloc) {
            __builtin_amdgcn_fence(__ATOMIC_RELEASE, "agent");
            asm volatile("s_waitcnt vmcnt(0)" ::: "memory");
            const unsigned og = xb_add(&bar[XB_TOP], 1u);
            const unsigned tg = og / nx;
            if (og + 1u == (tg + 1u) * nx) xb_add(&bar[XB_TOPGEN], 1u);
            else XB_SPIN(xb_ld(&bar[XB_TOPGEN]) == tg, bar);
            __builtin_amdgcn_fence(__ATOMIC_ACQUIRE, "agent");
            xb_add(&bar[XB_XGEN(b.x)], 1u);
            asm volatile("s_waitcnt vmcnt(0)" ::: "memory");
        } else {
            XB_SPIN(xb_ld(&bar[XB_XGEN(b.x)]) == gen, bar);
            __builtin_amdgcn_fence(__ATOMIC_ACQUIRE, "agent");
            asm volatile("s_waitcnt vmcnt(0)" ::: "memory");
        }
    }
    __syncthreads();
}

struct Args { const float* in[25]; float* out; unsigned char* ws; int ph_lo, ph_hi; };
enum { I_X = 0, I_C, I_CTX, I_CCTX, I_WMOD, I_BMOD, I_NORMG, I_WFFIN, I_WFFOUT, I_ABWIN, I_SCONVW, I_SCONVB, I_SALOG, I_SDTB, I_SD, I_SNORM,
       I_GCONVW, I_GALOG, I_GDTB, I_GNORM, I_ABWOUT, I_WQKV, I_QNORM, I_KNORM, I_WO };

struct Frame {
    const float* const* in; float* out; unsigned char* ws; long dxc, dcin;
    LAS unsigned char* lds; unsigned char* ldsg;
    int tid, lane, wave, G, bid;
};
#define F_MT   ((float*)(F.ws + WS_MT))
#define F_XC   ((float*)(F.ws + WS_XC))
#define F_HN   ((bf16_t*)(F.ws + WS_HN))
#define F_HID  ((bf16_t*)(F.ws + AR_HID))
#define F_ABP  ((bf16_t*)(F.ws + AR_ABP))
#define F_ABS  ((float*)(F.ws + AR_ABS))
#define F_CV   ((bf16_t*)(F.ws + AR_CV))
#define F_YACC ((float*)(F.ws + AR_YACC))
#define F_Y    ((bf16_t*)(F.ws + AR_Y))
#define F_QKV  ((bf16_t*)(F.ws + AR_QKV))
#define F_AO   ((bf16_t*)(F.ws + AR_AO))
__device__ __forceinline__ long xoff(int r, long dctx, bool& isctx) { const int b = r / TB, u = r - b * TB; isctx = u < CTXL; return isctx ? dctx + (long)(b * CTXL + u) * DM : (long)(b * SEQ + u - CTXL) * DM; }

template <bool DUAL, class Epi>
__device__ __forceinline__ void sgemm(Frame& F, const bf16_t* A, int lda, const float* W, int ldw, int dual_off, int row0, int nrows, int N, int K, bool skip_ctx, const Epi& epi) {
    LAS bf16_t* sA = (LAS bf16_t*)F.lds; LAS bf16_t* sB = sA + 128 * 40; LAS bf16_t* sB2 = sB + 64 * 40;
    const int tid = F.tid, lane = F.lane, wid = F.wave;
    const int ntn = N / 64, ntiles = (nrows / 128) * ntn;
    for (int t = F.bid; t < ntiles; t += F.G) {
        const int tm = t / ntn, tn = t - tm * ntn, m0 = row0 + tm * 128, n0 = tn * 64;
        if (skip_ctx && (m0 % TB) < CTXL) continue;
        f32x4 acc[4], acc2[4];
#pragma unroll
        for (int j = 0; j < 4; ++j) { acc[j] = (f32x4){0.f, 0.f, 0.f, 0.f}; acc2[j] = (f32x4){0.f, 0.f, 0.f, 0.f}; }
        for (int k0 = 0; k0 < K; k0 += 32) {
            { const int r = tid >> 2, kq = (tid & 3) * 8; const u32x4 v = *(const u32x4*)(A + (size_t)(m0 + r) * lda + k0 + kq); *(LAS u32x4*)(sA + r * 40 + kq) = v; }
            { const int k = tid >> 4, n4 = (tid & 15) * 4; const f32x4 w = *(const f32x4*)(W + (size_t)(k0 + k) * ldw + n0 + n4);
              sB[(n4 + 0) * 40 + k] = f2bf(w[0]); sB[(n4 + 1) * 40 + k] = f2bf(w[1]); sB[(n4 + 2) * 40 + k] = f2bf(w[2]); sB[(n4 + 3) * 40 + k] = f2bf(w[3]);
              if (DUAL) { const f32x4 w2 = *(const f32x4*)(W + (size_t)(k0 + k) * ldw + n0 + n4 + dual_off);
                  sB2[(n4 + 0) * 40 + k] = f2bf(w2[0]); sB2[(n4 + 1) * 40 + k] = f2bf(w2[1]); sB2[(n4 + 2) * 40 + k] = f2bf(w2[2]); sB2[(n4 + 3) * 40 + k] = f2bf(w2[3]); } }
            __syncthreads();
            const bf16x8 a = *(const LAS bf16x8*)(sA + (16 * wid + (lane & 15)) * 40 + 8 * (lane >> 4));
#pragma unroll
            for (int j = 0; j < 4; ++j) { const bf16x8 b = *(const LAS bf16x8*)(sB + (16 * j + (lane & 15)) * 40 + 8 * (lane >> 4));
                acc[j] = __builtin_amdgcn_mfma_f32_16x16x32_bf16(a, b, acc[j], 0, 0, 0);
                if (DUAL) { const bf16x8 b2 = *(const LAS bf16x8*)(sB2 + (16 * j + (lane & 15)) * 40 + 8 * (lane >> 4)); acc2[j] = __builtin_amdgcn_mfma_f32_16x16x32_bf16(a, b2, acc2[j], 0, 0, 0); } }
            __syncthreads();
        }
#pragma unroll
        for (int j = 0; j < 4; ++j)
#pragma unroll
            for (int r = 0; r < 4; ++r) epi(m0 + 16 * wid + 4 * (lane >> 4) + r, n0 + 16 * j + (lane & 15), acc[j][r], acc2[j][r]);
    }
}
struct EpiSwiglu { bf16_t* hid; __device__ __forceinline__ void operator()(int r, int c, float g, float u) const { hid[(size_t)r * DFF + c] = f2bf(silu_f(g) * u); } };
struct EpiResid {
    const float* base; long dbase; float* out; long dxc; const float* mt; int gidx; float coef;
    __device__ __forceinline__ void operator()(int r, int c, float v, float) const {
        bool isctx; const long ob = xoff(r, dbase, isctx) + c; const long oo = xoff(r, dxc, isctx) + c; const int s = isctx ? 2 : r / TB;
        out[oo] = base[ob] + coef * mt[(s * 9 + gidx) * DM + c] * v;
    }
};
struct EpiAB {
    bf16_t* abp; float* abs_; int row0;
    __device__ __forceinline__ void operator()(int r, int c, float v, float) const {
        const int u = r - row0;
        if (c < 2560) abp[(size_t)u * 6656 + c] = f2bf(v);
        else if (c < 2592) abs_[u * 64 + (c - 2560)] = v;
        else if (c < 6688) abp[(size_t)u * 6656 + (c - 32)] = f2bf(v);
        else abs_[u * 64 + 32 + (c - 6688)] = v;
    }
};
struct EpiBf16Store { bf16_t* o; int ldo; __device__ __forceinline__ void operator()(int r, int c, float v, float) const { o[(size_t)r * ldo + c] = f2bf(v); } };

namespace att {
constexpr int D = 128, NW = 8, QBLK = 32, KVBLK = 64;
constexpr float SCALE = 0.088388347648318440f;
constexpr float THR = 8.f;
constexpr int SDEPTH = 1;
constexpr int LDQ = 2048, LDK = 2048, LDO = 1024;
constexpr size_t SHM_V = KVBLK * D * 2, SHM_K = KVBLK * D * 2, SHM_ATTN = 2 * SHM_V + 2 * SHM_K + NW * 64 * 4;
#define KSWZ(row, colB) ((row) * 256 + ((colB) ^ (((row) & 7) << 4)))
#define SBAR() __builtin_amdgcn_sched_barrier(0)
__device__ __forceinline__ int crow(int r, int hi) { return (r & 3) + 8 * (r >> 2) + 4 * hi; }
__device__ __forceinline__ unsigned cvtpk(float lo, float hi) { unsigned r; asm volatile("v_cvt_pk_bf16_f32 %0, %1, %2" : "=v"(r) : "v"(lo), "v"(hi)); return r; }
__device__ __forceinline__ bf16x8 ld8(const bf16_t* p) { return *reinterpret_cast<const bf16x8*>(p); }
__device__ __forceinline__ void partialSM(f32x16& p0, f32x16& p1, float& m_reg, float& mn, float& alpha) {
  constexpr float C = SCALE * 1.4426950408889634f;
  float pmax = p0[0]; for (int r = 1; r < 16; ++r) pmax = fmaxf(pmax, p0[r]); for (int r = 0; r < 16; ++r) pmax = fmaxf(pmax, p1[r]);
  { auto rr = __builtin_amdgcn_permlane32_swap(__float_as_uint(pmax), __float_as_uint(pmax), false, false);
    pmax = fmaxf(__uint_as_float(rr[0]), __uint_as_float(rr[1])); }
  if (__builtin_expect(__all(pmax - m_reg <= THR / SCALE), 1)) { mn = m_reg; alpha = 1.f; }
  else { mn = fmaxf(m_reg, pmax); alpha = __builtin_amdgcn_exp2f((m_reg - mn) * C); m_reg = mn; }
  float mnC = -mn * C;
  for (int r = 0; r < 16; ++r) p0[r] = fmaf(p0[r], C, mnC); for (int r = 0; r < 16; ++r) p1[r] = fmaf(p1[r], C, mnC);
  for (int r = 0; r < 16; ++r) p0[r] = __builtin_amdgcn_exp2f(p0[r]);
}
__device__ __forceinline__ void finishSM(f32x16& p0, f32x16& p1, float alpha, float& l_reg, bf16x8& pa0, bf16x8& pa1, bf16x8& pa2, bf16x8& pa3) {
  for (int r = 0; r < 16; ++r) p1[r] = __builtin_amdgcn_exp2f(p1[r]);
  float ps = 0; for (int r = 0; r < 16; ++r) ps += p0[r]; for (int r = 0; r < 16; ++r) ps += p1[r];
  { auto rr = __builtin_amdgcn_permlane32_swap(__float_as_uint(ps), __float_as_uint(ps), false, false);
    ps = __uint_as_float(rr[0]) + __uint_as_float(rr[1]); }
  l_reg = l_reg * alpha + ps;
#define PK4(P, BASE, OUT) do { unsigned a0 = cvtpk(P[BASE + 0], P[BASE + 1]), a1 = cvtpk(P[BASE + 2], P[BASE + 3]);   \
    unsigned b0 = cvtpk(P[BASE + 4], P[BASE + 5]), b1 = cvtpk(P[BASE + 6], P[BASE + 7]);                              \
    auto r0 = __builtin_amdgcn_permlane32_swap(a0, b0, false, false); auto r1 = __builtin_amdgcn_permlane32_swap(a1, b1, false, false); \
    u32x4 w = {r0[0], r1[0], r0[1], r1[1]}; OUT = *reinterpret_cast<bf16x8*>(&w); } while (0)
  PK4(p0, 0, pa0); PK4(p0, 8, pa1); PK4(p1, 0, pa2); PK4(p1, 8, pa3);
#undef PK4
}
__device__ __forceinline__ void qkt(f32x16& p0, f32x16& p1, const bf16_t* Ks, const bf16x8* qr, int r32, int hi) {
  p0 = f32x16{}; p1 = f32x16{};
  for (int d0 = 0; d0 < 8; ++d0) { int cb = (d0 * 16 + hi * 8) * 2;
    bf16x8 b0 = *reinterpret_cast<const bf16x8*>((const char*)Ks + KSWZ(r32, cb));
    bf16x8 b1 = *reinterpret_cast<const bf16x8*>((const char*)Ks + KSWZ(32 + r32, cb));
    p0 = __builtin_amdgcn_mfma_f32_32x32x16_bf16(b0, qr[d0], p0, 0, 0, 0);
    p1 = __builtin_amdgcn_mfma_f32_32x32x16_bf16(b1, qr[d0], p1, 0, 0, 0); }
}
__device__ __forceinline__ int v_st(int k, int c) { const int kk = (k & ~0xC) | ((k & 4) << 1) | ((k & 8) >> 1); return ((kk >> 3) * 4 + (c >> 5)) * 512 + ((kk & 7) * 32 + (c & 31)) * 2; }
__device__ __forceinline__ int v_rd_base(int lane) { return ((lane & 3) << 3) | (((lane >> 2) & 3) << 6) | (((lane >> 4) & 1) << 5) | (((lane >> 5) & 1) << 8); }
constexpr int v_rd_off(int d0, int ks, int half) { return d0 * 512 + ks * 4096 + half * 2048; }
template <int OFF> __device__ __forceinline__ s16x4 tr_read(int vb) {
  s16x4 r; asm volatile("ds_read_b64_tr_b16 %0, %1 offset:%2" : "=&v"(r) : "v"(vb), "i"(OFF) : "memory"); return r;
}
template <int D0> __device__ __forceinline__ void pv_one(f32x16& od, int vb, bf16x8 pa0, bf16x8 pa1, bf16x8 pa2, bf16x8 pa3) {
  const s16x4 l0 = tr_read<v_rd_off(D0, 0, 0)>(vb), h0 = tr_read<v_rd_off(D0, 0, 1)>(vb), l1 = tr_read<v_rd_off(D0, 1, 0)>(vb), h1 = tr_read<v_rd_off(D0, 1, 1)>(vb);
  const s16x4 l2 = tr_read<v_rd_off(D0, 2, 0)>(vb), h2 = tr_read<v_rd_off(D0, 2, 1)>(vb), l3 = tr_read<v_rd_off(D0, 3, 0)>(vb), h3 = tr_read<v_rd_off(D0, 3, 1)>(vb);
  asm volatile("s_waitcnt lgkmcnt(0)" ::: "memory"); SBAR();
#define PK(L, H) (bf16x8){L[0], L[1], L[2], L[3], H[0], H[1], H[2], H[3]}
  od = __builtin_amdgcn_mfma_f32_32x32x16_bf16(pa0, PK(l0, h0), od, 0, 0, 0);
  od = __builtin_amdgcn_mfma_f32_32x32x16_bf16(pa1, PK(l1, h1), od, 0, 0, 0);
  od = __builtin_amdgcn_mfma_f32_32x32x16_bf16(pa2, PK(l2, h2), od, 0, 0, 0);
  od = __builtin_amdgcn_mfma_f32_32x32x16_bf16(pa3, PK(l3, h3), od, 0, 0, 0);
#undef PK
}
__device__ __forceinline__ void pv_d0(f32x16* o, int vb, bf16x8 pa0, bf16x8 pa1, bf16x8 pa2, bf16x8 pa3) {
  pv_one<0>(o[0], vb, pa0, pa1, pa2, pa3); pv_one<1>(o[1], vb, pa0, pa1, pa2, pa3); pv_one<2>(o[2], vb, pa0, pa1, pa2, pa3); pv_one<3>(o[3], vb, pa0, pa1, pa2, pa3);
}
__device__ __forceinline__ void attn_dense_body(const bf16_t* __restrict__ Qb, const bf16_t* __restrict__ Kh, const bf16_t* __restrict__ Vh,
                                                bf16_t* __restrict__ Ob, int seq, char* lds, int tid) {
  const int wid = tid >> 6, lane = tid & 63, r32 = lane & 31, hi = lane >> 5;
  bf16_t* V_lds = (bf16_t*)lds; bf16_t* K_lds = (bf16_t*)(lds + 2 * SHM_V);
  float* ws = (float*)(lds + 2 * SHM_V + 2 * SHM_K) + wid * 64; float* li_l = ws; float* al_l = ws + 32;
  float m_reg = -1e30f, l_reg = 0; f32x16 o[4] = {}; bf16x8 qr[8];
  const bf16_t* Qw = Qb + (long)(wid * QBLK + r32) * LDQ + hi * 8;
#pragma unroll
  for (int d0 = 0; d0 < 8; ++d0) qr[d0] = ld8(Qw + d0 * 16);
  const int sr = tid >> 4, sc = (tid & 15) * 8, vst0 = v_st(sr, sc), vst1 = v_st(32 + sr, sc);
  const int vb0 = (int)(uintptr_t)V_lds + v_rd_base(lane);
  struct { bf16x8 vs0, vs1, ks0, ks1; } sr_[SDEPTH];
#define SLOAD(i, k0) do { sr_[i].vs0 = ld8(&Vh[(long)((k0) + sr) * LDK + sc]); sr_[i].vs1 = ld8(&Vh[(long)((k0) + 32 + sr) * LDK + sc]); \
    sr_[i].ks0 = ld8(&Kh[(long)((k0) + sr) * LDK + sc]); sr_[i].ks1 = ld8(&Kh[(long)((k0) + 32 + sr) * LDK + sc]); } while (0)
#define SWRITE(b, i) do { *(bf16x8*)((char*)V_lds + (b) * SHM_V + vst0) = sr_[i].vs0;          \
    *(bf16x8*)((char*)V_lds + (b) * SHM_V + vst1) = sr_[i].vs1; int kc = sc * 2;               \
    *(bf16x8*)((char*)K_lds + (b) * SHM_K + KSWZ(sr, kc)) = sr_[i].ks0;                       \
    *(bf16x8*)((char*)K_lds + (b) * SHM_K + KSWZ(32 + sr, kc)) = sr_[i].ks1; } while (0)
#define SWAIT() do { if constexpr (SDEPTH == 2) asm volatile("s_waitcnt vmcnt(4)" ::: "memory"); else asm volatile("s_waitcnt vmcnt(0)" ::: "memory"); } while (0)
#define RESC(a) do { if (__any((a) < 1.f)) { if (hi == 0) al_l[r32] = (a); asm volatile("s_waitcnt lgkmcnt(0)" ::: "memory"); \
    for (int d = 0; d < 4; ++d) for (int r = 0; r < 16; ++r) o[d][r] *= al_l[crow(r, hi)]; } } while (0)
  f32x16 pA0, pA1, pB0, pB1; float mnA, mnB, alA, alB; bf16x8 pa0, pa1, pa2, pa3; const int NT = seq / KVBLK;
  constexpr int SE = 0, SO = SDEPTH - 1;
  SLOAD(SE, 0); asm volatile("s_waitcnt vmcnt(0)" ::: "memory"); SWRITE(0, SE); __syncthreads();
  qkt(pA0, pA1, K_lds, qr, r32, hi); partialSM(pA0, pA1, m_reg, mnA, alA);
  SLOAD(SO, KVBLK); if constexpr (SDEPTH == 2) { if (2 < NT) SLOAD(SE, 2 * KVBLK); }
  SWAIT(); SWRITE(1, SO); __syncthreads();
  for (int j = 1; j + 1 < NT; j += 2) {
    SBAR(); qkt(pB0, pB1, (bf16_t*)((char*)K_lds + SHM_K), qr, r32, hi);
    finishSM(pA0, pA1, alA, l_reg, pa0, pa1, pa2, pa3); SBAR();
    SLOAD(SO, (j + SDEPTH) * KVBLK); SBAR();
    pv_d0(o, vb0, pa0, pa1, pa2, pa3); partialSM(pB0, pB1, m_reg, mnB, alB);
    __syncthreads(); SWAIT(); SWRITE(0, SE);
    RESC(alB); __syncthreads();
    SBAR(); qkt(pA0, pA1, K_lds, qr, r32, hi);
    finishSM(pB0, pB1, alB, l_reg, pa0, pa1, pa2, pa3); SBAR();
    if (SDEPTH == 1 || j + 3 < NT) SLOAD(SE, (j + 1 + SDEPTH) * KVBLK); SBAR();
    pv_d0(o, vb0 + (int)SHM_V, pa0, pa1, pa2, pa3); partialSM(pA0, pA1, m_reg, mnA, alA);
    __syncthreads(); SWAIT(); SWRITE(1, SO);
    RESC(alA); __syncthreads();
  }
  SBAR(); qkt(pB0, pB1, (bf16_t*)((char*)K_lds + SHM_K), qr, r32, hi);
  finishSM(pA0, pA1, alA, l_reg, pa0, pa1, pa2, pa3); SBAR();
  pv_d0(o, vb0, pa0, pa1, pa2, pa3); partialSM(pB0, pB1, m_reg, mnB, alB);
  __syncthreads(); RESC(alB);
  finishSM(pB0, pB1, alB, l_reg, pa0, pa1, pa2, pa3); SBAR();
  pv_d0(o, vb0 + (int)SHM_V, pa0, pa1, pa2, pa3);
  if (hi == 0) li_l[r32] = l_reg; asm volatile("s_waitcnt lgkmcnt(0)" ::: "memory");
  float rli[16];
#pragma unroll
  for (int r = 0; r < 16; ++r) rli[r] = __builtin_amdgcn_rcpf(li_l[crow(r, hi)]);
  bf16_t* Ow = Ob + (long)(wid * QBLK) * LDO;
#pragma unroll
  for (int r = 0; r < 16; ++r) { int orow = crow(r, hi);
    for (int d0 = 0; d0 < 4; ++d0) Ow[(long)orow * LDO + d0 * 32 + r32] = f2bf(o[d0][r] * rli[r]); }
#undef SLOAD
#undef SWRITE
#undef SWAIT
#undef RESC
}
}

__device__ __forceinline__ void phase_modtab(Frame& F) {
    LAS float* sc = (LAS float*)F.lds;
    for (int i = F.tid; i < 3 * DM; i += NTHREADS) { const int s = i / DM, k = i - s * DM; const float c = s < 2 ? F.in[I_C][s * DM + k] : F.in[I_CCTX][k]; sc[i] = silu_f(c); }
    __syncthreads();
    const int gid = F.bid * NTHREADS + F.tid;
    if (gid < 2 * 9216) {
        const int l = gid / 9216, n = gid - l * 9216; const float* w = F.in[I_WMOD] + (size_t)l * DM * 9216 + n;
        const float bm = F.in[I_BMOD][l * 9216 + n]; float a0 = bm, a1 = bm, a2 = bm;
#pragma unroll 8
        for (int k = 0; k < DM; ++k) { const float wv = w[(size_t)k * 9216]; a0 = fmaf(sc[k], wv, a0); a1 = fmaf(sc[DM + k], wv, a1); a2 = fmaf(sc[2 * DM + k], wv, a2); }
        F_MT[(l * 3 + 0) * 9216 + n] = a0; F_MT[(l * 3 + 1) * 9216 + n] = a1; F_MT[(l * 3 + 2) * 9216 + n] = a2;
    }
    __syncthreads();
}
__device__ __forceinline__ void phase_norm(Frame& F, int l, int which, bool from_input, bool skip_ctx) {
    const float* g = F.in[I_NORMG] + (l * 3 + which) * DM;
    const float* src = from_input ? F.in[I_X] : F.out; const long dsrc = from_input ? F.dcin : F.dxc;
    const int gw = F.bid * 8 + F.wave, NGW = F.G * 8;
    for (int r = gw; r < TT; r += NGW) {
        bool isctx; const long o = xoff(r, dsrc, isctx); if (skip_ctx && isctx) continue;
        const int s = isctx ? 2 : r / TB;
        const float* sh = F_MT + ((l * 3 + s) * 9 + which * 3 + 0) * DM; const float* sc = sh + DM;
        f32x4 v[4]; float ss = 0.f;
#pragma unroll
        for (int j = 0; j < 4; ++j) { v[j] = *(const f32x4*)(src + o + j * 256 + F.lane * 4); ss += (v[j][0] * v[j][0] + v[j][1] * v[j][1]) + (v[j][2] * v[j][2] + v[j][3] * v[j][3]); }
        const float rstd = 1.0f / sqrtf(wave_sum(ss) * (1.f / DM) + NEPS);
#pragma unroll
        for (int j = 0; j < 4; ++j) { const int c = j * 256 + F.lane * 4; const f32x4 gv = *(const f32x4*)(g + c), shv = *(const f32x4*)(sh + c), scv = *(const f32x4*)(sc + c);
            unsigned w0, w1; { const float a = v[j][0] * rstd * gv[0] * (1.f + scv[0]) + shv[0], b = v[j][1] * rstd * gv[1] * (1.f + scv[1]) + shv[1]; w0 = (unsigned)f2bf(a) | ((unsigned)f2bf(b) << 16); }
            { const float a = v[j][2] * rstd * gv[2] * (1.f + scv[2]) + shv[2], b = v[j][3] * rstd * gv[3] * (1.f + scv[3]) + shv[3]; w1 = (unsigned)f2bf(a) | ((unsigned)f2bf(b) << 16); }
            *(uint2*)(F_HN + (size_t)r * DM + c) = make_uint2(w0, w1); }
    }
}
__device__ __forceinline__ void phase_conv(Frame& F, int b) {
    const int gw = F.bid * 8 + F.wave, NGW = F.G * 8;
    for (int it = gw; it < TB * 36; it += NGW) {
        const int u = it / 36, grp = it - u * 36; const int c0 = grp * 128 + F.lane * 2;
        const int seg_lo = u < CTXL ? 0 : CTXL, seg_hi = u < CTXL ? CTXL : TB;
        const bool ssd = c0 < 1536; const float* cw = ssd ? F.in[I_SCONVW] : F.in[I_GCONVW]; const int cc = ssd ? c0 : c0 - 1536, cn = ssd ? 1536 : 3072;
        float a0 = ssd ? F.in[I_SCONVB][cc] : 0.f, a1 = ssd ? F.in[I_SCONVB][cc + 1] : 0.f;
#pragma unroll
        for (int i = 0; i < 5; ++i) { const int uu = u + i - 2; if (uu >= seg_lo && uu < seg_hi) { const unsigned w = *(const unsigned*)(F_ABP + (size_t)uu * 6656 + 1024 + c0);
                a0 = fmaf(cw[i * cn + cc], bflo(w), a0); a1 = fmaf(cw[i * cn + cc + 1], bfhi(w), a1); } }
        a0 = silu_f(a0); a1 = silu_f(a1);
        if (grp >= 12 && grp < 28) { const float ss = wave_sum(a0 * a0 + a1 * a1); float sc = 1.0f / sqrtf(ss + NEPS); if (grp < 20) sc *= 0.08838834764831845f; a0 *= sc; a1 *= sc; }
        *(unsigned*)(F_CV + (size_t)u * 4608 + c0) = (unsigned)f2bf(a0) | ((unsigned)f2bf(a1) << 16);
    }
    for (int i = F.bid * NTHREADS + F.tid; i < TB * 64; i += F.G * NTHREADS) {
        const int j = i & 63; float v = F_ABS[i];
        if (j < 32) v = softplus_f(v + F.in[I_SDTB][j]);
        else if (j < 48) v = sigmoid_f(v);
        else v = -__expf(F.in[I_GALOG][j - 48]) * softplus_f(v + F.in[I_GDTB][j - 48]);
        F_ABS[i] = v;
    }
}
__device__ __forceinline__ int scan_tok(int dir, int i) { return dir == 0 ? i : (i < CTXL ? CTXL - 1 - i : TB + CTXL - 1 - i); }
__device__ __forceinline__ void ssd_naive(Frame& F, int head) {
    const int p = F.tid >> 3, nq = F.tid & 7, g = head >> 3;
    for (int dir = 0; dir < 2; ++dir) {
        const float a = -__expf(F.in[I_SALOG][dir * 16 + head]);
        float S[16];
#pragma unroll
        for (int j = 0; j < 16; ++j) S[j] = 0.f;
        for (int i = 0; i < TB; ++i) {
            const int u = scan_tok(dir, i); const bf16_t* row = F_CV + (size_t)u * 4608;
            const float x = bf2f(row[head * 64 + p]), dt = F_ABS[u * 64 + dir * 16 + head];
            const u32x4 b0 = *(const u32x4*)(row + 1024 + g * 128 + nq * 16), b1 = *(const u32x4*)(row + 1024 + g * 128 + nq * 16 + 8);
            const u32x4 c0 = *(const u32x4*)(row + 1280 + g * 128 + nq * 16), c1 = *(const u32x4*)(row + 1280 + g * 128 + nq * 16 + 8);
            const float dA = __expf(dt * a), xdt = x * dt; float y = 0.f;
#pragma unroll
            for (int j = 0; j < 4; ++j) {
                S[2 * j] = fmaf(S[2 * j], dA, xdt * bflo(b0[j])); y = fmaf(bflo(c0[j]), S[2 * j], y);
                S[2 * j + 1] = fmaf(S[2 * j + 1], dA, xdt * bfhi(b0[j])); y = fmaf(bfhi(c0[j]), S[2 * j + 1], y);
                S[8 + 2 * j] = fmaf(S[8 + 2 * j], dA, xdt * bflo(b1[j])); y = fmaf(bflo(c1[j]), S[8 + 2 * j], y);
                S[8 + 2 * j + 1] = fmaf(S[8 + 2 * j + 1], dA, xdt * bfhi(b1[j])); y = fmaf(bfhi(c1[j]), S[8 + 2 * j + 1], y); }
            y += __shfl_xor(y, 1); y += __shfl_xor(y, 2); y += __shfl_xor(y, 4);
            if (nq == 0) { float* yp = F_YACC + (size_t)u * 2048 + head * 64 + p; *yp = dir ? *yp + y : y; }
        }
    }
}
__device__ __forceinline__ void gdn_naive(Frame& F, int h) {
    const int e = F.tid >> 2, dq = F.tid & 3;
    for (int dir = 0; dir < 2; ++dir) {
        float S[32];
#pragma unroll
        for (int j = 0; j < 32; ++j) S[j] = 0.f;
        for (int i = 0; i < TB; ++i) {
            const int u = scan_tok(dir, i); const bf16_t* row = F_CV + (size_t)u * 4608;
            const float v = bf2f(row[3584 + h * 128 + e]), beta = F_ABS[u * 64 + 32 + dir * 8 + h], eg = __expf(F_ABS[u * 64 + 48 + dir * 8 + h]);
            u32x4 kk[4], qq[4];
#pragma unroll
            for (int j = 0; j < 4; ++j) { kk[j] = *(const u32x4*)(row + 2560 + h * 128 + dq * 32 + j * 8); qq[j] = *(const u32x4*)(row + 1536 + h * 128 + dq * 32 + j * 8); }
            float ks = 0.f;
#pragma unroll
            for (int j = 0; j < 4; ++j)
#pragma unroll
                for (int w = 0; w < 4; ++w) { ks = fmaf(bflo(kk[j][w]), S[j * 8 + 2 * w], ks); ks = fmaf(bfhi(kk[j][w]), S[j * 8 + 2 * w + 1], ks); }
            ks += __shfl_xor(ks, 1); ks += __shfl_xor(ks, 2);
            const float vn = beta * (v - eg * ks); float o = 0.f;
#pragma unroll
            for (int j = 0; j < 4; ++j)
#pragma unroll
                for (int w = 0; w < 4; ++w) {
                    S[j * 8 + 2 * w] = fmaf(eg, S[j * 8 + 2 * w], bflo(kk[j][w]) * vn); o = fmaf(bflo(qq[j][w]), S[j * 8 + 2 * w], o);
                    S[j * 8 + 2 * w + 1] = fmaf(eg, S[j * 8 + 2 * w + 1], bfhi(kk[j][w]) * vn); o = fmaf(bfhi(qq[j][w]), S[j * 8 + 2 * w + 1], o); }
            o += __shfl_xor(o, 1); o += __shfl_xor(o, 2);
            if (dq == 0) { float* yp = F_YACC + (size_t)u * 2048 + 1024 + h * 128 + e; *yp = dir ? *yp + o : o; }
        }
    }
}
__device__ __forceinline__ void phase_finish(Frame& F, int b) {
    const int gw = F.bid * 8 + F.wave, NGW = F.G * 8;
    for (int it = gw; it < TB * 10; it += NGW) {
        const int u = it / 10, k = it - u * 10;
        if (k < 2) {
            const int c0 = k * 512 + F.lane * 8; float y[8]; float ss = 0.f;
#pragma unroll
            for (int j = 0; j < 8; ++j) { const int c = c0 + j; const float xs = bf2f(F_CV[(size_t)u * 4608 + c]), z = bf2f(F_ABP[(size_t)u * 6656 + c]);
                y[j] = (F_YACC[(size_t)u * 2048 + c] + xs * F.in[I_SD][c >> 6]) * silu_f(z); ss += y[j] * y[j]; }
            const float rstd = 1.0f / sqrtf(wave_sum(ss) * (1.f / 512.f) + NEPS);
#pragma unroll
            for (int j = 0; j < 8; ++j) F_Y[(size_t)u * 2048 + c0 + j] = f2bf(y[j] * rstd * F.in[I_SNORM][c0 + j]);
        } else {
            const int h = k - 2, e0 = F.lane * 2; float y[2]; float ss = 0.f;
#pragma unroll
            for (int j = 0; j < 2; ++j) { y[j] = F_YACC[(size_t)u * 2048 + 1024 + h * 128 + e0 + j]; ss += y[j] * y[j]; }
            const float rstd = 1.0f / sqrtf(wave_sum(ss) * (1.f / 128.f) + NEPS);
#pragma unroll
            for (int j = 0; j < 2; ++j) { const float gt = bf2f(F_ABP[(size_t)u * 6656 + 5632 + h * 128 + e0 + j]);
                F_Y[(size_t)u * 2048 + 1024 + h * 128 + e0 + j] = f2bf(y[j] * rstd * F.in[I_GNORM][e0 + j] * silu_f(gt)); }
        }
    }
}
__device__ __forceinline__ void phase_qknorm_rope(Frame& F) {
    const int gw = F.bid * 8 + F.wave, NGW = F.G * 8;
    const int j = F.lane; const float invf = exp2f(-(float)(j & 31) * (13.287712379549449f / 32.f));
    for (int it = gw; it < TT * 12; it += NGW) {
        const int r = it / 12, hs = it - r * 12; const int b = r / TB, u = r - b * TB; const bool isctx = u < CTXL;
        if (isctx && hs < 8) continue;
        bf16_t* p = F_QKV + (size_t)r * 2048 + hs * 128; const float* w = hs < 8 ? F.in[I_QNORM] : F.in[I_KNORM];
        const float x1 = bf2f(p[j]), x2 = bf2f(p[j + 64]);
        const float rstd = 1.0f / sqrtf(wave_sum(x1 * x1 + x2 * x2) * (1.f / 128.f) + NEPS);
        float n1 = x1 * rstd * w[j], n2 = x2 * rstd * w[j + 64];
        if (!isctx) { const int t = u - CTXL; const float pos = (float)(j < 32 ? (t >> 6) : (t & 63)); const float ang = pos * invf;
            const float rev = ang * 0.15915494309189535f; const float fr = rev - rintf(rev);
            const float cs = __builtin_amdgcn_cosf(fr), sn = __builtin_amdgcn_sinf(fr);
            const float o1 = n1 * cs - n2 * sn, o2 = n2 * cs + n1 * sn; n1 = o1; n2 = o2; }
        p[j] = f2bf(n1); p[j + 64] = f2bf(n2);
    }
}
__device__ __forceinline__ void phase_attention(Frame& F) {
    for (int un = F.bid; un < 512; un += F.G) {
        const int qb = un & 31, hq = (un >> 5) & 7, b = un >> 8, kh = hq >> 1;
        const bf16_t* Qb = F_QKV + (size_t)(b * TB + CTXL + qb * 256) * 2048 + hq * 128;
        const bf16_t* Kh = F_QKV + (size_t)(b * TB) * 2048 + 1024 + kh * 128;
        const bf16_t* Vh = F_QKV + (size_t)(b * TB) * 2048 + 1536 + kh * 128;
        bf16_t* Ob = F_AO + (size_t)(b * TB + CTXL + qb * 256) * DM + hq * 128;
        att::attn_dense_body(Qb, Kh, Vh, Ob, TB, (char*)F.ldsg, F.tid);
        __syncthreads();
    }
}

constexpr int LDS_BYTES = 147456;
constexpr int MISC_OFF = 131072;

__global__ void __launch_bounds__(NTHREADS, 2) mk_fwd(Args args) {
    extern __shared__ __attribute__((aligned(16))) unsigned char lds_raw[];
    Frame F;
    F.in = args.in; F.out = args.out; F.ws = args.ws; F.dxc = (float*)(args.ws + WS_XC) - args.out; F.dcin = args.in[I_CTX] - args.in[I_X];
    F.lds = (LAS unsigned char*)lds_raw; F.ldsg = lds_raw;
    F.tid = threadIdx.x; F.lane = F.tid & 63; F.wave = __builtin_amdgcn_readfirstlane(F.tid >> 6); F.G = gridDim.x; F.bid = blockIdx.x;
    volatile LAS unsigned* MISC = (volatile LAS unsigned*)(F.lds + MISC_OFF);
    if (F.tid < 64) MISC[F.tid] = 0u;
    __syncthreads();
    XcdBarrier bar = xcd_barrier_post((unsigned*)(args.ws + WS_CTL), MISC + 8);
    const int lo = args.ph_lo, hi = args.ph_hi; int ph = 0;
#define PH_BEGIN if (ph >= lo && ph < hi) { F.tid = threadIdx.x; asm volatile("" : "+v"(F.tid)); F.lane = F.tid & 63; F.wave = __builtin_amdgcn_readfirstlane(F.tid >> 6);
#define PH_END   if (ph + 1 < hi) xcd_barrier(bar); } ++ph;

    PH_BEGIN phase_modtab(F); PH_END
    for (int l = 0; l < 2; ++l) {
        const float* mt = F_MT + l * 3 * 9216;
        PH_BEGIN phase_norm(F, l, 0, l == 0, false); PH_END
        PH_BEGIN { EpiSwiglu E{F_HID}; sgemm<true>(F, F_HN, DM, F.in[I_WFFIN] + (size_t)(l * 2 + 0) * DM * 2 * DFF, 2 * DFF, DFF, 0, TT, DFF, DM, false, E); } PH_END
        PH_BEGIN { EpiResid E{l == 0 ? F.in[I_X] : F.out, l == 0 ? F.dcin : F.dxc, F.out, F.dxc, mt, 2, 0.5f}; sgemm<false>(F, F_HID, DFF, F.in[I_WFFOUT] + (size_t)(l * 2 + 0) * DFF * DM, DM, 0, 0, TT, DM, DFF, false, E); } PH_END
        PH_BEGIN phase_norm(F, l, 1, false, false); PH_END
        if (l == 0) {
            for (int b = 0; b < NBATCH; ++b) {
                PH_BEGIN { EpiAB E{F_ABP, F_ABS, b * TB}; sgemm<false>(F, F_HN, DM, F.in[I_ABWIN], 6720, 0, b * TB, TB, 6720, DM, false, E); } PH_END
                PH_BEGIN phase_conv(F, b); PH_END
                #ifndef NO_SCAN
                PH_BEGIN { if (F.bid < 16) ssd_naive(F, F.bid); else if (F.bid < 24) gdn_naive(F, F.bid - 16); } PH_END
#endif
                PH_BEGIN phase_finish(F, b); PH_END
                PH_BEGIN { EpiResid E{F.out, F.dxc, F.out, F.dxc, mt, 5, 1.0f}; sgemm<false>(F, F_Y - (size_t)b * TB * 2048, 2048, F.in[I_ABWOUT], DM, 0, b * TB, TB, DM, 2048, false, E); } PH_END
            }
        } else {
            PH_BEGIN { EpiBf16Store E{F_QKV, 2048}; sgemm<false>(F, F_HN, DM, F.in[I_WQKV], 2048, 0, 0, TT, 2048, DM, false, E); } PH_END
            PH_BEGIN phase_qknorm_rope(F); PH_END
            #ifndef NO_ATT
            PH_BEGIN phase_attention(F); PH_END
#endif
            PH_BEGIN { EpiResid E{F.out, F.dxc, F.out, F.dxc, mt, 5, 1.0f}; sgemm<false>(F, F_AO, DM, F.in[I_WO], DM, 0, 0, TT, DM, DM, true, E); } PH_END
        }
        const bool skipc = (l == 1);
        PH_BEGIN phase_norm(F, l, 2, false, skipc); PH_END
        PH_BEGIN { EpiSwiglu E{F_HID}; sgemm<true>(F, F_HN, DM, F.in[I_WFFIN] + (size_t)(l * 2 + 1) * DM * 2 * DFF, 2 * DFF, DFF, 0, TT, DFF, DM, skipc, E); } PH_END
        PH_BEGIN { EpiResid E{F.out, F.dxc, F.out, F.dxc, mt, 8, 0.5f}; sgemm<false>(F, F_HID, DFF, F.in[I_WFFOUT] + (size_t)(l * 2 + 1) * DFF * DM, DM, 0, 0, TT, DM, DFF, skipc, E); } PH_END
    }
#undef PH_BEGIN
#undef PH_END
}

extern "C" void kernel_launch(void* const* d_in, const int* in_sizes, int n_in, void* d_out, int out_size, void* d_ws, size_t ws_size, hipStream_t stream) {
    static int grid = 0;
    if (grid == 0) {
        if (n_in != 25 || out_size != NBATCH * SEQ * DM || ws_size < WS_END) { fprintf(stderr, "kernel_launch: unexpected shapes (n_in %d out %d ws %zu need %zu)\n", n_in, out_size, ws_size, (size_t)WS_END); grid = -1; return; }
        int dev = 0, cus = 0, per_cu = 0;
        if (hipGetDevice(&dev) != hipSuccess || hipDeviceGetAttribute(&cus, hipDeviceAttributeMultiprocessorCount, dev) != hipSuccess) { grid = -1; return; }
        if (hipFuncSetAttribute((const void*)mk_fwd, hipFuncAttributeMaxDynamicSharedMemorySize, LDS_BYTES) != hipSuccess) { fprintf(stderr, "kernel_launch: hipFuncSetAttribute failed\n"); grid = -1; return; }
        if (hipOccupancyMaxActiveBlocksPerMultiprocessor(&per_cu, (const void*)mk_fwd, NTHREADS, LDS_BYTES) != hipSuccess || per_cu < 1) { fprintf(stderr, "kernel_launch: occupancy query says %d blocks per CU\n", per_cu); grid = -1; (void)hipGetLastError(); return; }
        grid = cus;
    }
    if (grid < 0) return;
    (void)hipMemsetAsync((char*)d_ws + WS_CTL, 0, CTL_BYTES, stream);
    Args a{};
    for (int i = 0; i < 25; ++i) a.in[i] = (const float*)d_in[i];
    a.out = (float*)d_out; a.ws = (unsigned char*)d_ws; a.ph_lo = 0; a.ph_hi = 1000;
    hipLaunchKernelGGL(mk_fwd, dim3(grid), dim3(NTHREADS), LDS_BYTES, stream, a);
    const hipError_t le = hipPeekAtLastError();
    if (le != hipSuccess) fprintf(stderr, "kernel_launch: launch failed: %s\n", hipGetErrorName(le));
}
```

```cpp
#include <hip/hip_runtime.h>
#include <cstdio>
#include <cstdint>

#define LAS __attribute__((address_space(3)))
typedef unsigned short bf16_t;
typedef short bf16x8 __attribute__((ext_vector_type(8)));
typedef short s16x4 __attribute__((ext_vector_type(4)));
typedef float f32x4 __attribute__((ext_vector_type(4)));
typedef float f32x8 __attribute__((ext_vector_type(8)));
typedef float f32x16 __attribute__((ext_vector_type(16)));
typedef unsigned u32x4 __attribute__((ext_vector_type(4)));

constexpr int DM = 1024, NBATCH = 2, SEQ = 8192, CTXL = 256, TB = SEQ + CTXL  , TT = NBATCH * TB, DFF = 2816;
constexpr int NTHREADS = 512;
constexpr float NEPS = 1e-6f;

constexpr size_t AL(size_t x) { return (x + 255) / 256 * 256; }
constexpr size_t WS_CTL = 0;
constexpr size_t CTL_BYTES = 65536;
constexpr size_t WS_MT = WS_CTL + CTL_BYTES;
constexpr size_t WS_XC = WS_MT + AL((size_t)2 * 3 * 9216 * 4);
constexpr size_t WS_HN = WS_XC + AL((size_t)2 * CTXL * DM * 4);
constexpr size_t WS_W  = WS_HN + AL((size_t)TT * DM * 2);
constexpr size_t W_FFIN0 = 0, W_FFOUT0 = W_FFIN0 + (size_t)2 * DFF * DM * 2, W_FFIN1 = W_FFOUT0 + (size_t)DM * DFF * 2, W_FFOUT1 = W_FFIN1 + (size_t)2 * DFF * DM * 2,
                 W_MIXIN = W_FFOUT1 + (size_t)DM * DFF * 2, W_MIXOUT = W_MIXIN + (size_t)6912 * DM * 2, W_BYTES = W_MIXOUT + (size_t)DM * 2048 * 2;
constexpr size_t WS_AR = WS_W + AL(W_BYTES);
constexpr size_t AR_HID = WS_AR;
constexpr size_t AR_ABP = WS_AR;
constexpr size_t AR_ABS = AR_ABP + AL((size_t)TB * 6656 * 2);
constexpr size_t AR_CV  = AR_ABS + AL((size_t)TB * 64 * 4);
constexpr size_t AR_YACC = AR_CV + AL((size_t)TB * 4608 * 2);
constexpr size_t AR_Y   = AR_YACC;
constexpr size_t AR_END0 = AR_Y + AL((size_t)TB * 2048 * 2);
constexpr size_t AR_QKV = WS_AR;
constexpr size_t AR_AO  = AR_QKV + AL((size_t)TT * 2048 * 2);
constexpr size_t AR_END1 = AR_AO + AL((size_t)TT * DM * 2);
constexpr size_t WS_END = AR_END0 > AR_END1 ? AR_END0 : AR_END1;

__device__ __forceinline__ bf16_t f2bf(float f) { unsigned u = __float_as_uint(f); u += 0x7fffu + ((u >> 16) & 1u); return (bf16_t)(u >> 16); }
__device__ __forceinline__ float bf2f(bf16_t b) { return __uint_as_float(((unsigned)b) << 16); }
__device__ __forceinline__ float bflo(unsigned w) { return __uint_as_float(w << 16); }
__device__ __forceinline__ float bfhi(unsigned w) { return __uint_as_float(w & 0xffff0000u); }
__device__ __forceinline__ float silu_f(float x) { return x / (1.f + __expf(-x)); }
__device__ __forceinline__ float softplus_f(float x) { return fmaxf(x, 0.f) + log1pf(__expf(-fabsf(x))); }
__device__ __forceinline__ float sigmoid_f(float x) { return 1.f / (1.f + __expf(-x)); }
__device__ __forceinline__ float wave_sum(float v) {
#pragma unroll
    for (int o = 1; o < 64; o <<= 1) v += __shfl_xor(v, o);
    return v;
}

#define XB_TMO      128
#define XB_XCNT(j)  (256  + 64 * (j))
#define XB_XSUB(j)  (1280 + 64 * (j))
#define XB_XGEN(j)  (2304 + 64 * (j))
#define XB_TOP      3328
#define XB_TOPGEN   3392
#define XCD_BAR_WORDS 3456
#define XB_SPIN_CAP (1u << 24)
__device__ __forceinline__ unsigned xb_ld(unsigned* p)              { return __hip_atomic_load(p, __ATOMIC_RELAXED, __HIP_MEMORY_SCOPE_AGENT); }
__device__ __forceinline__ unsigned xb_add(unsigned* p, unsigned v) { return __hip_atomic_fetch_add(p, v, __ATOMIC_RELAXED, __HIP_MEMORY_SCOPE_AGENT); }
__device__ __forceinline__ unsigned xb_xcc_id() { return (unsigned)__builtin_amdgcn_s_getreg((3 << 11) | 20) & 0xFu; }
#define XB_SPIN(cond, bar) do { unsigned _sp = 0; while (cond) { __builtin_amdgcn_s_sleep(1); \
    if ((++_sp & 255u) == 0u) { if (xb_ld(&(bar)[XB_TMO])) break; if (_sp > XB_SPIN_CAP) { atomicAdd(&(bar)[XB_TMO], 1u); break; } } } } while (0)
struct XcdBarrier { unsigned* bar; unsigned x; volatile LAS unsigned* st; };
__device__ __forceinline__ XcdBarrier xcd_barrier_post(unsigned* bar, volatile LAS unsigned* st) {
    XcdBarrier b; b.bar = bar; b.x = xb_xcc_id(); b.st = st;
    if (threadIdx.x == 0) (void)xb_add(&bar[XB_XCNT(b.x)], 1u);
    return b;
}
__device__ __forceinline__ void xcd_barrier_complete(unsigned* bar, unsigned x, unsigned& nloc, unsigned& nx) {
    const unsigned G = gridDim.x * gridDim.y * gridDim.z;
    unsigned sum, cnt, mine, sp = 0u;
    for (;;) {
        sum = 0u; cnt = 0u; mine = 0u;
#pragma unroll
        for (unsigned j = 0; j < 16; ++j) { const unsigned c = xb_ld(&bar[XB_XCNT(j)]); sum += c; cnt += (c > 0u) ? 1u : 0u; mine = (j == x) ? c : mine; }
        if (sum == G) break;
        __builtin_amdgcn_s_sleep(1);
        if ((++sp & 255u) == 0u) { if (xb_ld(&bar[XB_TMO])) break; if (sp > XB_SPIN_CAP) { atomicAdd(&bar[XB_TMO], 1u); break; } }
    }
    nloc = mine > 0u ? mine : 1u; nx = cnt > 0u ? cnt : 1u;
}
__device__ __forceinline__ void xcd_barrier(const XcdBarrier& b) {
    asm volatile("s_waitcnt vmcnt(0)" ::: "memory");
    __syncthreads();
    if (threadIdx.x == 0) {
        unsigned* bar = b.bar;
        __builtin_amdgcn_s_waitcnt(0);
        unsigned nloc = b.st[0], nx = b.st[1];
        if (nloc == 0u) { xcd_barrier_complete(bar, b.x, nloc, nx); b.st[0] = nloc; b.st[1] = nx; }
        const unsigned old = xb_add(&bar[XB_XSUB(b.x)], 1u);
        const unsigned gen = old / nloc;
        if (old + 1u == (gen + 1u) * nloc) {
            __builtin_amdgcn_fence(__ATOMIC_RELEASE, "agent");
            asm volatile("s_waitcnt vmcnt(0)" ::: "memory");
            const unsigned og = xb_add(&bar[XB_TOP], 1u);
            const unsigned tg = og / nx;
            if (og + 1u == (tg + 1u) * nx) xb_add(&bar[XB_TOPGEN], 1u);
            else XB_SPIN(xb_ld(&bar[XB_TOPGEN]) == tg, bar);
            __builtin_amdgcn_fence(__ATOMIC_ACQUIRE, "agent");
            xb_add(&bar[XB_XGEN(b.x)], 1u);
            asm volatile("s_waitcnt vmcnt(0)" ::: "memory");
        } else {
            XB_SPIN(xb_ld(&bar[XB_XGEN(b.x)]) == gen, bar);
            __builtin_amdgcn_fence(__ATOMIC_ACQUIRE, "agent");
            asm volatile("s_waitcnt vmcnt(0)" ::: "memory");
        }
    }
    __syncthreads();
}

struct Args { const float* in[25]; float* out; unsigned char* ws; int ph_lo, ph_hi; };
enum { I_X = 0, I_C, I_CTX, I_CCTX, I_WMOD, I_BMOD, I_NORMG, I_WFFIN, I_WFFOUT, I_ABWIN, I_SCONVW, I_SCONVB, I_SALOG, I_SDTB, I_SD, I_SNORM,
       I_GCONVW, I_GALOG, I_GDTB, I_GNORM, I_ABWOUT, I_WQKV, I_QNORM, I_KNORM, I_WO };

struct Frame {
    const float* const* in; float* out; unsigned char* ws; long dxc, dcin;
    LAS unsigned char* lds; unsigned char* ldsg;
    int tid, lane, wave, G, bid;
};
#define F_MT   ((float*)(F.ws + WS_MT))
#define F_XC   ((float*)(F.ws + WS_XC))
#define F_HN   ((bf16_t*)(F.ws + WS_HN))
#define F_HID  ((bf16_t*)(F.ws + AR_HID))
#define F_ABP  ((bf16_t*)(F.ws + AR_ABP))
#define F_ABS  ((float*)(F.ws + AR_ABS))
#define F_CV   ((bf16_t*)(F.ws + AR_CV))
#define F_YACC ((bf16_t*)(F.ws + AR_YACC))
#define F_Y    ((bf16_t*)(F.ws + AR_Y))
#define F_QKV  ((bf16_t*)(F.ws + AR_QKV))
#define F_AO   ((bf16_t*)(F.ws + AR_AO))
__device__ __forceinline__ long xoff(int r, long dctx, bool& isctx) { const int b = r / TB, u = r - b * TB; isctx = u < CTXL; return isctx ? dctx + (long)(b * CTXL + u) * DM : (long)(b * SEQ + u - CTXL) * DM; }

template <bool DUAL, class Epi>
__device__ __forceinline__ void sgemm(Frame& F, const bf16_t* A, int lda, const float* W, int ldw, int dual_off, int row0, int nrows, int N, int K, bool skip_ctx, const Epi& epi) {
    LAS bf16_t* sA = (LAS bf16_t*)F.lds; LAS bf16_t* sB = sA + 128 * 40; LAS bf16_t* sB2 = sB + 64 * 40;
    const int tid = F.tid, lane = F.lane, wid = F.wave;
    const int ntn = N / 64, ntiles = (nrows / 128) * ntn;
    for (int t = F.bid; t < ntiles; t += F.G) {
        const int tm = t / ntn, tn = t - tm * ntn, m0 = row0 + tm * 128, n0 = tn * 64;
        if (skip_ctx && (m0 % TB) < CTXL) continue;
        f32x4 acc[4], acc2[4];
#pragma unroll
        for (int j = 0; j < 4; ++j) { acc[j] = (f32x4){0.f, 0.f, 0.f, 0.f}; acc2[j] = (f32x4){0.f, 0.f, 0.f, 0.f}; }
        for (int k0 = 0; k0 < K; k0 += 32) {
            { const int r = tid >> 2, kq = (tid & 3) * 8; const u32x4 v = *(const u32x4*)(A + (size_t)(m0 + r) * lda + k0 + kq); *(LAS u32x4*)(sA + r * 40 + kq) = v; }
            { const int k = tid >> 4, n4 = (tid & 15) * 4; const f32x4 w = *(const f32x4*)(W + (size_t)(k0 + k) * ldw + n0 + n4);
              sB[(n4 + 0) * 40 + k] = f2bf(w[0]); sB[(n4 + 1) * 40 + k] = f2bf(w[1]); sB[(n4 + 2) * 40 + k] = f2bf(w[2]); sB[(n4 + 3) * 40 + k] = f2bf(w[3]);
              if (DUAL) { const f32x4 w2 = *(const f32x4*)(W + (size_t)(k0 + k) * ldw + n0 + n4 + dual_off);
                  sB2[(n4 + 0) * 40 + k] = f2bf(w2[0]); sB2[(n4 + 1) * 40 + k] = f2bf(w2[1]); sB2[(n4 + 2) * 40 + k] = f2bf(w2[2]); sB2[(n4 + 3) * 40 + k] = f2bf(w2[3]); } }
            __syncthreads();
            const bf16x8 a = *(const LAS bf16x8*)(sA + (16 * wid + (lane & 15)) * 40 + 8 * (lane >> 4));
#pragma unroll
            for (int j = 0; j < 4; ++j) { const bf16x8 b = *(const LAS bf16x8*)(sB + (16 * j + (lane & 15)) * 40 + 8 * (lane >> 4));
                acc[j] = __builtin_amdgcn_mfma_f32_16x16x32_bf16(a, b, acc[j], 0, 0, 0);
                if (DUAL) { const bf16x8 b2 = *(const LAS bf16x8*)(sB2 + (16 * j + (lane & 15)) * 40 + 8 * (lane >> 4)); acc2[j] = __builtin_amdgcn_mfma_f32_16x16x32_bf16(a, b2, acc2[j], 0, 0, 0); } }
            __syncthreads();
        }
#pragma unroll
        for (int j = 0; j < 4; ++j)
#pragma unroll
            for (int r = 0; r < 4; ++r) epi(m0 + 16 * wid + 4 * (lane >> 4) + r, n0 + 16 * j + (lane & 15), acc[j][r], acc2[j][r]);
    }
}
struct EpiSwiglu { bf16_t* hid; __device__ __forceinline__ void operator()(int r, int c, float g, float u) const { hid[(size_t)r * DFF + c] = f2bf(silu_f(g) * u); } };
struct EpiResid {
    const float* base; long dbase; float* out; long dxc; const float* mt; int gidx; float coef;
    __device__ __forceinline__ void operator()(int r, int c, float v, float) const {
        bool isctx; const long ob = xoff(r, dbase, isctx) + c; const long oo = xoff(r, dxc, isctx) + c; const int s = isctx ? 2 : r / TB;
        out[oo] = base[ob] + coef * mt[(s * 9 + gidx) * DM + c] * v;
    }
};
struct EpiAB {
    bf16_t* abp; float* abs_; int row0;
    __device__ __forceinline__ void operator()(int r, int c, float v, float) const {
        const int u = r - row0;
        if (c < 2560) abp[(size_t)u * 6656 + c] = f2bf(v);
        else if (c < 2592) abs_[u * 64 + (c - 2560)] = v;
        else if (c < 6688) abp[(size_t)u * 6656 + (c - 32)] = f2bf(v);
        else abs_[u * 64 + 32 + (c - 6688)] = v;
    }
};
struct EpiBf16Store { bf16_t* o; int ldo; __device__ __forceinline__ void operator()(int r, int c, float v, float) const { o[(size_t)r * ldo + c] = f2bf(v); } };


namespace pg8 {
constexpr int BM = 256, BK = 64, HALF = 128, HTB = HALF * BK * 2, STAGE_BYTES = 8 * HTB, NXCD = 8, WGM = 8;
__host__ __device__ __forceinline__ int lds_byte(int r, int c) { const int st = (r >> 4) * 2 + (c >> 5), rr = r & 15, cc = c & 31, ob = rr * 64 + cc * 2; return st * 1024 + (ob ^ (((ob >> 9) & 1) << 5)); }
__host__ __device__ __forceinline__ void stage_rc(int b, int& R, int& C) { const int st = b / 1024, sb = b % 1024, swz = sb ^ (((sb >> 9) & 1) << 5); R = (st >> 1) * 16 + swz / 64; C = (st & 1) * 32 + (swz % 64) / 2; }
__host__ __device__ __forceinline__ int perm32(int rho) { const int n = rho >> 4, i = rho & 15; return 8 * (i >> 2) + 4 * n + (i & 3); }
struct Unit { int pm, pn; };
struct Gemm { const bf16_t* A; const bf16_t* Bt; int K; };
struct Order {
    int nM, nN, nwg, G, c, pm0, mode;
    __device__ __forceinline__ void init(int nM_, int nN_, int G_, int c_, int pm0_, int mode_) { nM = nM_; nN = nN_; nwg = nM * nN; G = G_; c = c_; pm0 = pm0_; mode = mode_; }
    __device__ __forceinline__ bool next(int i, Unit& u) const {
        const long L = (long)i * G + c; if (L >= nwg) return false;
        int wgid = (int)L; { const int q = nwg / NXCD, r = nwg % NXCD, xcd = wgid % NXCD, off = wgid / NXCD; wgid = (xcd < r ? xcd * (q + 1) : r * (q + 1) + (xcd - r) * q) + off; }
        const int nig = WGM * nN, gid = wgid / nig, fm = gid * WGM, gsz = (nM - fm) < WGM ? (nM - fm) : WGM;
        int pm = fm + ((wgid % nig) % gsz); u.pn = (wgid % nig) / gsz;
        u.pm = mode ? (pm / 32) * 33 + 1 + (pm % 32) : pm0 + pm; return true;
    }
};
__device__ __forceinline__ unsigned cvt_pk_bf16(float lo, float hi) { unsigned r; asm volatile("v_cvt_pk_bf16_f32 %0, %1, %2" : "=v"(r) : "v"(lo), "v"(hi)); return r; }

template <class Epi>
__device__ __forceinline__ void gemm_phase(LAS unsigned char* lds, const Gemm g, const Order& S, const Epi& E, int tid) {
    const int wid = __builtin_amdgcn_readfirstlane(tid >> 6), lane = tid & 63, wr = wid >> 2, wc = wid & 3, fr = lane & 15, fq = lane >> 4;
    const int K = g.K, nt = K / BK;
    unsigned voffA[2], voffB[2];
#pragma unroll
    for (int i = 0; i < 2; ++i) { int R, C; stage_rc(tid * 16 + i * 8192, R, C); const int Rb = Epi::PERM ? ((R & ~31) + perm32(R & 31)) : R;
        voffA[i] = (unsigned)(R * K + C) * 2u; voffB[i] = (unsigned)(Rb * K + C) * 2u; }
    const size_t kstep = (size_t)(BK * 2);
    const size_t hstep = (size_t)HALF * K * 2;
    const size_t tstep = 2 * hstep;
    const unsigned ldsw = (unsigned)wid * 1024u;
    const int aoff = lds_byte(wr * 64 + fr, fq * 8), boff = lds_byte(wc * 32 + fr, fq * 8);
#define PG8_SA(b, h) (((b) * 2 + (h)) * HTB)
#define PG8_SB(b, h) ((4 + (b) * 2 + (h)) * HTB)
#define PG8_STAGE(bufoff, gbase, voff) do { _Pragma("unroll") for (int _i = 0; _i < 2; ++_i) \
        __builtin_amdgcn_global_load_lds((const unsigned*)((const char*)(gbase) + (voff)[_i]), (LAS unsigned*)(lds + (bufoff) + ldsw + _i * 8192), 16, 0, 0); } while (0)
#define PG8_LDA(dst, b, h) do { _Pragma("unroll") for (int m = 0; m < 4; ++m) _Pragma("unroll") for (int k = 0; k < 2; ++k) dst[m][k] = *(const LAS bf16x8*)(lds + PG8_SA(b, h) + aoff + m * 2048 + k * 1024); } while (0)
#define PG8_LDB(dst, b, h) do { _Pragma("unroll") for (int n = 0; n < 2; ++n) _Pragma("unroll") for (int k = 0; k < 2; ++k) dst[n][k] = *(const LAS bf16x8*)(lds + PG8_SB(b, h) + boff + n * 2048 + k * 1024); } while (0)
#define PG8_MMA(ai, bj, At, Bt) do { __builtin_amdgcn_s_setprio(1); _Pragma("unroll") for (int m = 0; m < 4; ++m) _Pragma("unroll") for (int n = 0; n < 2; ++n) _Pragma("unroll") for (int k = 0; k < 2; ++k) \
        acc[ai][bj][m][n] = __builtin_amdgcn_mfma_f32_16x16x32_bf16(Bt[n][k], At[m][k], acc[ai][bj][m][n], 0, 0, 0); __builtin_amdgcn_s_setprio(0); } while (0)
#define PG8_WAIT_V(n) asm volatile("s_waitcnt vmcnt(" #n ")" ::: "memory")
#define PG8_WAIT_L(n) asm volatile("s_waitcnt lgkmcnt(" #n ")" ::: "memory")
#define PG8_BAR __builtin_amdgcn_s_barrier()
#define PG8_SCHED __builtin_amdgcn_sched_barrier(0)
    Unit cur, nxt; int ui = 0;
    if (!S.next(0, cur)) return;
    f32x4 acc[2][2][4][2];
#pragma unroll
    for (int a = 0; a < 2; ++a)
#pragma unroll
        for (int b = 0; b < 2; ++b)
#pragma unroll
            for (int m = 0; m < 4; ++m)
#pragma unroll
                for (int n = 0; n < 2; ++n) acc[a][b][m][n] = (f32x4){0.f, 0.f, 0.f, 0.f};
    bf16x8 At[4][2], B0[2][2], B1[2][2];
    const char* cA = (const char*)g.A + (size_t)cur.pm * tstep; const char* cB = (const char*)g.Bt + (size_t)cur.pn * tstep;
    PG8_STAGE(PG8_SB(0, 0), cB, voffB); PG8_STAGE(PG8_SA(0, 0), cA, voffA); PG8_STAGE(PG8_SB(0, 1), cB + hstep, voffB); PG8_STAGE(PG8_SA(0, 1), cA + hstep, voffA);
    if (wr == 1) PG8_BAR;
    PG8_WAIT_V(4); PG8_BAR;
    PG8_STAGE(PG8_SB(1, 0), cB + kstep, voffB); PG8_STAGE(PG8_SA(1, 0), cA + kstep, voffA); PG8_STAGE(PG8_SB(1, 1), cB + hstep + kstep, voffB);
    PG8_WAIT_V(6); PG8_BAR;
    for (;;) {
        const bool has_next = S.next(ui + 1, nxt);
        const char* nA = has_next ? (const char*)g.A + (size_t)nxt.pm * tstep : cA; const char* nB = has_next ? (const char*)g.Bt + (size_t)nxt.pn * tstep : cB;
        for (int t = 0; t < nt; t += 2) {
            const bool last = (t == nt - 2);
            const char* a1 = cA + (size_t)(t + 1) * kstep;
            const char* a2 = last ? nA : cA + (size_t)(t + 2) * kstep; const char* b2 = last ? nB : cB + (size_t)(t + 2) * kstep;
            const char* a3 = a2 + kstep; const char* b3 = b2 + kstep;
            PG8_LDB(B0, 0, 0); PG8_SCHED; PG8_LDA(At, 0, 0); PG8_STAGE(PG8_SA(1, 1), a1 + hstep, voffA);
            PG8_WAIT_L(8); PG8_BAR; PG8_WAIT_L(0); PG8_MMA(0, 0, At, B0); PG8_BAR; PG8_SCHED;
            PG8_LDB(B1, 0, 1); PG8_STAGE(PG8_SB(0, 0), b2, voffB);
            PG8_BAR; PG8_WAIT_L(0); PG8_MMA(0, 1, At, B1); PG8_BAR;
            PG8_LDA(At, 0, 1); PG8_STAGE(PG8_SA(0, 0), a2, voffA);
            PG8_BAR; PG8_WAIT_L(0); PG8_MMA(1, 0, At, B0); PG8_BAR; PG8_SCHED;
            PG8_STAGE(PG8_SB(0, 1), b2 + hstep, voffB);
            PG8_WAIT_V(6); PG8_BAR; PG8_MMA(1, 1, At, B1); PG8_BAR;
            PG8_LDB(B0, 1, 0); PG8_SCHED; PG8_LDA(At, 1, 0); PG8_STAGE(PG8_SA(0, 1), a2 + hstep, voffA);
            PG8_WAIT_L(8); PG8_BAR; PG8_WAIT_L(0); PG8_MMA(0, 0, At, B0); PG8_BAR; PG8_SCHED;
            PG8_LDB(B1, 1, 1); PG8_STAGE(PG8_SB(1, 0), b3, voffB);
            PG8_BAR; PG8_WAIT_L(0); PG8_MMA(0, 1, At, B1); PG8_BAR;
            PG8_LDA(At, 1, 1); PG8_STAGE(PG8_SA(1, 0), a3, voffA);
            PG8_BAR; PG8_WAIT_L(0); PG8_MMA(1, 0, At, B0); PG8_BAR; PG8_SCHED;
            PG8_STAGE(PG8_SB(1, 1), b3 + hstep, voffB);
            PG8_WAIT_V(6); PG8_BAR; PG8_MMA(1, 1, At, B1); PG8_BAR;
        }
        E(acc, cur, wr, wc, fr, fq);
        if (!has_next) break;
#pragma unroll
        for (int a = 0; a < 2; ++a)
#pragma unroll
            for (int b = 0; b < 2; ++b)
#pragma unroll
                for (int m = 0; m < 4; ++m)
#pragma unroll
                    for (int n = 0; n < 2; ++n) acc[a][b][m][n] = (f32x4){0.f, 0.f, 0.f, 0.f};
        cur = nxt; cA = nA; cB = nB; ++ui;
    }
    PG8_WAIT_V(0);
    if (wr == 0) PG8_BAR;
    PG8_BAR;
#undef PG8_SA
#undef PG8_SB
#undef PG8_STAGE
#undef PG8_LDA
#undef PG8_LDB
#undef PG8_MMA
#undef PG8_WAIT_V
#undef PG8_WAIT_L
#undef PG8_BAR
#undef PG8_SCHED
}
struct EpiSwigluP {
    static constexpr bool PERM = true; bf16_t* hid;
    __device__ __forceinline__ void operator()(const f32x4 (&acc)[2][2][4][2], const Unit& u, int wr, int wc, int fr, int fq) const {
        const int row0 = u.pm * BM + wr * 64 + fr, col0 = u.pn * 128 + wc * 32 + 8 * fq;
#pragma unroll
        for (int ai = 0; ai < 2; ++ai)
#pragma unroll
            for (int m = 0; m < 4; ++m) { float h[8];
#pragma unroll
                for (int n = 0; n < 2; ++n)
#pragma unroll
                    for (int i = 0; i < 4; ++i) h[n * 4 + i] = silu_f(acc[ai][0][m][n][i]) * acc[ai][1][m][n][i];
                u32x4 w; w.x = cvt_pk_bf16(h[0], h[1]); w.y = cvt_pk_bf16(h[2], h[3]); w.z = cvt_pk_bf16(h[4], h[5]); w.w = cvt_pk_bf16(h[6], h[7]);
                *(u32x4*)(hid + (size_t)(row0 + ai * HALF + m * 16) * DFF + col0) = w; }
    }
};
struct EpiResidP {
    static constexpr bool PERM = false; const float* base; long dbase; float* out; long dxc; const float* mt; int gidx; float coef;
    __device__ __forceinline__ void operator()(const f32x4 (&acc)[2][2][4][2], const Unit& u, int wr, int wc, int fr, int fq) const {
        const int b = u.pm / 33, j = u.pm - b * 33; const bool isctx = (j == 0); const int s = isctx ? 2 : b;
        const long rb = isctx ? (long)(b * CTXL) * DM : (long)(b * SEQ + (j - 1) * 256) * DM;
        const float* bp = base + rb + (isctx ? dbase : 0); float* op = out + rb + (isctx ? dxc : 0);
        const int col0 = u.pn * BM + wc * 32 + 4 * fq; const float* gv = mt + (s * 9 + gidx) * DM + col0;
        f32x4 g4[2][2];
#pragma unroll
        for (int bj = 0; bj < 2; ++bj)
#pragma unroll
            for (int n = 0; n < 2; ++n) g4[bj][n] = *(const f32x4*)(gv + bj * HALF + n * 16) * coef;
#pragma unroll
        for (int ai = 0; ai < 2; ++ai)
#pragma unroll
            for (int m = 0; m < 4; ++m) { const long off = (long)(ai * HALF + wr * 64 + m * 16 + fr) * DM + col0;
#pragma unroll
                for (int bj = 0; bj < 2; ++bj)
#pragma unroll
                    for (int n = 0; n < 2; ++n) { const f32x4 bs = *(const f32x4*)(bp + off + bj * HALF + n * 16); *(f32x4*)(op + off + bj * HALF + n * 16) = bs + g4[bj][n] * acc[ai][bj][m][n]; }
                asm volatile("" ::: "memory"); }
    }
};
struct EpiABP {
    static constexpr bool PERM = true; bf16_t* abp; float* abs_; int row0;
    __device__ __forceinline__ void operator()(const f32x4 (&acc)[2][2][4][2], const Unit& u, int wr, int wc, int fr, int fq) const {
        const int u0 = u.pm * BM - row0 + wr * 64 + fr;
        if (u.pn < 26) { const int col0 = u.pn * BM + wc * 32 + 8 * fq;
#pragma unroll
            for (int ai = 0; ai < 2; ++ai)
#pragma unroll
                for (int m = 0; m < 4; ++m)
#pragma unroll
                    for (int bj = 0; bj < 2; ++bj) { const f32x4 v0 = acc[ai][bj][m][0], v1 = acc[ai][bj][m][1];
                        u32x4 w; w.x = cvt_pk_bf16(v0[0], v0[1]); w.y = cvt_pk_bf16(v0[2], v0[3]); w.z = cvt_pk_bf16(v1[0], v1[1]); w.w = cvt_pk_bf16(v1[2], v1[3]);
                        *(u32x4*)(abp + (size_t)(u0 + ai * HALF + m * 16) * 6656 + col0 + bj * HALF) = w; }
        } else if (wc < 2) {
#pragma unroll
            for (int ai = 0; ai < 2; ++ai)
#pragma unroll
                for (int m = 0; m < 4; ++m) { float* p = abs_ + (size_t)(u0 + ai * HALF + m * 16) * 64 + wc * 32 + 8 * fq;
                    *(f32x4*)p = acc[ai][0][m][0]; *(f32x4*)(p + 4) = acc[ai][0][m][1]; }
        }
    }
};
struct EpiBf16P {
    static constexpr bool PERM = true; bf16_t* O; int ldc;
    __device__ __forceinline__ void operator()(const f32x4 (&acc)[2][2][4][2], const Unit& u, int wr, int wc, int fr, int fq) const {
        const int row0 = u.pm * BM + wr * 64 + fr, col0 = u.pn * BM + wc * 32 + 8 * fq;
#pragma unroll
        for (int ai = 0; ai < 2; ++ai)
#pragma unroll
            for (int m = 0; m < 4; ++m)
#pragma unroll
                for (int bj = 0; bj < 2; ++bj) { const f32x4 v0 = acc[ai][bj][m][0], v1 = acc[ai][bj][m][1];
                    u32x4 w; w.x = cvt_pk_bf16(v0[0], v0[1]); w.y = cvt_pk_bf16(v0[2], v0[3]); w.z = cvt_pk_bf16(v1[0], v1[1]); w.w = cvt_pk_bf16(v1[2], v1[3]);
                    *(u32x4*)(O + (size_t)(row0 + ai * HALF + m * 16) * ldc + col0 + bj * HALF) = w; }
    }
};
}

__device__ __forceinline__ void cvt_item(const float* W, int ldw, int K, bf16_t* WT, int dest_row0, int src_col0, int kb, LAS float* scr, int lane) {
    const int k0 = 64 * kb;
#pragma unroll 8
    for (int i = 0; i < 32; ++i) { const int kk = 2 * i + (lane >> 5); scr[kk * 33 + (lane & 31)] = src_col0 >= 0 ? W[(size_t)(k0 + kk) * ldw + src_col0 + (lane & 31)] : 0.f; }
    asm volatile("s_waitcnt lgkmcnt(0)" ::: "memory");
    const int c = lane & 7;
#pragma unroll
    for (int j = 0; j < 4; ++j) { const int n = (lane >> 3) + 8 * j; const LAS float* sp = scr + (8 * c) * 33 + n;
        u32x4 o; o.x = pg8::cvt_pk_bf16(sp[0 * 33], sp[1 * 33]); o.y = pg8::cvt_pk_bf16(sp[2 * 33], sp[3 * 33]); o.z = pg8::cvt_pk_bf16(sp[4 * 33], sp[5 * 33]); o.w = pg8::cvt_pk_bf16(sp[6 * 33], sp[7 * 33]);
        *(u32x4*)(WT + (size_t)(dest_row0 + n) * K + k0 + 8 * c) = o; }
    asm volatile("s_waitcnt lgkmcnt(0)" ::: "memory");
}
__device__ __forceinline__ int map_ffin(int nb) { const int r0 = nb * 32, pn = r0 >> 8, j = r0 & 255; return j < 128 ? pn * 128 + j : DFF + pn * 128 + (j - 128); }
__device__ __forceinline__ int map_abin(int nb) { const int r0 = nb * 32; return r0 < 2560 ? r0 : (r0 < 6656 ? r0 + 32 : (r0 == 6656 ? 2560 : (r0 == 6688 ? 6688 : -1))); }
__device__ __forceinline__ void phase_convert(Frame& F, int l) {
    LAS float* scr = (LAS float*)(F.lds + F.wave * 8448);
    unsigned char* wb = F.ws + WS_W;
    const int gw = F.bid * 8 + F.wave, NGW = F.G * 8;
    constexpr int I_FFIN = 16 * 176, I_FFOUT = 44 * 32;
    const int n_in = l == 0 ? 216 : 64, I_MIN = 16 * n_in, kb_out = l == 0 ? 32 : 16, I_MOUT = kb_out * 32;
    const int total = 2 * I_FFIN + 2 * I_FFOUT + I_MIN + I_MOUT;
    for (int it = gw; it < total; it += NGW) {
        int r = it;
        if (r < 2 * I_FFIN) { const int w = r / I_FFIN; r -= w * I_FFIN; const int kb = r / 176, nb = r - kb * 176;
            cvt_item(F.in[I_WFFIN] + (size_t)(l * 2 + w) * DM * 2 * DFF, 2 * DFF, DM, (bf16_t*)(wb + (w ? W_FFIN1 : W_FFIN0)), nb * 32, map_ffin(nb), kb, scr, F.lane); continue; }
        r -= 2 * I_FFIN;
        if (r < 2 * I_FFOUT) { const int w = r / I_FFOUT; r -= w * I_FFOUT; const int kb = r / 32, nb = r - kb * 32;
            cvt_item(F.in[I_WFFOUT] + (size_t)(l * 2 + w) * DFF * DM, DM, DFF, (bf16_t*)(wb + (w ? W_FFOUT1 : W_FFOUT0)), nb * 32, nb * 32, kb, scr, F.lane); continue; }
        r -= 2 * I_FFOUT;
        if (r < I_MIN) { const int kb = r / n_in, nb = r - kb * n_in;
            if (l == 0) cvt_item(F.in[I_ABWIN], 6720, DM, (bf16_t*)(wb + W_MIXIN), nb * 32, map_abin(nb), kb, scr, F.lane);
            else cvt_item(F.in[I_WQKV], 2048, DM, (bf16_t*)(wb + W_MIXIN), nb * 32, nb * 32, kb, scr, F.lane);
            continue; }
        r -= I_MIN;
        { const int kb = r / 32, nb = r - kb * 32;
          if (l == 0) cvt_item(F.in[I_ABWOUT], DM, 2048, (bf16_t*)(wb + W_MIXOUT), nb * 32, nb * 32, kb, scr, F.lane);
          else cvt_item(F.in[I_WO], DM, DM, (bf16_t*)(wb + W_MIXOUT), nb * 32, nb * 32, kb, scr, F.lane); }
    }
}

namespace att {
constexpr int D = 128, NW = 8, QBLK = 32, KVBLK = 64;
constexpr float SCALE = 0.088388347648318440f;
constexpr float THR = 8.f;
constexpr int SDEPTH = 1;
constexpr int LDQ = 2048, LDK = 2048, LDO = 1024;
constexpr size_t SHM_V = KVBLK * D * 2, SHM_K = KVBLK * D * 2, SHM_ATTN = 2 * SHM_V + 2 * SHM_K + NW * 64 * 4;
#define KSWZ(row, colB) ((row) * 256 + ((colB) ^ (((row) & 7) << 4)))
#define SBAR() __builtin_amdgcn_sched_barrier(0)
__device__ __forceinline__ int crow(int r, int hi) { return (r & 3) + 8 * (r >> 2) + 4 * hi; }
__device__ __forceinline__ unsigned cvtpk(float lo, float hi) { unsigned r; asm volatile("v_cvt_pk_bf16_f32 %0, %1, %2" : "=v"(r) : "v"(lo), "v"(hi)); return r; }
__device__ __forceinline__ bf16x8 ld8(const bf16_t* p) { return *reinterpret_cast<const bf16x8*>(p); }
__device__ __forceinline__ void partialSM(f32x16& p0, f32x16& p1, float& m_reg, float& mn, float& alpha) {
  constexpr float C = SCALE * 1.4426950408889634f;
  float pmax = p0[0]; for (int r = 1; r < 16; ++r) pmax = fmaxf(pmax, p0[r]); for (int r = 0; r < 16; ++r) pmax = fmaxf(pmax, p1[r]);
  { auto rr = __builtin_amdgcn_permlane32_swap(__float_as_uint(pmax), __float_as_uint(pmax), false, false);
    pmax = fmaxf(__uint_as_float(rr[0]), __uint_as_float(rr[1])); }
  if (__builtin_expect(__all(pmax - m_reg <= THR / SCALE), 1)) { mn = m_reg; alpha = 1.f; }
  else { mn = fmaxf(m_reg, pmax); alpha = __builtin_amdgcn_exp2f((m_reg - mn) * C); m_reg = mn; }
  float mnC = -mn * C;
  for (int r = 0; r < 16; ++r) p0[r] = fmaf(p0[r], C, mnC); for (int r = 0; r < 16; ++r) p1[r] = fmaf(p1[r], C, mnC);
  for (int r = 0; r < 16; ++r) p0[r] = __builtin_amdgcn_exp2f(p0[r]);
}
__device__ __forceinline__ void finishSM(f32x16& p0, f32x16& p1, float alpha, float& l_reg, bf16x8& pa0, bf16x8& pa1, bf16x8& pa2, bf16x8& pa3) {
  for (int r = 0; r < 16; ++r) p1[r] = __builtin_amdgcn_exp2f(p1[r]);
  float ps = 0; for (int r = 0; r < 16; ++r) ps += p0[r]; for (int r = 0; r < 16; ++r) ps += p1[r];
  { auto rr = __builtin_amdgcn_permlane32_swap(__float_as_uint(ps), __float_as_uint(ps), false, false);
    ps = __uint_as_float(rr[0]) + __uint_as_float(rr[1]); }
  l_reg = l_reg * alpha + ps;
#define PK4(P, BASE, OUT) do { unsigned a0 = cvtpk(P[BASE + 0], P[BASE + 1]), a1 = cvtpk(P[BASE + 2], P[BASE + 3]);   \
    unsigned b0 = cvtpk(P[BASE + 4], P[BASE + 5]), b1 = cvtpk(P[BASE + 6], P[BASE + 7]);                              \
    auto r0 = __builtin_amdgcn_permlane32_swap(a0, b0, false, false); auto r1 = __builtin_amdgcn_permlane32_swap(a1, b1, false, false); \
    u32x4 w = {r0[0], r1[0], r0[1], r1[1]}; OUT = *reinterpret_cast<bf16x8*>(&w); } while (0)
  PK4(p0, 0, pa0); PK4(p0, 8, pa1); PK4(p1, 0, pa2); PK4(p1, 8, pa3);
#undef PK4
}
__device__ __forceinline__ void qkt(f32x16& p0, f32x16& p1, const bf16_t* Ks, const bf16x8* qr, int r32, int hi) {
  p0 = f32x16{}; p1 = f32x16{};
  for (int d0 = 0; d0 < 8; ++d0) { int cb = (d0 * 16 + hi * 8) * 2;
    bf16x8 b0 = *reinterpret_cast<const bf16x8*>((const char*)Ks + KSWZ(r32, cb));
    bf16x8 b1 = *reinterpret_cast<const bf16x8*>((const char*)Ks + KSWZ(32 + r32, cb));
    p0 = __builtin_amdgcn_mfma_f32_32x32x16_bf16(b0, qr[d0], p0, 0, 0, 0);
    p1 = __builtin_amdgcn_mfma_f32_32x32x16_bf16(b1, qr[d0], p1, 0, 0, 0); }
}
__device__ __forceinline__ int v_st(int k, int c) { const int kk = (k & ~0xC) | ((k & 4) << 1) | ((k & 8) >> 1); return ((kk >> 3) * 4 + (c >> 5)) * 512 + ((kk & 7) * 32 + (c & 31)) * 2; }
__device__ __forceinline__ int v_rd_base(int lane) { return ((lane & 3) << 3) | (((lane >> 2) & 3) << 6) | (((lane >> 4) & 1) << 5) | (((lane >> 5) & 1) << 8); }
constexpr int v_rd_off(int d0, int ks, int half) { return d0 * 512 + ks * 4096 + half * 2048; }
template <int OFF> __device__ __forceinline__ s16x4 tr_read(int vb) {
  s16x4 r; asm volatile("ds_read_b64_tr_b16 %0, %1 offset:%2" : "=&v"(r) : "v"(vb), "i"(OFF) : "memory"); return r;
}
template <int D0> __device__ __forceinline__ void pv_one(f32x16& od, int vb, bf16x8 pa0, bf16x8 pa1, bf16x8 pa2, bf16x8 pa3) {
  const s16x4 l0 = tr_read<v_rd_off(D0, 0, 0)>(vb), h0 = tr_read<v_rd_off(D0, 0, 1)>(vb), l1 = tr_read<v_rd_off(D0, 1, 0)>(vb), h1 = tr_read<v_rd_off(D0, 1, 1)>(vb);
  const s16x4 l2 = tr_read<v_rd_off(D0, 2, 0)>(vb), h2 = tr_read<v_rd_off(D0, 2, 1)>(vb), l3 = tr_read<v_rd_off(D0, 3, 0)>(vb), h3 = tr_read<v_rd_off(D0, 3, 1)>(vb);
  asm volatile("s_waitcnt lgkmcnt(0)" ::: "memory"); SBAR();
#define PK(L, H) (bf16x8){L[0], L[1], L[2], L[3], H[0], H[1], H[2], H[3]}
  od = __builtin_amdgcn_mfma_f32_32x32x16_bf16(pa0, PK(l0, h0), od, 0, 0, 0);
  od = __builtin_amdgcn_mfma_f32_32x32x16_bf16(pa1, PK(l1, h1), od, 0, 0, 0);
  od = __builtin_amdgcn_mfma_f32_32x32x16_bf16(pa2, PK(l2, h2), od, 0, 0, 0);
  od = __builtin_amdgcn_mfma_f32_32x32x16_bf16(pa3, PK(l3, h3), od, 0, 0, 0);
#undef PK
}
__device__ __forceinline__ void pv_d0(f32x16* o, int vb, bf16x8 pa0, bf16x8 pa1, bf16x8 pa2, bf16x8 pa3) {
  pv_one<0>(o[0], vb, pa0, pa1, pa2, pa3); pv_one<1>(o[1], vb, pa0, pa1, pa2, pa3); pv_one<2>(o[2], vb, pa0, pa1, pa2, pa3); pv_one<3>(o[3], vb, pa0, pa1, pa2, pa3);
}
__device__ __forceinline__ void attn_dense_body(const bf16_t* __restrict__ Qb, const bf16_t* __restrict__ Kh, const bf16_t* __restrict__ Vh,
                                                bf16_t* __restrict__ Ob, int seq, char* lds, int tid) {
  const int wid = tid >> 6, lane = tid & 63, r32 = lane & 31, hi = lane >> 5;
  bf16_t* V_lds = (bf16_t*)lds; bf16_t* K_lds = (bf16_t*)(lds + 2 * SHM_V);
  float* ws = (float*)(lds + 2 * SHM_V + 2 * SHM_K) + wid * 64; float* li_l = ws; float* al_l = ws + 32;
  float m_reg = -1e30f, l_reg = 0; f32x16 o[4] = {}; bf16x8 qr[8];
  const bf16_t* Qw = Qb + (long)(wid * QBLK + r32) * LDQ + hi * 8;
#pragma unroll
  for (int d0 = 0; d0 < 8; ++d0) qr[d0] = ld8(Qw + d0 * 16);
  const int sr = tid >> 4, sc = (tid & 15) * 8, vst0 = v_st(sr, sc), vst1 = v_st(32 + sr, sc);
  const int vb0 = (int)(uintptr_t)V_lds + v_rd_base(lane);
  struct { bf16x8 vs0, vs1, ks0, ks1; } sr_[SDEPTH];
#define SLOAD(i, k0) do { sr_[i].vs0 = ld8(&Vh[(long)((k0) + sr) * LDK + sc]); sr_[i].vs1 = ld8(&Vh[(long)((k0) + 32 + sr) * LDK + sc]); \
    sr_[i].ks0 = ld8(&Kh[(long)((k0) + sr) * LDK + sc]); sr_[i].ks1 = ld8(&Kh[(long)((k0) + 32 + sr) * LDK + sc]); } while (0)
#define SWRITE(b, i) do { *(bf16x8*)((char*)V_lds + (b) * SHM_V + vst0) = sr_[i].vs0;          \
    *(bf16x8*)((char*)V_lds + (b) * SHM_V + vst1) = sr_[i].vs1; int kc = sc * 2;               \
    *(bf16x8*)((char*)K_lds + (b) * SHM_K + KSWZ(sr, kc)) = sr_[i].ks0;                       \
    *(bf16x8*)((char*)K_lds + (b) * SHM_K + KSWZ(32 + sr, kc)) = sr_[i].ks1; } while (0)
#define SWAIT() do { if constexpr (SDEPTH == 2) asm volatile("s_waitcnt vmcnt(4)" ::: "memory"); else asm volatile("s_waitcnt vmcnt(0)" ::: "memory"); } while (0)
#define RESC(a) do { if (__any((a) < 1.f)) { if (hi == 0) al_l[r32] = (a); asm volatile("s_waitcnt lgkmcnt(0)" ::: "memory"); \
    for (int d = 0; d < 4; ++d) for (int r = 0; r < 16; ++r) o[d][r] *= al_l[crow(r, hi)]; } } while (0)
  f32x16 pA0, pA1, pB0, pB1; float mnA, mnB, alA, alB; bf16x8 pa0, pa1, pa2, pa3; const int NT = seq / KVBLK;
  constexpr int SE = 0, SO = SDEPTH - 1;
  SLOAD(SE, 0); asm volatile("s_waitcnt vmcnt(0)" ::: "memory"); SWRITE(0, SE); __syncthreads();
  qkt(pA0, pA1, K_lds, qr, r32, hi); partialSM(pA0, pA1, m_reg, mnA, alA);
  SLOAD(SO, KVBLK); if constexpr (SDEPTH == 2) { if (2 < NT) SLOAD(SE, 2 * KVBLK); }
  SWAIT(); SWRITE(1, SO); __syncthreads();
  for (int j = 1; j + 1 < NT; j += 2) {
    SBAR(); qkt(pB0, pB1, (bf16_t*)((char*)K_lds + SHM_K), qr, r32, hi);
    finishSM(pA0, pA1, alA, l_reg, pa0, pa1, pa2, pa3); SBAR();
    SLOAD(SO, (j + SDEPTH) * KVBLK); SBAR();
    pv_d0(o, vb0, pa0, pa1, pa2, pa3); partialSM(pB0, pB1, m_reg, mnB, alB);
    __syncthreads(); SWAIT(); SWRITE(0, SE);
    RESC(alB); __syncthreads();
    SBAR(); qkt(pA0, pA1, K_lds, qr, r32, hi);
    finishSM(pB0, pB1, alB, l_reg, pa0, pa1, pa2, pa3); SBAR();
    if (SDEPTH == 1 || j + 3 < NT) SLOAD(SE, (j + 1 + SDEPTH) * KVBLK); SBAR();
    pv_d0(o, vb0 + (int)SHM_V, pa0, pa1, pa2, pa3); partialSM(pA0, pA1, m_reg, mnA, alA);
    __syncthreads(); SWAIT(); SWRITE(1, SO);
    RESC(alA); __syncthreads();
  }
  SBAR(); qkt(pB0, pB1, (bf16_t*)((char*)K_lds + SHM_K), qr, r32, hi);
  finishSM(pA0, pA1, alA, l_reg, pa0, pa1, pa2, pa3); SBAR();
  pv_d0(o, vb0, pa0, pa1, pa2, pa3); partialSM(pB0, pB1, m_reg, mnB, alB);
  __syncthreads(); RESC(alB);
  finishSM(pB0, pB1, alB, l_reg, pa0, pa1, pa2, pa3); SBAR();
  pv_d0(o, vb0 + (int)SHM_V, pa0, pa1, pa2, pa3);
  if (hi == 0) li_l[r32] = l_reg; asm volatile("s_waitcnt lgkmcnt(0)" ::: "memory");
  float rli[16];
#pragma unroll
  for (int r = 0; r < 16; ++r) rli[r] = __builtin_amdgcn_rcpf(li_l[crow(r, hi)]);
  bf16_t* Ow = Ob + (long)(wid * QBLK) * LDO;
#pragma unroll
  for (int r = 0; r < 16; ++r) { int orow = crow(r, hi);
    for (int d0 = 0; d0 < 4; ++d0) Ow[(long)orow * LDO + d0 * 32 + r32] = f2bf(o[d0][r] * rli[r]); }
#undef SLOAD
#undef SWRITE
#undef SWAIT
#undef RESC
}
}

__device__ __forceinline__ void phase_modtab(Frame& F) {
    LAS float* sc = (LAS float*)F.lds;
    for (int i = F.tid; i < 3 * DM; i += NTHREADS) { const int s = i / DM, k = i - s * DM; const float c = s < 2 ? F.in[I_C][s * DM + k] : F.in[I_CCTX][k]; sc[i] = silu_f(c); }
    __syncthreads();
    const int gid = F.bid * NTHREADS + F.tid;
    if (gid < 2 * 9216) {
        const int l = gid / 9216, n = gid - l * 9216; const float* w = F.in[I_WMOD] + (size_t)l * DM * 9216 + n;
        const float bm = F.in[I_BMOD][l * 9216 + n]; float a0 = bm, a1 = bm, a2 = bm;
#pragma unroll 8
        for (int k = 0; k < DM; ++k) { const float wv = w[(size_t)k * 9216]; a0 = fmaf(sc[k], wv, a0); a1 = fmaf(sc[DM + k], wv, a1); a2 = fmaf(sc[2 * DM + k], wv, a2); }
        F_MT[(l * 3 + 0) * 9216 + n] = a0; F_MT[(l * 3 + 1) * 9216 + n] = a1; F_MT[(l * 3 + 2) * 9216 + n] = a2;
    }
    __syncthreads();
}
__device__ __forceinline__ void phase_norm(Frame& F, int l, int which, bool from_input, bool skip_ctx) {
    const float* g = F.in[I_NORMG] + (l * 3 + which) * DM;
    const float* src = from_input ? F.in[I_X] : F.out; const long dsrc = from_input ? F.dcin : F.dxc;
    const int gw = F.bid * 8 + F.wave, NGW = F.G * 8;
    for (int r = gw; r < TT; r += NGW) {
        bool isctx; const long o = xoff(r, dsrc, isctx); if (skip_ctx && isctx) continue;
        const int s = isctx ? 2 : r / TB;
        const float* sh = F_MT + ((l * 3 + s) * 9 + which * 3 + 0) * DM; const float* sc = sh + DM;
        f32x4 v[4]; float ss = 0.f;
#pragma unroll
        for (int j = 0; j < 4; ++j) { v[j] = *(const f32x4*)(src + o + j * 256 + F.lane * 4); ss += (v[j][0] * v[j][0] + v[j][1] * v[j][1]) + (v[j][2] * v[j][2] + v[j][3] * v[j][3]); }
        const float rstd = 1.0f / sqrtf(wave_sum(ss) * (1.f / DM) + NEPS);
#pragma unroll
        for (int j = 0; j < 4; ++j) { const int c = j * 256 + F.lane * 4; const f32x4 gv = *(const f32x4*)(g + c), shv = *(const f32x4*)(sh + c), scv = *(const f32x4*)(sc + c);
            unsigned w0, w1; { const float a = v[j][0] * rstd * gv[0] * (1.f + scv[0]) + shv[0], b = v[j][1] * rstd * gv[1] * (1.f + scv[1]) + shv[1]; w0 = (unsigned)f2bf(a) | ((unsigned)f2bf(b) << 16); }
            { const float a = v[j][2] * rstd * gv[2] * (1.f + scv[2]) + shv[2], b = v[j][3] * rstd * gv[3] * (1.f + scv[3]) + shv[3]; w1 = (unsigned)f2bf(a) | ((unsigned)f2bf(b) << 16); }
            *(uint2*)(F_HN + (size_t)r * DM + c) = make_uint2(w0, w1); }
    }
}
__device__ __forceinline__ void phase_conv(Frame& F, int b) {
    const int gw = F.bid * 8 + F.wave, NGW = F.G * 8;
    for (int it = gw; it < TB * 36; it += NGW) {
        const int u = it / 36, grp = it - u * 36; const int c0 = grp * 128 + F.lane * 2;
        const int seg_lo = u < CTXL ? 0 : CTXL, seg_hi = u < CTXL ? CTXL : TB;
        const bool ssd = c0 < 1536; const float* cw = ssd ? F.in[I_SCONVW] : F.in[I_GCONVW]; const int cc = ssd ? c0 : c0 - 1536, cn = ssd ? 1536 : 3072;
        float a0 = ssd ? F.in[I_SCONVB][cc] : 0.f, a1 = ssd ? F.in[I_SCONVB][cc + 1] : 0.f;
#pragma unroll
        for (int i = 0; i < 5; ++i) { const int uu = u + i - 2; if (uu >= seg_lo && uu < seg_hi) { const unsigned w = *(const unsigned*)(F_ABP + (size_t)uu * 6656 + 1024 + c0);
                a0 = fmaf(cw[i * cn + cc], bflo(w), a0); a1 = fmaf(cw[i * cn + cc + 1], bfhi(w), a1); } }
        a0 = silu_f(a0); a1 = silu_f(a1);
        if (grp >= 12 && grp < 28) { const float ss = wave_sum(a0 * a0 + a1 * a1); float sc = 1.0f / sqrtf(ss + NEPS); if (grp < 20) sc *= 0.08838834764831845f; a0 *= sc; a1 *= sc; }
        *(unsigned*)(F_CV + (size_t)u * 4608 + c0) = (unsigned)f2bf(a0) | ((unsigned)f2bf(a1) << 16);
    }
    for (int i = F.bid * NTHREADS + F.tid; i < TB * 64; i += F.G * NTHREADS) {
        const int j = i & 63; float v = F_ABS[i];
        if (j < 32) v = softplus_f(v + F.in[I_SDTB][j]);
        else if (j < 48) v = sigmoid_f(v);
        else v = -__expf(F.in[I_GALOG][j - 48]) * softplus_f(v + F.in[I_GDTB][j - 48]);
        F_ABS[i] = v;
    }
}
__device__ __forceinline__ int scan_tok(int dir, int i) { return dir == 0 ? i : (i < CTXL ? CTXL - 1 - i : TB + CTXL - 1 - i); }
__device__ __forceinline__ void ssd_naive(Frame& F, int head) {
    const int p = F.tid >> 3, nq = F.tid & 7, g = head >> 3;
    for (int dir = 0; dir < 2; ++dir) {
        const float a = -__expf(F.in[I_SALOG][dir * 16 + head]);
        float S[16];
#pragma unroll
        for (int j = 0; j < 16; ++j) S[j] = 0.f;
        for (int i = 0; i < TB; ++i) {
            const int u = scan_tok(dir, i); const bf16_t* row = F_CV + (size_t)u * 4608;
            const float x = bf2f(row[head * 64 + p]), dt = F_ABS[u * 64 + dir * 16 + head];
            const u32x4 b0 = *(const u32x4*)(row + 1024 + g * 128 + nq * 16), b1 = *(const u32x4*)(row + 1024 + g * 128 + nq * 16 + 8);
            const u32x4 c0 = *(const u32x4*)(row + 1280 + g * 128 + nq * 16), c1 = *(const u32x4*)(row + 1280 + g * 128 + nq * 16 + 8);
            const float dA = __expf(dt * a), xdt = x * dt; float y = 0.f;
#pragma unroll
            for (int j = 0; j < 4; ++j) {
                S[2 * j] = fmaf(S[2 * j], dA, xdt * bflo(b0[j])); y = fmaf(bflo(c0[j]), S[2 * j], y);
                S[2 * j + 1] = fmaf(S[2 * j + 1], dA, xdt * bfhi(b0[j])); y = fmaf(bfhi(c0[j]), S[2 * j + 1], y);
                S[8 + 2 * j] = fmaf(S[8 + 2 * j], dA, xdt * bflo(b1[j])); y = fmaf(bflo(c1[j]), S[8 + 2 * j], y);
                S[8 + 2 * j + 1] = fmaf(S[8 + 2 * j + 1], dA, xdt * bfhi(b1[j])); y = fmaf(bfhi(c1[j]), S[8 + 2 * j + 1], y); }
            y += __shfl_xor(y, 1); y += __shfl_xor(y, 2); y += __shfl_xor(y, 4);
            if (nq == 0) { bf16_t* yp = F_YACC + (size_t)u * 2048 + head * 64 + p; *yp = f2bf(dir ? bf2f(*yp) + y : y); }
        }
    }
}
__device__ __forceinline__ void gdn_naive(Frame& F, int h) {
    const int e = F.tid >> 2, dq = F.tid & 3;
    for (int dir = 0; dir < 2; ++dir) {
        float S[32];
#pragma unroll
        for (int j = 0; j < 32; ++j) S[j] = 0.f;
        for (int i = 0; i < TB; ++i) {
            const int u = scan_tok(dir, i); const bf16_t* row = F_CV + (size_t)u * 4608;
            const float v = bf2f(row[3584 + h * 128 + e]), beta = F_ABS[u * 64 + 32 + dir * 8 + h], eg = __expf(F_ABS[u * 64 + 48 + dir * 8 + h]);
            u32x4 kk[4], qq[4];
#pragma unroll
            for (int j = 0; j < 4; ++j) { kk[j] = *(const u32x4*)(row + 2560 + h * 128 + dq * 32 + j * 8); qq[j] = *(const u32x4*)(row + 1536 + h * 128 + dq * 32 + j * 8); }
            float ks = 0.f;
#pragma unroll
            for (int j = 0; j < 4; ++j)
#pragma unroll
                for (int w = 0; w < 4; ++w) { ks = fmaf(bflo(kk[j][w]), S[j * 8 + 2 * w], ks); ks = fmaf(bfhi(kk[j][w]), S[j * 8 + 2 * w + 1], ks); }
            ks += __shfl_xor(ks, 1); ks += __shfl_xor(ks, 2);
            const float vn = beta * (v - eg * ks); float o = 0.f;
#pragma unroll
            for (int j = 0; j < 4; ++j)
#pragma unroll
                for (int w = 0; w < 4; ++w) {
                    S[j * 8 + 2 * w] = fmaf(eg, S[j * 8 + 2 * w], bflo(kk[j][w]) * vn); o = fmaf(bflo(qq[j][w]), S[j * 8 + 2 * w], o);
                    S[j * 8 + 2 * w + 1] = fmaf(eg, S[j * 8 + 2 * w + 1], bfhi(kk[j][w]) * vn); o = fmaf(bfhi(qq[j][w]), S[j * 8 + 2 * w + 1], o); }
            o += __shfl_xor(o, 1); o += __shfl_xor(o, 2);
            if (dq == 0) { bf16_t* yp = F_YACC + (size_t)u * 2048 + 1024 + h * 128 + e; *yp = f2bf(dir ? bf2f(*yp) + o : o); }
        }
    }
}
__device__ __forceinline__ void phase_finish(Frame& F, int b) {
    const int gw = F.bid * 8 + F.wave, NGW = F.G * 8;
    for (int it = gw; it < TB * 10; it += NGW) {
        const int u = it / 10, k = it - u * 10;
        if (k < 2) {
            const int c0 = k * 512 + F.lane * 8; float y[8]; float ss = 0.f;
#pragma unroll
            for (int j = 0; j < 8; ++j) { const int c = c0 + j; const float xs = bf2f(F_CV[(size_t)u * 4608 + c]), z = bf2f(F_ABP[(size_t)u * 6656 + c]);
                y[j] = (bf2f(F_YACC[(size_t)u * 2048 + c]) + xs * F.in[I_SD][c >> 6]) * silu_f(z); ss += y[j] * y[j]; }
            const float rstd = 1.0f / sqrtf(wave_sum(ss) * (1.f / 512.f) + NEPS);
#pragma unroll
            for (int j = 0; j < 8; ++j) F_Y[(size_t)u * 2048 + c0 + j] = f2bf(y[j] * rstd * F.in[I_SNORM][c0 + j]);
        } else {
            const int h = k - 2, e0 = F.lane * 2; float y[2]; float ss = 0.f;
#pragma unroll
            for (int j = 0; j < 2; ++j) { y[j] = bf2f(F_YACC[(size_t)u * 2048 + 1024 + h * 128 + e0 + j]); ss += y[j] * y[j]; }
            const float rstd = 1.0f / sqrtf(wave_sum(ss) * (1.f / 128.f) + NEPS);
#pragma unroll
            for (int j = 0; j < 2; ++j) { const float gt = bf2f(F_ABP[(size_t)u * 6656 + 5632 + h * 128 + e0 + j]);
                F_Y[(size_t)u * 2048 + 1024 + h * 128 + e0 + j] = f2bf(y[j] * rstd * F.in[I_GNORM][e0 + j] * silu_f(gt)); }
        }
    }
}
__device__ __forceinline__ void phase_qknorm_rope(Frame& F) {
    const int gw = F.bid * 8 + F.wave, NGW = F.G * 8;
    const int j = F.lane; const float invf = exp2f(-(float)(j & 31) * (13.287712379549449f / 32.f));
    for (int it = gw; it < TT * 12; it += NGW) {
        const int r = it / 12, hs = it - r * 12; const int b = r / TB, u = r - b * TB; const bool isctx = u < CTXL;
        if (isctx && hs < 8) continue;
        bf16_t* p = F_QKV + (size_t)r * 2048 + hs * 128; const float* w = hs < 8 ? F.in[I_QNORM] : F.in[I_KNORM];
        const float x1 = bf2f(p[j]), x2 = bf2f(p[j + 64]);
        const float rstd = 1.0f / sqrtf(wave_sum(x1 * x1 + x2 * x2) * (1.f / 128.f) + NEPS);
        float n1 = x1 * rstd * w[j], n2 = x2 * rstd * w[j + 64];
        if (!isctx) { const int t = u - CTXL; const float pos = (float)(j < 32 ? (t >> 6) : (t & 63)); const float ang = pos * invf;
            const float rev = ang * 0.15915494309189535f; const float fr = rev - rintf(rev);
            const float cs = __builtin_amdgcn_cosf(fr), sn = __builtin_amdgcn_sinf(fr);
            const float o1 = n1 * cs - n2 * sn, o2 = n2 * cs + n1 * sn; n1 = o1; n2 = o2; }
        p[j] = f2bf(n1); p[j + 64] = f2bf(n2);
    }
}
__device__ __forceinline__ void phase_attention(Frame& F) {
    for (int un = F.bid; un < 512; un += F.G) {
        const int qb = un & 31, hq = (un >> 5) & 7, b = un >> 8, kh = hq >> 1;
        const bf16_t* Qb = F_QKV + (size_t)(b * TB + CTXL + qb * 256) * 2048 + hq * 128;
        const bf16_t* Kh = F_QKV + (size_t)(b * TB) * 2048 + 1024 + kh * 128;
        const bf16_t* Vh = F_QKV + (size_t)(b * TB) * 2048 + 1536 + kh * 128;
        bf16_t* Ob = F_AO + (size_t)(b * TB + CTXL + qb * 256) * DM + hq * 128;
        att::attn_dense_body(Qb, Kh, Vh, Ob, TB, (char*)F.ldsg, F.tid);
        __syncthreads();
    }
}

constexpr int LDS_BYTES = 147456;
constexpr int MISC_OFF = 131072;

__global__ void __launch_bounds__(NTHREADS, 2) mk_fwd(Args args) {
    extern __shared__ __attribute__((aligned(16))) unsigned char lds_raw[];
    Frame F;
    F.in = args.in; F.out = args.out; F.ws = args.ws; F.dxc = (float*)(args.ws + WS_XC) - args.out; F.dcin = args.in[I_CTX] - args.in[I_X];
    F.lds = (LAS unsigned char*)lds_raw; F.ldsg = lds_raw;
    F.tid = threadIdx.x; F.lane = F.tid & 63; F.wave = __builtin_amdgcn_readfirstlane(F.tid >> 6); F.G = gridDim.x; F.bid = blockIdx.x;
    volatile LAS unsigned* MISC = (volatile LAS unsigned*)(F.lds + MISC_OFF);
    if (F.tid < 64) MISC[F.tid] = 0u;
    __syncthreads();
    XcdBarrier bar = xcd_barrier_post((unsigned*)(args.ws + WS_CTL), MISC + 8);
    const int lo = args.ph_lo, hi = args.ph_hi; int ph = 0;
#define PH_BEGIN if (ph >= lo && ph < hi) { F.tid = threadIdx.x; asm volatile("" : "+v"(F.tid)); F.lane = F.tid & 63; F.wave = __builtin_amdgcn_readfirstlane(F.tid >> 6);
#define PH_END   if (ph + 1 < hi) xcd_barrier(bar); } ++ph;

    PH_BEGIN phase_modtab(F); PH_END
    unsigned char* wb = F.ws + WS_W;
#define GEMM(EPI, A_, B_, K_, nM_, nN_, pm0_, mode_) do { pg8::Gemm g_{(const bf16_t*)(A_), (const bf16_t*)(B_), (K_)}; pg8::Order S_; S_.init((nM_), (nN_), F.G, F.bid, (pm0_), (mode_)); pg8::gemm_phase(F.lds, g_, S_, EPI, F.tid); } while (0)
    for (int l = 0; l < 2; ++l) {
        const float* mt = F_MT + l * 3 * 9216;
        PH_BEGIN phase_convert(F, l); phase_norm(F, l, 0, l == 0, false); PH_END
        PH_BEGIN { pg8::EpiSwigluP E{F_HID}; GEMM(E, F_HN, wb + W_FFIN0, DM, 66, 22, 0, 0); } PH_END
        PH_BEGIN { pg8::EpiResidP E{l == 0 ? F.in[I_X] : F.out, l == 0 ? F.dcin : F.dxc, F.out, F.dxc, mt, 2, 0.5f}; GEMM(E, F_HID, wb + W_FFOUT0, DFF, 66, 4, 0, 0); } PH_END
        PH_BEGIN phase_norm(F, l, 1, false, false); PH_END
        if (l == 0) {
            for (int b = 0; b < NBATCH; ++b) {
                PH_BEGIN { pg8::EpiABP E{F_ABP, F_ABS, b * TB}; GEMM(E, F_HN, wb + W_MIXIN, DM, 33, 27, b * 33, 0); } PH_END
                PH_BEGIN phase_conv(F, b); PH_END
#ifndef NO_SCAN
                PH_BEGIN { if (F.bid < 16) ssd_naive(F, F.bid); else if (F.bid < 24) gdn_naive(F, F.bid - 16); } PH_END
#endif
                PH_BEGIN phase_finish(F, b); PH_END
                PH_BEGIN { pg8::EpiResidP E{F.out, F.dxc, F.out, F.dxc, mt, 5, 1.0f}; GEMM(E, F_Y - (size_t)b * TB * 2048, wb + W_MIXOUT, 2048, 33, 4, b * 33, 0); } PH_END
            }
        } else {
            PH_BEGIN { pg8::EpiBf16P E{F_QKV, 2048}; GEMM(E, F_HN, wb + W_MIXIN, DM, 66, 8, 0, 0); } PH_END
            PH_BEGIN phase_qknorm_rope(F); PH_END
#ifndef NO_ATT
            PH_BEGIN phase_attention(F); PH_END
#endif
            PH_BEGIN { pg8::EpiResidP E{F.out, F.dxc, F.out, F.dxc, mt, 5, 1.0f}; GEMM(E, F_AO, wb + W_MIXOUT, DM, 64, 4, 0, 1); } PH_END
        }
        const bool skipc = (l == 1);
        PH_BEGIN phase_norm(F, l, 2, false, skipc); PH_END
        PH_BEGIN { pg8::EpiSwigluP E{F_HID}; GEMM(E, F_HN, wb + W_FFIN1, DM, skipc ? 64 : 66, 22, 0, skipc ? 1 : 0); } PH_END
        PH_BEGIN { pg8::EpiResidP E{F.out, F.dxc, F.out, F.dxc, mt, 8, 0.5f}; GEMM(E, F_HID, wb + W_FFOUT1, DFF, skipc ? 64 : 66, 4, 0, skipc ? 1 : 0); } PH_END
    }
#undef GEMM
#undef PH_BEGIN
#undef PH_END
}

extern "C" void kernel_launch(void* const* d_in, const int* in_sizes, int n_in, void* d_out, int out_size, void* d_ws, size_t ws_size, hipStream_t stream) {
    static int grid = 0;
    if (grid == 0) {
        if (n_in != 25 || out_size != NBATCH * SEQ * DM || ws_size < WS_END) { fprintf(stderr, "kernel_launch: unexpected shapes (n_in %d out %d ws %zu need %zu)\n", n_in, out_size, ws_size, (size_t)WS_END); grid = -1; return; }
        int dev = 0, cus = 0, per_cu = 0;
        if (hipGetDevice(&dev) != hipSuccess || hipDeviceGetAttribute(&cus, hipDeviceAttributeMultiprocessorCount, dev) != hipSuccess) { grid = -1; return; }
        if (hipFuncSetAttribute((const void*)mk_fwd, hipFuncAttributeMaxDynamicSharedMemorySize, LDS_BYTES) != hipSuccess) { fprintf(stderr, "kernel_launch: hipFuncSetAttribute failed\n"); grid = -1; return; }
        if (hipOccupancyMaxActiveBlocksPerMultiprocessor(&per_cu, (const void*)mk_fwd, NTHREADS, LDS_BYTES) != hipSuccess || per_cu < 1) { fprintf(stderr, "kernel_launch: occupancy query says %d blocks per CU\n", per_cu); grid = -1; (void)hipGetLastError(); return; }
        grid = cus;
    }
    if (grid < 0) return;
    (void)hipMemsetAsync((char*)d_ws + WS_CTL, 0, CTL_BYTES, stream);
    Args a{};
    for (int i = 0; i < 25; ++i) a.in[i] = (const float*)d_in[i];
    a.out = (float*)d_out; a.ws = (unsigned char*)d_ws; a.ph_lo = 0; a.ph_hi = 1000;
    hipLaunchKernelGGL(mk_fwd, dim3(grid), dim3(NTHREADS), LDS_BYTES, stream, a);
    const hipError_t le = hipPeekAtLastError();
    if (le != hipSuccess) fprintf(stderr, "kernel_launch: launch failed: %s\n", hipGetErrorName(le));
}
```

```cpp
#include <hip/hip_runtime.h>
#include <cstdio>
#include <cstdint>

#define LAS __attribute__((address_space(3)))
typedef unsigned short bf16_t;
typedef short bf16x8 __attribute__((ext_vector_type(8)));
typedef short s16x4 __attribute__((ext_vector_type(4)));
typedef float f32x4 __attribute__((ext_vector_type(4)));
typedef float f32x8 __attribute__((ext_vector_type(8)));
typedef float f32x16 __attribute__((ext_vector_type(16)));
typedef unsigned u32x4 __attribute__((ext_vector_type(4)));
typedef unsigned u32x2 __attribute__((ext_vector_type(2)));

#define DEBUG_SSD 0
#define DEBUG_GDN 0
#if DEBUG_SSD || DEBUG_GDN
#define NO_ATT 1
#endif
constexpr int DM = 1024, NBATCH = 2, SEQ = 8192, CTXL = 256, TB = SEQ + CTXL  , TT = NBATCH * TB, DFF = 2816;
constexpr int NTHREADS = 512;
constexpr float NEPS = 1e-6f;

constexpr size_t AL(size_t x) { return (x + 255) / 256 * 256; }
constexpr size_t WS_CTL = 0;
constexpr size_t CTL_BYTES = 65536;
constexpr size_t WS_MT = WS_CTL + CTL_BYTES;
constexpr size_t WS_XC = WS_MT + AL((size_t)2 * 3 * 9216 * 4);
constexpr size_t WS_HN = WS_XC + AL((size_t)2 * CTXL * DM * 4);
constexpr size_t WS_W  = WS_HN + AL((size_t)TT * DM * 2);
constexpr size_t W_FFIN0 = 0, W_FFOUT0 = W_FFIN0 + (size_t)2 * DFF * DM * 2, W_FFIN1 = W_FFOUT0 + (size_t)DM * DFF * 2, W_FFOUT1 = W_FFIN1 + (size_t)2 * DFF * DM * 2,
                 W_MIXIN = W_FFOUT1 + (size_t)DM * DFF * 2, W_MIXOUT = W_MIXIN + (size_t)6912 * DM * 2, W_BYTES = W_MIXOUT + (size_t)DM * 2048 * 2;
constexpr size_t WS_AR = WS_W + AL(W_BYTES);
constexpr size_t AR_HID = WS_AR;
constexpr size_t AR_ZG  = WS_AR;
constexpr size_t AR_RAW = AR_ZG + AL((size_t)TB * 2048 * 2);
constexpr size_t AR_YD  = AR_RAW;
constexpr size_t AR_Y   = AR_YD;
constexpr size_t AR_ABS = AR_RAW + AL((size_t)TB * 4608 * 2);
constexpr size_t AR_CV  = AR_ABS + AL((size_t)TB * 64 * 4);
constexpr size_t AR_CB  = AR_CV + AL((size_t)TB * 4608 * 2);
constexpr size_t AR_GT  = AR_CB + AL((size_t)2 * 66 * 128 * 128 * 2);
constexpr size_t GT_STRIDE = 8192 + 8192 + 768;
constexpr size_t AR_END0 = AR_GT + AL((size_t)8 * 2 * 132 * GT_STRIDE);
constexpr size_t WS_DBG = 0;
constexpr size_t AR_QKV = WS_AR;
constexpr size_t AR_AO  = AR_QKV + AL((size_t)TT * 2048 * 2);
constexpr size_t AR_END1 = AR_AO + AL((size_t)TT * DM * 2);
constexpr size_t WS_END0 = AR_END0 > AR_END1 ? AR_END0 : AR_END1;
constexpr size_t WS_TEST = WS_END0;
constexpr size_t WS_END = WS_END0 + (DEBUG_GDN ? AL((size_t)2 * TB * 1024 * 2) : 0);

__device__ __forceinline__ bf16_t f2bf(float f) { unsigned u = __float_as_uint(f); u += 0x7fffu + ((u >> 16) & 1u); return (bf16_t)(u >> 16); }
__device__ __forceinline__ unsigned pk2(float lo, float hi) { return (unsigned)f2bf(lo) | ((unsigned)f2bf(hi) << 16); }
__device__ __forceinline__ float bf2f(bf16_t b) { return __uint_as_float(((unsigned)b) << 16); }
__device__ __forceinline__ float bflo(unsigned w) { return __uint_as_float(w << 16); }
__device__ __forceinline__ float bfhi(unsigned w) { return __uint_as_float(w & 0xffff0000u); }
__device__ __forceinline__ float silu_f(float x) { return x / (1.f + __expf(-x)); }
__device__ __forceinline__ float softplus_f(float x) { return fmaxf(x, 0.f) + log1pf(__expf(-fabsf(x))); }
__device__ __forceinline__ float sigmoid_f(float x) { return 1.f / (1.f + __expf(-x)); }
__device__ __forceinline__ float wave_sum(float v) {
#pragma unroll
    for (int o = 1; o < 64; o <<= 1) v += __shfl_xor(v, o);
    return v;
}

#define XB_TMO      128
#define XB_XCNT(j)  (256  + 64 * (j))
#define XB_XSUB(j)  (1280 + 64 * (j))
#define XB_XGEN(j)  (2304 + 64 * (j))
#define XB_TOP      3328
#define XB_TOPGEN   3392
#define XCD_BAR_WORDS 3456
#define XB_SPIN_CAP (1u << 24)
__device__ __forceinline__ unsigned xb_ld(unsigned* p)              { return __hip_atomic_load(p, __ATOMIC_RELAXED, __HIP_MEMORY_SCOPE_AGENT); }
__device__ __forceinline__ unsigned xb_add(unsigned* p, unsigned v) { return __hip_atomic_fetch_add(p, v, __ATOMIC_RELAXED, __HIP_MEMORY_SCOPE_AGENT); }
__device__ __forceinline__ unsigned xb_xcc_id() { return (unsigned)__builtin_amdgcn_s_getreg((3 << 11) | 20) & 0xFu; }
#define XB_SPIN(cond, bar) do { unsigned _sp = 0; while (cond) { __builtin_amdgcn_s_sleep(1); \
    if ((++_sp & 255u) == 0u) { if (xb_ld(&(bar)[XB_TMO])) break; if (_sp > XB_SPIN_CAP) { atomicAdd(&(bar)[XB_TMO], 1u); break; } } } } while (0)
struct XcdBarrier { unsigned* bar; unsigned x; volatile LAS unsigned* st; };
__device__ __forceinline__ XcdBarrier xcd_barrier_post(unsigned* bar, volatile LAS unsigned* st) {
    XcdBarrier b; b.bar = bar; b.x = xb_xcc_id(); b.st = st;
    if (threadIdx.x == 0) (void)xb_add(&bar[XB_XCNT(b.x)], 1u);
    return b;
}
__device__ __forceinline__ void xcd_barrier_complete(unsigned* bar, unsigned x, unsigned& nloc, unsigned& nx) {
    const unsigned G = gridDim.x * gridDim.y * gridDim.z;
    unsigned sum, cnt, mine, sp = 0u;
    for (;;) {
        sum = 0u; cnt = 0u; mine = 0u;
#pragma unroll
        for (unsigned j = 0; j < 16; ++j) { const unsigned c = xb_ld(&bar[XB_XCNT(j)]); sum += c; cnt += (c > 0u) ? 1u : 0u; mine = (j == x) ? c : mine; }
        if (sum == G) break;
        __builtin_amdgcn_s_sleep(1);
        if ((++sp & 255u) == 0u) { if (xb_ld(&bar[XB_TMO])) break; if (sp > XB_SPIN_CAP) { atomicAdd(&bar[XB_TMO], 1u); break; } }
    }
    nloc = mine > 0u ? mine : 1u; nx = cnt > 0u ? cnt : 1u;
}
__device__ __forceinline__ void xcd_barrier(const XcdBarrier& b) {
    asm volatile("s_waitcnt vmcnt(0)" ::: "memory");
    __syncthreads();
    if (threadIdx.x == 0) {
        unsigned* bar = b.bar;
        __builtin_amdgcn_s_waitcnt(0);
        unsigned nloc = b.st[0], nx = b.st[1];
        if (nloc == 0u) { xcd_barrier_complete(bar, b.x, nloc, nx); b.st[0] = nloc; b.st[1] = nx; }
        const unsigned old = xb_add(&bar[XB_XSUB(b.x)], 1u);
        const unsigned gen = old / nloc;
        if (old + 1u == (gen + 1u) * nloc) {
            __builtin_amdgcn_fence(__ATOMIC_RELEASE, "agent");
            asm volatile("s_waitcnt vmcnt(0)" ::: "memory");
            const unsigned og = xb_add(&bar[XB_TOP], 1u);
            const unsigned tg = og / nx;
            if (og + 1u == (tg + 1u) * nx) xb_add(&bar[XB_TOPGEN], 1u);
            else XB_SPIN(xb_ld(&bar[XB_TOPGEN]) == tg, bar);
            __builtin_amdgcn_fence(__ATOMIC_ACQUIRE, "agent");
            xb_add(&bar[XB_XGEN(b.x)], 1u);
            asm volatile("s_waitcnt vmcnt(0)" ::: "memory");
        } else {
            XB_SPIN(xb_ld(&bar[XB_XGEN(b.x)]) == gen, bar);
            __builtin_amdgcn_fence(__ATOMIC_ACQUIRE, "agent");
            asm volatile("s_waitcnt vmcnt(0)" ::: "memory");
        }
    }
    __syncthreads();
}

struct Args { const float* in[25]; float* out; unsigned char* ws; int ph_lo, ph_hi; };
enum { I_X = 0, I_C, I_CTX, I_CCTX, I_WMOD, I_BMOD, I_NORMG, I_WFFIN, I_WFFOUT, I_ABWIN, I_SCONVW, I_SCONVB, I_SALOG, I_SDTB, I_SD, I_SNORM,
       I_GCONVW, I_GALOG, I_GDTB, I_GNORM, I_ABWOUT, I_WQKV, I_QNORM, I_KNORM, I_WO };

struct Frame {
    const float* const* in; float* out; unsigned char* ws; long dxc, dcin;
    LAS unsigned char* lds; unsigned char* ldsg;
    int tid, lane, wave, G, bid;
};
#define F_MT   ((float*)(F.ws + WS_MT))
#define F_XC   ((float*)(F.ws + WS_XC))
#define F_HN   ((bf16_t*)(F.ws + WS_HN))
#define F_HID  ((bf16_t*)(F.ws + AR_HID))
#define F_ZG   ((bf16_t*)(F.ws + AR_ZG))
#define F_RAW  ((bf16_t*)(F.ws + AR_RAW))
#define F_YD   ((bf16_t*)(F.ws + AR_YD))
#define F_CB   ((bf16_t*)(F.ws + AR_CB))
#define F_GT   ((bf16_t*)(F.ws + AR_GT))
#define F_ABS  ((float*)(F.ws + AR_ABS))
#define F_CV   ((bf16_t*)(F.ws + AR_CV))
#define F_Y    ((bf16_t*)(F.ws + AR_Y))
#define F_QKV  ((bf16_t*)(F.ws + AR_QKV))
#define F_AO   ((bf16_t*)(F.ws + AR_AO))
__device__ __forceinline__ long xoff(int r, long dctx, bool& isctx) { const int b = r / TB, u = r - b * TB; isctx = u < CTXL; return isctx ? dctx + (long)(b * CTXL + u) * DM : (long)(b * SEQ + u - CTXL) * DM; }

template <bool DUAL, class Epi>
__device__ __forceinline__ void sgemm(Frame& F, const bf16_t* A, int lda, const float* W, int ldw, int dual_off, int row0, int nrows, int N, int K, bool skip_ctx, const Epi& epi) {
    LAS bf16_t* sA = (LAS bf16_t*)F.lds; LAS bf16_t* sB = sA + 128 * 40; LAS bf16_t* sB2 = sB + 64 * 40;
    const int tid = F.tid, lane = F.lane, wid = F.wave;
    const int ntn = N / 64, ntiles = (nrows / 128) * ntn;
    for (int t = F.bid; t < ntiles; t += F.G) {
        const int tm = t / ntn, tn = t - tm * ntn, m0 = row0 + tm * 128, n0 = tn * 64;
        if (skip_ctx && (m0 % TB) < CTXL) continue;
        f32x4 acc[4], acc2[4];
#pragma unroll
        for (int j = 0; j < 4; ++j) { acc[j] = (f32x4){0.f, 0.f, 0.f, 0.f}; acc2[j] = (f32x4){0.f, 0.f, 0.f, 0.f}; }
        for (int k0 = 0; k0 < K; k0 += 32) {
            { const int r = tid >> 2, kq = (tid & 3) * 8; const u32x4 v = *(const u32x4*)(A + (size_t)(m0 + r) * lda + k0 + kq); *(LAS u32x4*)(sA + r * 40 + kq) = v; }
            { const int k = tid >> 4, n4 = (tid & 15) * 4; const f32x4 w = *(const f32x4*)(W + (size_t)(k0 + k) * ldw + n0 + n4);
              sB[(n4 + 0) * 40 + k] = f2bf(w[0]); sB[(n4 + 1) * 40 + k] = f2bf(w[1]); sB[(n4 + 2) * 40 + k] = f2bf(w[2]); sB[(n4 + 3) * 40 + k] = f2bf(w[3]);
              if (DUAL) { const f32x4 w2 = *(const f32x4*)(W + (size_t)(k0 + k) * ldw + n0 + n4 + dual_off);
                  sB2[(n4 + 0) * 40 + k] = f2bf(w2[0]); sB2[(n4 + 1) * 40 + k] = f2bf(w2[1]); sB2[(n4 + 2) * 40 + k] = f2bf(w2[2]); sB2[(n4 + 3) * 40 + k] = f2bf(w2[3]); } }
            __syncthreads();
            const bf16x8 a = *(const LAS bf16x8*)(sA + (16 * wid + (lane & 15)) * 40 + 8 * (lane >> 4));
#pragma unroll
            for (int j = 0; j < 4; ++j) { const bf16x8 b = *(const LAS bf16x8*)(sB + (16 * j + (lane & 15)) * 40 + 8 * (lane >> 4));
                acc[j] = __builtin_amdgcn_mfma_f32_16x16x32_bf16(a, b, acc[j], 0, 0, 0);
                if (DUAL) { const bf16x8 b2 = *(const LAS bf16x8*)(sB2 + (16 * j + (lane & 15)) * 40 + 8 * (lane >> 4)); acc2[j] = __builtin_amdgcn_mfma_f32_16x16x32_bf16(a, b2, acc2[j], 0, 0, 0); } }
            __syncthreads();
        }
#pragma unroll
        for (int j = 0; j < 4; ++j)
#pragma unroll
            for (int r = 0; r < 4; ++r) epi(m0 + 16 * wid + 4 * (lane >> 4) + r, n0 + 16 * j + (lane & 15), acc[j][r], acc2[j][r]);
    }
}
struct EpiSwiglu { bf16_t* hid; __device__ __forceinline__ void operator()(int r, int c, float g, float u) const { hid[(size_t)r * DFF + c] = f2bf(silu_f(g) * u); } };
struct EpiResid {
    const float* base; long dbase; float* out; long dxc; const float* mt; int gidx; float coef;
    __device__ __forceinline__ void operator()(int r, int c, float v, float) const {
        bool isctx; const long ob = xoff(r, dbase, isctx) + c; const long oo = xoff(r, dxc, isctx) + c; const int s = isctx ? 2 : r / TB;
        out[oo] = base[ob] + coef * mt[(s * 9 + gidx) * DM + c] * v;
    }
};
struct EpiAB {
    bf16_t* abp; float* abs_; int row0;
    __device__ __forceinline__ void operator()(int r, int c, float v, float) const {
        const int u = r - row0;
        if (c < 2560) abp[(size_t)u * 6656 + c] = f2bf(v);
        else if (c < 2592) abs_[u * 64 + (c - 2560)] = v;
        else if (c < 6688) abp[(size_t)u * 6656 + (c - 32)] = f2bf(v);
        else abs_[u * 64 + 32 + (c - 6688)] = v;
    }
};
struct EpiBf16Store { bf16_t* o; int ldo; __device__ __forceinline__ void operator()(int r, int c, float v, float) const { o[(size_t)r * ldo + c] = f2bf(v); } };


namespace pg8 {
constexpr int BM = 256, BK = 64, HALF = 128, HTB = HALF * BK * 2, STAGE_BYTES = 8 * HTB, NXCD = 8, WGM = 8;
__host__ __device__ __forceinline__ int lds_byte(int r, int c) { const int st = (r >> 4) * 2 + (c >> 5), rr = r & 15, cc = c & 31, ob = rr * 64 + cc * 2; return st * 1024 + (ob ^ (((ob >> 9) & 1) << 5)); }
__host__ __device__ __forceinline__ void stage_rc(int b, int& R, int& C) { const int st = b / 1024, sb = b % 1024, swz = sb ^ (((sb >> 9) & 1) << 5); R = (st >> 1) * 16 + swz / 64; C = (st & 1) * 32 + (swz % 64) / 2; }
__host__ __device__ __forceinline__ int perm32(int rho) { const int n = rho >> 4, i = rho & 15; return 8 * (i >> 2) + 4 * n + (i & 3); }
struct Unit { int pm, pn; };
struct Gemm { const bf16_t* A; const bf16_t* Bt; int K; };
struct Order {
    int nM, nN, nwg, G, c, pm0, mode;
    __device__ __forceinline__ void init(int nM_, int nN_, int G_, int c_, int pm0_, int mode_) { nM = nM_; nN = nN_; nwg = nM * nN; G = G_; c = c_; pm0 = pm0_; mode = mode_; }
    __device__ __forceinline__ bool next(int i, Unit& u) const {
        const long L = (long)i * G + c; if (L >= nwg) return false;
        int wgid = (int)L; { const int q = nwg / NXCD, r = nwg % NXCD, xcd = wgid % NXCD, off = wgid / NXCD; wgid = (xcd < r ? xcd * (q + 1) : r * (q + 1) + (xcd - r) * q) + off; }
        const int nig = WGM * nN, gid = wgid / nig, fm = gid * WGM, gsz = (nM - fm) < WGM ? (nM - fm) : WGM;
        int pm = fm + ((wgid % nig) % gsz); u.pn = (wgid % nig) / gsz;
        u.pm = mode ? (pm / 32) * 33 + 1 + (pm % 32) : pm0 + pm; return true;
    }
};
__device__ __forceinline__ unsigned cvt_pk_bf16(float lo, float hi) { unsigned r; asm volatile("v_cvt_pk_bf16_f32 %0, %1, %2" : "=v"(r) : "v"(lo), "v"(hi)); return r; }

template <class Epi>
__device__ __forceinline__ void gemm_phase(LAS unsigned char* lds, const Gemm g, const Order& S, const Epi& E, int tid) {
    const int wid = __builtin_amdgcn_readfirstlane(tid >> 6), lane = tid & 63, wr = wid >> 2, wc = wid & 3, fr = lane & 15, fq = lane >> 4;
    const int K = g.K, nt = K / BK;
    unsigned voffA[2], voffB[2];
#pragma unroll
    for (int i = 0; i < 2; ++i) { int R, C; stage_rc(tid * 16 + i * 8192, R, C); const int Rb = Epi::PERM ? ((R & ~31) + perm32(R & 31)) : R;
        voffA[i] = (unsigned)(R * K + C) * 2u; voffB[i] = (unsigned)(Rb * K + C) * 2u; }
    const size_t kstep = (size_t)(BK * 2);
    const size_t hstep = (size_t)HALF * K * 2;
    const size_t tstep = 2 * hstep;
    const unsigned ldsw = (unsigned)wid * 1024u;
    const int aoff = lds_byte(wr * 64 + fr, fq * 8), boff = lds_byte(wc * 32 + fr, fq * 8);
#define PG8_SA(b, h) (((b) * 2 + (h)) * HTB)
#define PG8_SB(b, h) ((4 + (b) * 2 + (h)) * HTB)
#define PG8_STAGE(bufoff, gbase, voff) do { _Pragma("unroll") for (int _i = 0; _i < 2; ++_i) \
        __builtin_amdgcn_global_load_lds((const unsigned*)((const char*)(gbase) + (voff)[_i]), (LAS unsigned*)(lds + (bufoff) + ldsw + _i * 8192), 16, 0, 0); } while (0)
#define PG8_LDA(dst, b, h) do { _Pragma("unroll") for (int m = 0; m < 4; ++m) _Pragma("unroll") for (int k = 0; k < 2; ++k) dst[m][k] = *(const LAS bf16x8*)(lds + PG8_SA(b, h) + aoff + m * 2048 + k * 1024); } while (0)
#define PG8_LDB(dst, b, h) do { _Pragma("unroll") for (int n = 0; n < 2; ++n) _Pragma("unroll") for (int k = 0; k < 2; ++k) dst[n][k] = *(const LAS bf16x8*)(lds + PG8_SB(b, h) + boff + n * 2048 + k * 1024); } while (0)
#define PG8_MMA(ai, bj, At, Bt) do { __builtin_amdgcn_s_setprio(1); _Pragma("unroll") for (int m = 0; m < 4; ++m) _Pragma("unroll") for (int n = 0; n < 2; ++n) _Pragma("unroll") for (int k = 0; k < 2; ++k) \
        acc[ai][bj][m][n] = __builtin_amdgcn_mfma_f32_16x16x32_bf16(Bt[n][k], At[m][k], acc[ai][bj][m][n], 0, 0, 0); __builtin_amdgcn_s_setprio(0); } while (0)
#define PG8_WAIT_V(n) asm volatile("s_waitcnt vmcnt(" #n ")" ::: "memory")
#define PG8_WAIT_L(n) asm volatile("s_waitcnt lgkmcnt(" #n ")" ::: "memory")
#define PG8_BAR __builtin_amdgcn_s_barrier()
#define PG8_SCHED __builtin_amdgcn_sched_barrier(0)
    Unit cur, nxt; int ui = 0;
    if (!S.next(0, cur)) return;
    f32x4 acc[2][2][4][2];
#pragma unroll
    for (int a = 0; a < 2; ++a)
#pragma unroll
        for (int b = 0; b < 2; ++b)
#pragma unroll
            for (int m = 0; m < 4; ++m)
#pragma unroll
                for (int n = 0; n < 2; ++n) acc[a][b][m][n] = (f32x4){0.f, 0.f, 0.f, 0.f};
    bf16x8 At[4][2], B0[2][2], B1[2][2];
    const char* cA = (const char*)g.A + (size_t)cur.pm * tstep; const char* cB = (const char*)g.Bt + (size_t)cur.pn * tstep;
    PG8_STAGE(PG8_SB(0, 0), cB, voffB); PG8_STAGE(PG8_SA(0, 0), cA, voffA); PG8_STAGE(PG8_SB(0, 1), cB + hstep, voffB); PG8_STAGE(PG8_SA(0, 1), cA + hstep, voffA);
    if (wr == 1) PG8_BAR;
    PG8_WAIT_V(4); PG8_BAR;
    PG8_STAGE(PG8_SB(1, 0), cB + kstep, voffB); PG8_STAGE(PG8_SA(1, 0), cA + kstep, voffA); PG8_STAGE(PG8_SB(1, 1), cB + hstep + kstep, voffB);
    PG8_WAIT_V(6); PG8_BAR;
    for (;;) {
        const bool has_next = S.next(ui + 1, nxt);
        const char* nA = has_next ? (const char*)g.A + (size_t)nxt.pm * tstep : cA; const char* nB = has_next ? (const char*)g.Bt + (size_t)nxt.pn * tstep : cB;
        for (int t = 0; t < nt; t += 2) {
            const bool last = (t == nt - 2);
            const char* a1 = cA + (size_t)(t + 1) * kstep;
            const char* a2 = last ? nA : cA + (size_t)(t + 2) * kstep; const char* b2 = last ? nB : cB + (size_t)(t + 2) * kstep;
            const char* a3 = a2 + kstep; const char* b3 = b2 + kstep;
            PG8_LDB(B0, 0, 0); PG8_SCHED; PG8_LDA(At, 0, 0); PG8_STAGE(PG8_SA(1, 1), a1 + hstep, voffA);
            PG8_WAIT_L(8); PG8_BAR; PG8_WAIT_L(0); PG8_MMA(0, 0, At, B0); PG8_BAR; PG8_SCHED;
            PG8_LDB(B1, 0, 1); PG8_STAGE(PG8_SB(0, 0), b2, voffB);
            PG8_BAR; PG8_WAIT_L(0); PG8_MMA(0, 1, At, B1); PG8_BAR;
            PG8_LDA(At, 0, 1); PG8_STAGE(PG8_SA(0, 0), a2, voffA);
            PG8_BAR; PG8_WAIT_L(0); PG8_MMA(1, 0, At, B0); PG8_BAR; PG8_SCHED;
            PG8_STAGE(PG8_SB(0, 1), b2 + hstep, voffB);
            PG8_WAIT_V(6); PG8_BAR; PG8_MMA(1, 1, At, B1); PG8_BAR;
            PG8_LDB(B0, 1, 0); PG8_SCHED; PG8_LDA(At, 1, 0); PG8_STAGE(PG8_SA(0, 1), a2 + hstep, voffA);
            PG8_WAIT_L(8); PG8_BAR; PG8_WAIT_L(0); PG8_MMA(0, 0, At, B0); PG8_BAR; PG8_SCHED;
            PG8_LDB(B1, 1, 1); PG8_STAGE(PG8_SB(1, 0), b3, voffB);
            PG8_BAR; PG8_WAIT_L(0); PG8_MMA(0, 1, At, B1); PG8_BAR;
            PG8_LDA(At, 1, 1); PG8_STAGE(PG8_SA(1, 0), a3, voffA);
            PG8_BAR; PG8_WAIT_L(0); PG8_MMA(1, 0, At, B0); PG8_BAR; PG8_SCHED;
            PG8_STAGE(PG8_SB(1, 1), b3 + hstep, voffB);
            PG8_WAIT_V(6); PG8_BAR; PG8_MMA(1, 1, At, B1); PG8_BAR;
        }
        E(acc, cur, wr, wc, fr, fq);
        if (!has_next) break;
#pragma unroll
        for (int a = 0; a < 2; ++a)
#pragma unroll
            for (int b = 0; b < 2; ++b)
#pragma unroll
                for (int m = 0; m < 4; ++m)
#pragma unroll
                    for (int n = 0; n < 2; ++n) acc[a][b][m][n] = (f32x4){0.f, 0.f, 0.f, 0.f};
        cur = nxt; cA = nA; cB = nB; ++ui;
    }
    PG8_WAIT_V(0);
    if (wr == 0) PG8_BAR;
    PG8_BAR;
#undef PG8_SA
#undef PG8_SB
#undef PG8_STAGE
#undef PG8_LDA
#undef PG8_LDB
#undef PG8_MMA
#undef PG8_WAIT_V
#undef PG8_WAIT_L
#undef PG8_BAR
#undef PG8_SCHED
}
struct EpiSwigluP {
    static constexpr bool PERM = true; bf16_t* hid;
    __device__ __forceinline__ void operator()(const f32x4 (&acc)[2][2][4][2], const Unit& u, int wr, int wc, int fr, int fq) const {
        const int row0 = u.pm * BM + wr * 64 + fr, col0 = u.pn * 128 + wc * 32 + 8 * fq;
#pragma unroll
        for (int ai = 0; ai < 2; ++ai)
#pragma unroll
            for (int m = 0; m < 4; ++m) { float h[8];
#pragma unroll
                for (int n = 0; n < 2; ++n)
#pragma unroll
                    for (int i = 0; i < 4; ++i) h[n * 4 + i] = silu_f(acc[ai][0][m][n][i]) * acc[ai][1][m][n][i];
                u32x4 w; w.x = cvt_pk_bf16(h[0], h[1]); w.y = cvt_pk_bf16(h[2], h[3]); w.z = cvt_pk_bf16(h[4], h[5]); w.w = cvt_pk_bf16(h[6], h[7]);
                *(u32x4*)(hid + (size_t)(row0 + ai * HALF + m * 16) * DFF + col0) = w; }
    }
};
struct EpiResidP {
    static constexpr bool PERM = false; const float* base; long dbase; float* out; long dxc; const float* mt; int gidx; float coef;
    __device__ __forceinline__ void operator()(const f32x4 (&acc)[2][2][4][2], const Unit& u, int wr, int wc, int fr, int fq) const {
        const int b = u.pm / 33, j = u.pm - b * 33; const bool isctx = (j == 0); const int s = isctx ? 2 : b;
        const long rb = isctx ? (long)(b * CTXL) * DM : (long)(b * SEQ + (j - 1) * 256) * DM;
        const float* bp = base + rb + (isctx ? dbase : 0); float* op = out + rb + (isctx ? dxc : 0);
        const int col0 = u.pn * BM + wc * 32 + 4 * fq; const float* gv = mt + (s * 9 + gidx) * DM + col0;
        f32x4 g4[2][2];
#pragma unroll
        for (int bj = 0; bj < 2; ++bj)
#pragma unroll
            for (int n = 0; n < 2; ++n) g4[bj][n] = *(const f32x4*)(gv + bj * HALF + n * 16) * coef;
#pragma unroll
        for (int ai = 0; ai < 2; ++ai)
#pragma unroll
            for (int m = 0; m < 4; ++m) { const long off = (long)(ai * HALF + wr * 64 + m * 16 + fr) * DM + col0;
#pragma unroll
                for (int bj = 0; bj < 2; ++bj)
#pragma unroll
                    for (int n = 0; n < 2; ++n) { const f32x4 bs = *(const f32x4*)(bp + off + bj * HALF + n * 16); *(f32x4*)(op + off + bj * HALF + n * 16) = bs + g4[bj][n] * acc[ai][bj][m][n]; }
                asm volatile("" ::: "memory"); }
    }
};
struct EpiABP {
    static constexpr bool PERM = true; bf16_t* zg; bf16_t* raw; float* abs_; int row0;
    __device__ __forceinline__ void operator()(const f32x4 (&acc)[2][2][4][2], const Unit& u, int wr, int wc, int fr, int fq) const {
        const int u0 = u.pm * BM - row0 + wr * 64 + fr;
        if (u.pn < 26) {
            const bool israw = (u.pn >= 4 && u.pn < 22); const int ld = israw ? 4608 : 2048;
            bf16_t* dst = israw ? raw + (u.pn - 4) * BM : (u.pn < 4 ? zg + u.pn * BM : zg + 1024 + (u.pn - 22) * BM); const int col0 = wc * 32 + 8 * fq;
#pragma unroll
            for (int ai = 0; ai < 2; ++ai)
#pragma unroll
                for (int m = 0; m < 4; ++m)
#pragma unroll
                    for (int bj = 0; bj < 2; ++bj) { const f32x4 v0 = acc[ai][bj][m][0], v1 = acc[ai][bj][m][1];
                        u32x4 w; w.x = cvt_pk_bf16(v0[0], v0[1]); w.y = cvt_pk_bf16(v0[2], v0[3]); w.z = cvt_pk_bf16(v1[0], v1[1]); w.w = cvt_pk_bf16(v1[2], v1[3]);
                        *(u32x4*)(dst + (size_t)(u0 + ai * HALF + m * 16) * ld + col0 + bj * HALF) = w; }
        } else if (wc < 2) {
#pragma unroll
            for (int ai = 0; ai < 2; ++ai)
#pragma unroll
                for (int m = 0; m < 4; ++m) { float* p = abs_ + (size_t)(u0 + ai * HALF + m * 16) * 64 + wc * 32 + 8 * fq;
                    *(f32x4*)p = acc[ai][0][m][0]; *(f32x4*)(p + 4) = acc[ai][0][m][1]; }
        }
    }
};
struct EpiBf16P {
    static constexpr bool PERM = true; bf16_t* O; int ldc;
    __device__ __forceinline__ void operator()(const f32x4 (&acc)[2][2][4][2], const Unit& u, int wr, int wc, int fr, int fq) const {
        const int row0 = u.pm * BM + wr * 64 + fr, col0 = u.pn * BM + wc * 32 + 8 * fq;
#pragma unroll
        for (int ai = 0; ai < 2; ++ai)
#pragma unroll
            for (int m = 0; m < 4; ++m)
#pragma unroll
                for (int bj = 0; bj < 2; ++bj) { const f32x4 v0 = acc[ai][bj][m][0], v1 = acc[ai][bj][m][1];
                    u32x4 w; w.x = cvt_pk_bf16(v0[0], v0[1]); w.y = cvt_pk_bf16(v0[2], v0[3]); w.z = cvt_pk_bf16(v1[0], v1[1]); w.w = cvt_pk_bf16(v1[2], v1[3]);
                    *(u32x4*)(O + (size_t)(row0 + ai * HALF + m * 16) * ldc + col0 + bj * HALF) = w; }
    }
};
}

__device__ __forceinline__ void cvt_item(const float* W, int ldw, int K, bf16_t* WT, int dest_row0, int src_col0, int kb, LAS float* scr, int lane) {
    const int k0 = 64 * kb;
#pragma unroll 8
    for (int i = 0; i < 32; ++i) { const int kk = 2 * i + (lane >> 5); scr[kk * 33 + (lane & 31)] = src_col0 >= 0 ? W[(size_t)(k0 + kk) * ldw + src_col0 + (lane & 31)] : 0.f; }
    asm volatile("s_waitcnt lgkmcnt(0)" ::: "memory");
    const int c = lane & 7;
#pragma unroll
    for (int j = 0; j < 4; ++j) { const int n = (lane >> 3) + 8 * j; const LAS float* sp = scr + (8 * c) * 33 + n;
        u32x4 o; o.x = pg8::cvt_pk_bf16(sp[0 * 33], sp[1 * 33]); o.y = pg8::cvt_pk_bf16(sp[2 * 33], sp[3 * 33]); o.z = pg8::cvt_pk_bf16(sp[4 * 33], sp[5 * 33]); o.w = pg8::cvt_pk_bf16(sp[6 * 33], sp[7 * 33]);
        *(u32x4*)(WT + (size_t)(dest_row0 + n) * K + k0 + 8 * c) = o; }
    asm volatile("s_waitcnt lgkmcnt(0)" ::: "memory");
}
__device__ __forceinline__ int map_ffin(int nb) { const int r0 = nb * 32, pn = r0 >> 8, j = r0 & 255; return j < 128 ? pn * 128 + j : DFF + pn * 128 + (j - 128); }
__device__ __forceinline__ int map_abin(int nb) { const int r0 = nb * 32; return r0 < 2560 ? r0 : (r0 < 6656 ? r0 + 32 : (r0 == 6656 ? 2560 : (r0 == 6688 ? 6688 : -1))); }
__device__ __forceinline__ void phase_convert(Frame& F, int l) {
    LAS float* scr = (LAS float*)(F.lds + F.wave * 8448);
    unsigned char* wb = F.ws + WS_W;
    const int gw = F.bid * 8 + F.wave, NGW = F.G * 8;
    constexpr int I_FFIN = 16 * 176, I_FFOUT = 44 * 32;
    const int n_in = l == 0 ? 216 : 64, I_MIN = 16 * n_in, kb_out = l == 0 ? 32 : 16, I_MOUT = kb_out * 32;
    const int total = 2 * I_FFIN + 2 * I_FFOUT + I_MIN + I_MOUT;
    for (int it = gw; it < total; it += NGW) {
        int r = it;
        if (r < 2 * I_FFIN) { const int w = r / I_FFIN; r -= w * I_FFIN; const int kb = r / 176, nb = r - kb * 176;
            cvt_item(F.in[I_WFFIN] + (size_t)(l * 2 + w) * DM * 2 * DFF, 2 * DFF, DM, (bf16_t*)(wb + (w ? W_FFIN1 : W_FFIN0)), nb * 32, map_ffin(nb), kb, scr, F.lane); continue; }
        r -= 2 * I_FFIN;
        if (r < 2 * I_FFOUT) { const int w = r / I_FFOUT; r -= w * I_FFOUT; const int kb = r / 32, nb = r - kb * 32;
            cvt_item(F.in[I_WFFOUT] + (size_t)(l * 2 + w) * DFF * DM, DM, DFF, (bf16_t*)(wb + (w ? W_FFOUT1 : W_FFOUT0)), nb * 32, nb * 32, kb, scr, F.lane); continue; }
        r -= 2 * I_FFOUT;
        if (r < I_MIN) { const int kb = r / n_in, nb = r - kb * n_in;
            if (l == 0) cvt_item(F.in[I_ABWIN], 6720, DM, (bf16_t*)(wb + W_MIXIN), nb * 32, map_abin(nb), kb, scr, F.lane);
            else cvt_item(F.in[I_WQKV], 2048, DM, (bf16_t*)(wb + W_MIXIN), nb * 32, nb * 32, kb, scr, F.lane);
            continue; }
        r -= I_MIN;
        { const int kb = r / 32, nb = r - kb * 32;
          if (l == 0) cvt_item(F.in[I_ABWOUT], DM, 2048, (bf16_t*)(wb + W_MIXOUT), nb * 32, nb * 32, kb, scr, F.lane);
          else cvt_item(F.in[I_WO], DM, DM, (bf16_t*)(wb + W_MIXOUT), nb * 32, nb * 32, kb, scr, F.lane); }
    }
}

namespace att {
constexpr int D = 128, NW = 8, QBLK = 32, KVBLK = 64;
constexpr float SCALE = 0.088388347648318440f;
constexpr float THR = 8.f;
constexpr int SDEPTH = 1;
constexpr int LDQ = 2048, LDK = 2048, LDO = 1024;
constexpr size_t SHM_V = KVBLK * D * 2, SHM_K = KVBLK * D * 2, SHM_ATTN = 2 * SHM_V + 2 * SHM_K + NW * 64 * 4;
#define KSWZ(row, colB) ((row) * 256 + ((colB) ^ (((row) & 7) << 4)))
#define SBAR() __builtin_amdgcn_sched_barrier(0)
__device__ __forceinline__ int crow(int r, int hi) { return (r & 3) + 8 * (r >> 2) + 4 * hi; }
__device__ __forceinline__ unsigned cvtpk(float lo, float hi) { unsigned r; asm volatile("v_cvt_pk_bf16_f32 %0, %1, %2" : "=v"(r) : "v"(lo), "v"(hi)); return r; }
__device__ __forceinline__ bf16x8 ld8(const bf16_t* p) { return *reinterpret_cast<const bf16x8*>(p); }
__device__ __forceinline__ void partialSM(f32x16& p0, f32x16& p1, float& m_reg, float& mn, float& alpha) {
  constexpr float C = SCALE * 1.4426950408889634f;
  float pmax = p0[0]; for (int r = 1; r < 16; ++r) pmax = fmaxf(pmax, p0[r]); for (int r = 0; r < 16; ++r) pmax = fmaxf(pmax, p1[r]);
  { auto rr = __builtin_amdgcn_permlane32_swap(__float_as_uint(pmax), __float_as_uint(pmax), false, false);
    pmax = fmaxf(__uint_as_float(rr[0]), __uint_as_float(rr[1])); }
  if (__builtin_expect(__all(pmax - m_reg <= THR / SCALE), 1)) { mn = m_reg; alpha = 1.f; }
  else { mn = fmaxf(m_reg, pmax); alpha = __builtin_amdgcn_exp2f((m_reg - mn) * C); m_reg = mn; }
  float mnC = -mn * C;
  for (int r = 0; r < 16; ++r) p0[r] = fmaf(p0[r], C, mnC); for (int r = 0; r < 16; ++r) p1[r] = fmaf(p1[r], C, mnC);
  for (int r = 0; r < 16; ++r) p0[r] = __builtin_amdgcn_exp2f(p0[r]);
}
__device__ __forceinline__ void finishSM(f32x16& p0, f32x16& p1, float alpha, float& l_reg, bf16x8& pa0, bf16x8& pa1, bf16x8& pa2, bf16x8& pa3) {
  for (int r = 0; r < 16; ++r) p1[r] = __builtin_amdgcn_exp2f(p1[r]);
  float ps = 0; for (int r = 0; r < 16; ++r) ps += p0[r]; for (int r = 0; r < 16; ++r) ps += p1[r];
  { auto rr = __builtin_amdgcn_permlane32_swap(__float_as_uint(ps), __float_as_uint(ps), false, false);
    ps = __uint_as_float(rr[0]) + __uint_as_float(rr[1]); }
  l_reg = l_reg * alpha + ps;
#define PK4(P, BASE, OUT) do { unsigned a0 = cvtpk(P[BASE + 0], P[BASE + 1]), a1 = cvtpk(P[BASE + 2], P[BASE + 3]);   \
    unsigned b0 = cvtpk(P[BASE + 4], P[BASE + 5]), b1 = cvtpk(P[BASE + 6], P[BASE + 7]);                              \
    auto r0 = __builtin_amdgcn_permlane32_swap(a0, b0, false, false); auto r1 = __builtin_amdgcn_permlane32_swap(a1, b1, false, false); \
    u32x4 w = {r0[0], r1[0], r0[1], r1[1]}; OUT = *reinterpret_cast<bf16x8*>(&w); } while (0)
  PK4(p0, 0, pa0); PK4(p0, 8, pa1); PK4(p1, 0, pa2); PK4(p1, 8, pa3);
#undef PK4
}
__device__ __forceinline__ void qkt(f32x16& p0, f32x16& p1, const bf16_t* Ks, const bf16x8* qr, int r32, int hi) {
  p0 = f32x16{}; p1 = f32x16{};
  for (int d0 = 0; d0 < 8; ++d0) { int cb = (d0 * 16 + hi * 8) * 2;
    bf16x8 b0 = *reinterpret_cast<const bf16x8*>((const char*)Ks + KSWZ(r32, cb));
    bf16x8 b1 = *reinterpret_cast<const bf16x8*>((const char*)Ks + KSWZ(32 + r32, cb));
    p0 = __builtin_amdgcn_mfma_f32_32x32x16_bf16(b0, qr[d0], p0, 0, 0, 0);
    p1 = __builtin_amdgcn_mfma_f32_32x32x16_bf16(b1, qr[d0], p1, 0, 0, 0); }
}
__device__ __forceinline__ int v_st(int k, int c) { const int kk = (k & ~0xC) | ((k & 4) << 1) | ((k & 8) >> 1); return ((kk >> 3) * 4 + (c >> 5)) * 512 + ((kk & 7) * 32 + (c & 31)) * 2; }
__device__ __forceinline__ int v_rd_base(int lane) { return ((lane & 3) << 3) | (((lane >> 2) & 3) << 6) | (((lane >> 4) & 1) << 5) | (((lane >> 5) & 1) << 8); }
constexpr int v_rd_off(int d0, int ks, int half) { return d0 * 512 + ks * 4096 + half * 2048; }
template <int OFF> __device__ __forceinline__ s16x4 tr_read(int vb) {
  s16x4 r; asm volatile("ds_read_b64_tr_b16 %0, %1 offset:%2" : "=&v"(r) : "v"(vb), "i"(OFF) : "memory"); return r;
}
template <int D0> __device__ __forceinline__ void pv_one(f32x16& od, int vb, bf16x8 pa0, bf16x8 pa1, bf16x8 pa2, bf16x8 pa3) {
  const s16x4 l0 = tr_read<v_rd_off(D0, 0, 0)>(vb), h0 = tr_read<v_rd_off(D0, 0, 1)>(vb), l1 = tr_read<v_rd_off(D0, 1, 0)>(vb), h1 = tr_read<v_rd_off(D0, 1, 1)>(vb);
  const s16x4 l2 = tr_read<v_rd_off(D0, 2, 0)>(vb), h2 = tr_read<v_rd_off(D0, 2, 1)>(vb), l3 = tr_read<v_rd_off(D0, 3, 0)>(vb), h3 = tr_read<v_rd_off(D0, 3, 1)>(vb);
  asm volatile("s_waitcnt lgkmcnt(0)" ::: "memory"); SBAR();
#define PK(L, H) (bf16x8){L[0], L[1], L[2], L[3], H[0], H[1], H[2], H[3]}
  od = __builtin_amdgcn_mfma_f32_32x32x16_bf16(pa0, PK(l0, h0), od, 0, 0, 0);
  od = __builtin_amdgcn_mfma_f32_32x32x16_bf16(pa1, PK(l1, h1), od, 0, 0, 0);
  od = __builtin_amdgcn_mfma_f32_32x32x16_bf16(pa2, PK(l2, h2), od, 0, 0, 0);
  od = __builtin_amdgcn_mfma_f32_32x32x16_bf16(pa3, PK(l3, h3), od, 0, 0, 0);
#undef PK
}
__device__ __forceinline__ void pv_d0(f32x16* o, int vb, bf16x8 pa0, bf16x8 pa1, bf16x8 pa2, bf16x8 pa3) {
  pv_one<0>(o[0], vb, pa0, pa1, pa2, pa3); pv_one<1>(o[1], vb, pa0, pa1, pa2, pa3); pv_one<2>(o[2], vb, pa0, pa1, pa2, pa3); pv_one<3>(o[3], vb, pa0, pa1, pa2, pa3);
}
__device__ __forceinline__ void attn_dense_body(const bf16_t* __restrict__ Qb, const bf16_t* __restrict__ Kh, const bf16_t* __restrict__ Vh,
                                                bf16_t* __restrict__ Ob, int  , char* lds, int tid) {
  constexpr int seq = TB;
  const int wid = tid >> 6, lane = tid & 63, r32 = lane & 31, hi = lane >> 5;
  bf16_t* V_lds = (bf16_t*)lds; bf16_t* K_lds = (bf16_t*)(lds + 2 * SHM_V);
  float* ws = (float*)(lds + 2 * SHM_V + 2 * SHM_K) + wid * 64; float* li_l = ws; float* al_l = ws + 32;
  float m_reg = -1e30f, l_reg = 0; f32x16 o[4] = {}; bf16x8 qr[8];
  const bf16_t* Qw = Qb + (long)(wid * QBLK + r32) * LDQ + hi * 8;
#pragma unroll
  for (int d0 = 0; d0 < 8; ++d0) qr[d0] = ld8(Qw + d0 * 16);
  const int sr = tid >> 4, sc = (tid & 15) * 8, vst0 = v_st(sr, sc), vst1 = v_st(32 + sr, sc);
  const int vb0 = (int)(uintptr_t)V_lds + v_rd_base(lane);
  struct { bf16x8 vs0, vs1, ks0, ks1; } sr_[SDEPTH];
#define SLOAD(i, k0) do { sr_[i].vs0 = ld8(&Vh[(long)((k0) + sr) * LDK + sc]); sr_[i].vs1 = ld8(&Vh[(long)((k0) + 32 + sr) * LDK + sc]); \
    sr_[i].ks0 = ld8(&Kh[(long)((k0) + sr) * LDK + sc]); sr_[i].ks1 = ld8(&Kh[(long)((k0) + 32 + sr) * LDK + sc]); } while (0)
#define SWRITE(b, i) do { *(bf16x8*)((char*)V_lds + (b) * SHM_V + vst0) = sr_[i].vs0;          \
    *(bf16x8*)((char*)V_lds + (b) * SHM_V + vst1) = sr_[i].vs1; int kc = sc * 2;               \
    *(bf16x8*)((char*)K_lds + (b) * SHM_K + KSWZ(sr, kc)) = sr_[i].ks0;                       \
    *(bf16x8*)((char*)K_lds + (b) * SHM_K + KSWZ(32 + sr, kc)) = sr_[i].ks1; } while (0)
#define SWAIT() do { if constexpr (SDEPTH == 2) asm volatile("s_waitcnt vmcnt(4)" ::: "memory"); else asm volatile("s_waitcnt vmcnt(0)" ::: "memory"); } while (0)
#define RESC(a) do { if (__any((a) < 1.f)) { if (hi == 0) al_l[r32] = (a); asm volatile("s_waitcnt lgkmcnt(0)" ::: "memory"); \
    for (int d = 0; d < 4; ++d) for (int r = 0; r < 16; ++r) o[d][r] *= al_l[crow(r, hi)]; } } while (0)
  f32x16 pA0, pA1, pB0, pB1; float mnA, mnB, alA, alB; bf16x8 pa0, pa1, pa2, pa3; const int NT = seq / KVBLK;
  constexpr int SE = 0, SO = SDEPTH - 1;
  SLOAD(SE, 0); asm volatile("s_waitcnt vmcnt(0)" ::: "memory"); SWRITE(0, SE); __syncthreads();
  qkt(pA0, pA1, K_lds, qr, r32, hi); partialSM(pA0, pA1, m_reg, mnA, alA);
  SLOAD(SO, KVBLK); if constexpr (SDEPTH == 2) { if (2 < NT) SLOAD(SE, 2 * KVBLK); }
  SWAIT(); SWRITE(1, SO); __syncthreads();
  for (int j = 1; j + 1 < NT; j += 2) {
    SBAR(); qkt(pB0, pB1, (bf16_t*)((char*)K_lds + SHM_K), qr, r32, hi);
    finishSM(pA0, pA1, alA, l_reg, pa0, pa1, pa2, pa3); SBAR();
    SLOAD(SO, (j + SDEPTH) * KVBLK); SBAR();
    pv_d0(o, vb0, pa0, pa1, pa2, pa3); partialSM(pB0, pB1, m_reg, mnB, alB);
    __syncthreads(); SWAIT(); SWRITE(0, SE);
    RESC(alB); __syncthreads();
    SBAR(); qkt(pA0, pA1, K_lds, qr, r32, hi);
    finishSM(pB0, pB1, alB, l_reg, pa0, pa1, pa2, pa3); SBAR();
    if (SDEPTH == 1 || j + 3 < NT) SLOAD(SE, (j + 1 + SDEPTH) * KVBLK); SBAR();
    pv_d0(o, vb0 + (int)SHM_V, pa0, pa1, pa2, pa3); partialSM(pA0, pA1, m_reg, mnA, alA);
    __syncthreads(); SWAIT(); SWRITE(1, SO);
    RESC(alA); __syncthreads();
  }
  SBAR(); qkt(pB0, pB1, (bf16_t*)((char*)K_lds + SHM_K), qr, r32, hi);
  finishSM(pA0, pA1, alA, l_reg, pa0, pa1, pa2, pa3); SBAR();
  pv_d0(o, vb0, pa0, pa1, pa2, pa3); partialSM(pB0, pB1, m_reg, mnB, alB);
  __syncthreads(); RESC(alB);
  finishSM(pB0, pB1, alB, l_reg, pa0, pa1, pa2, pa3); SBAR();
  pv_d0(o, vb0 + (int)SHM_V, pa0, pa1, pa2, pa3);
  if (hi == 0) li_l[r32] = l_reg; asm volatile("s_waitcnt lgkmcnt(0)" ::: "memory");
  float rli[16];
#pragma unroll
  for (int r = 0; r < 16; ++r) rli[r] = __builtin_amdgcn_rcpf(li_l[crow(r, hi)]);
  bf16_t* Ow = Ob + (long)(wid * QBLK) * LDO;
#pragma unroll
  for (int r = 0; r < 16; ++r) { int orow = crow(r, hi);
    for (int d0 = 0; d0 < 4; ++d0) Ow[(long)orow * LDO + d0 * 32 + r32] = f2bf(o[d0][r] * rli[r]); }
#undef SLOAD
#undef SWRITE
#undef SWAIT
#undef RESC
}
}

__device__ __forceinline__ void phase_modtab(Frame& F) {
    LAS float* sc = (LAS float*)F.lds;
    for (int i = F.tid; i < 3 * DM; i += NTHREADS) { const int s = i / DM, k = i - s * DM; const float c = s < 2 ? F.in[I_C][s * DM + k] : F.in[I_CCTX][k]; sc[i] = silu_f(c); }
    __syncthreads();
    const int gid = F.bid * NTHREADS + F.tid;
    if (gid < 2 * 9216) {
        const int l = gid / 9216, n = gid - l * 9216; const float* w = F.in[I_WMOD] + (size_t)l * DM * 9216 + n;
        const float bm = F.in[I_BMOD][l * 9216 + n]; float a0 = bm, a1 = bm, a2 = bm;
#pragma unroll 8
        for (int k = 0; k < DM; ++k) { const float wv = w[(size_t)k * 9216]; a0 = fmaf(sc[k], wv, a0); a1 = fmaf(sc[DM + k], wv, a1); a2 = fmaf(sc[2 * DM + k], wv, a2); }
        F_MT[(l * 3 + 0) * 9216 + n] = a0; F_MT[(l * 3 + 1) * 9216 + n] = a1; F_MT[(l * 3 + 2) * 9216 + n] = a2;
    }
    __syncthreads();
}
__device__ __forceinline__ void phase_norm(Frame& F, int l, int which, bool from_input, bool skip_ctx) {
    const float* g = F.in[I_NORMG] + (l * 3 + which) * DM;
    const float* src = from_input ? F.in[I_X] : F.out; const long dsrc = from_input ? F.dcin : F.dxc;
    const int gw = F.bid * 8 + F.wave, NGW = F.G * 8;
    for (int r = gw; r < TT; r += NGW) {
        bool isctx; const long o = xoff(r, dsrc, isctx); if (skip_ctx && isctx) continue;
        const int s = isctx ? 2 : r / TB;
        const float* sh = F_MT + ((l * 3 + s) * 9 + which * 3 + 0) * DM; const float* sc = sh + DM;
        f32x4 v[4]; float ss = 0.f;
#pragma unroll
        for (int j = 0; j < 4; ++j) { v[j] = *(const f32x4*)(src + o + j * 256 + F.lane * 4); ss += (v[j][0] * v[j][0] + v[j][1] * v[j][1]) + (v[j][2] * v[j][2] + v[j][3] * v[j][3]); }
        const float rstd = 1.0f / sqrtf(wave_sum(ss) * (1.f / DM) + NEPS);
#pragma unroll
        for (int j = 0; j < 4; ++j) { const int c = j * 256 + F.lane * 4; const f32x4 gv = *(const f32x4*)(g + c), shv = *(const f32x4*)(sh + c), scv = *(const f32x4*)(sc + c);
            unsigned w0, w1; { const float a = v[j][0] * rstd * gv[0] * (1.f + scv[0]) + shv[0], b = v[j][1] * rstd * gv[1] * (1.f + scv[1]) + shv[1]; w0 = (unsigned)f2bf(a) | ((unsigned)f2bf(b) << 16); }
            { const float a = v[j][2] * rstd * gv[2] * (1.f + scv[2]) + shv[2], b = v[j][3] * rstd * gv[3] * (1.f + scv[3]) + shv[3]; w1 = (unsigned)f2bf(a) | ((unsigned)f2bf(b) << 16); }
            *(uint2*)(F_HN + (size_t)r * DM + c) = make_uint2(w0, w1); }
    }
}
__device__ __forceinline__ void phase_conv(Frame& F, int b) {
    const int gw = F.bid * 8 + F.wave, NGW = F.G * 8;
    for (int it = gw; it < TB * 36; it += NGW) {
        const int u = it / 36, grp = it - u * 36; const int c0 = grp * 128 + F.lane * 2;
        const int seg_lo = u < CTXL ? 0 : CTXL, seg_hi = u < CTXL ? CTXL : TB;
        const bool ssd = c0 < 1536; const float* cw = ssd ? F.in[I_SCONVW] : F.in[I_GCONVW]; const int cc = ssd ? c0 : c0 - 1536, cn = ssd ? 1536 : 3072;
        float a0 = ssd ? F.in[I_SCONVB][cc] : 0.f, a1 = ssd ? F.in[I_SCONVB][cc + 1] : 0.f;
#pragma unroll
        for (int i = 0; i < 5; ++i) { const int uu = u + i - 2; if (uu >= seg_lo && uu < seg_hi) { const unsigned w = *(const unsigned*)(F_RAW + (size_t)uu * 4608 + c0);
                a0 = fmaf(cw[i * cn + cc], bflo(w), a0); a1 = fmaf(cw[i * cn + cc + 1], bfhi(w), a1); } }
        a0 = silu_f(a0); a1 = silu_f(a1);
        if (grp >= 12 && grp < 28) { const float ss = wave_sum(a0 * a0 + a1 * a1); float sc = 1.0f / sqrtf(ss + NEPS); if (grp < 20) sc *= 0.08838834764831845f; a0 *= sc; a1 *= sc; }
        *(unsigned*)(F_CV + (size_t)u * 4608 + c0) = (unsigned)f2bf(a0) | ((unsigned)f2bf(a1) << 16);
    }
    for (int i = F.bid * NTHREADS + F.tid; i < TB * 64; i += F.G * NTHREADS) {
        const int j = i & 63; float v = F_ABS[i];
        if (j < 32) v = softplus_f(v + F.in[I_SDTB][j]);
        else if (j < 48) v = sigmoid_f(v);
        else v = -__expf(F.in[I_GALOG][j - 48]) * softplus_f(v + F.in[I_GDTB][j - 48]);
        F_ABS[i] = v;
    }
}
__device__ __forceinline__ int scan_tok(int dir, int i) { return dir == 0 ? i : (i < CTXL ? CTXL - 1 - i : TB + CTXL - 1 - i); }
__device__ __forceinline__ void ssd_naive(Frame& F, int head) {
    const int p = F.tid >> 3, nq = F.tid & 7, g = head >> 3;
    for (int dir = 0; dir < 2; ++dir) {
        const float a = -__expf(F.in[I_SALOG][dir * 16 + head]);
        float S[16];
#pragma unroll
        for (int j = 0; j < 16; ++j) S[j] = 0.f;
        for (int i = 0; i < TB; ++i) {
            const int u = scan_tok(dir, i); const bf16_t* row = F_CV + (size_t)u * 4608;
            const float x = bf2f(row[head * 64 + p]), dt = F_ABS[u * 64 + dir * 16 + head];
            const u32x4 b0 = *(const u32x4*)(row + 1024 + g * 128 + nq * 16), b1 = *(const u32x4*)(row + 1024 + g * 128 + nq * 16 + 8);
            const u32x4 c0 = *(const u32x4*)(row + 1280 + g * 128 + nq * 16), c1 = *(const u32x4*)(row + 1280 + g * 128 + nq * 16 + 8);
            const float dA = __expf(dt * a), xdt = x * dt; float y = 0.f;
#pragma unroll
            for (int j = 0; j < 4; ++j) {
                S[2 * j] = fmaf(S[2 * j], dA, xdt * bflo(b0[j])); y = fmaf(bflo(c0[j]), S[2 * j], y);
                S[2 * j + 1] = fmaf(S[2 * j + 1], dA, xdt * bfhi(b0[j])); y = fmaf(bfhi(c0[j]), S[2 * j + 1], y);
                S[8 + 2 * j] = fmaf(S[8 + 2 * j], dA, xdt * bflo(b1[j])); y = fmaf(bflo(c1[j]), S[8 + 2 * j], y);
                S[8 + 2 * j + 1] = fmaf(S[8 + 2 * j + 1], dA, xdt * bfhi(b1[j])); y = fmaf(bfhi(c1[j]), S[8 + 2 * j + 1], y); }
            y += __shfl_xor(y, 1); y += __shfl_xor(y, 2); y += __shfl_xor(y, 4);
            if (nq == 0) F_YD[((size_t)dir * TB + u) * 2048 + head * 64 + p] = f2bf(y);
        }
    }
}
__device__ __forceinline__ void gdn_naive(Frame& F, int h) {
    const int e = F.tid >> 2, dq = F.tid & 3;
    for (int dir = 0; dir < 2; ++dir) {
        float S[32];
#pragma unroll
        for (int j = 0; j < 32; ++j) S[j] = 0.f;
        for (int i = 0; i < TB; ++i) {
            const int u = scan_tok(dir, i); const bf16_t* row = F_CV + (size_t)u * 4608;
            const float v = bf2f(row[3584 + h * 128 + e]), beta = F_ABS[u * 64 + 32 + dir * 8 + h], eg = __expf(F_ABS[u * 64 + 48 + dir * 8 + h]);
            u32x4 kk[4], qq[4];
#pragma unroll
            for (int j = 0; j < 4; ++j) { kk[j] = *(const u32x4*)(row + 2560 + h * 128 + dq * 32 + j * 8); qq[j] = *(const u32x4*)(row + 1536 + h * 128 + dq * 32 + j * 8); }
            float ks = 0.f;
#pragma unroll
            for (int j = 0; j < 4; ++j)
#pragma unroll
                for (int w = 0; w < 4; ++w) { ks = fmaf(bflo(kk[j][w]), S[j * 8 + 2 * w], ks); ks = fmaf(bfhi(kk[j][w]), S[j * 8 + 2 * w + 1], ks); }
            ks += __shfl_xor(ks, 1); ks += __shfl_xor(ks, 2);
            const float vn = beta * (v - eg * ks); float o = 0.f;
#pragma unroll
            for (int j = 0; j < 4; ++j)
#pragma unroll
                for (int w = 0; w < 4; ++w) {
                    S[j * 8 + 2 * w] = fmaf(eg, S[j * 8 + 2 * w], bflo(kk[j][w]) * vn); o = fmaf(bflo(qq[j][w]), S[j * 8 + 2 * w], o);
                    S[j * 8 + 2 * w + 1] = fmaf(eg, S[j * 8 + 2 * w + 1], bfhi(kk[j][w]) * vn); o = fmaf(bfhi(qq[j][w]), S[j * 8 + 2 * w + 1], o); }
            o += __shfl_xor(o, 1); o += __shfl_xor(o, 2);
            if (dq == 0) F_YD[((size_t)dir * TB + u) * 2048 + 1024 + h * 128 + e] = f2bf(o);
        }
    }
}

__device__ __forceinline__ int crow32(int r, int hi) { return (r & 3) + 8 * (r >> 2) + 4 * hi; }
__device__ __forceinline__ s16x4 tr_read_b64(unsigned addr) { s16x4 r; asm volatile("ds_read_b64_tr_b16 %0, %1" : "=&v"(r) : "v"(addr) : "memory"); return r; }
#define LGKM_WAIT0() do { asm volatile("s_waitcnt lgkmcnt(0)" ::: "memory"); __builtin_amdgcn_sched_barrier(0); } while (0)
#define PK8(L, H) (bf16x8){L[0], L[1], L[2], L[3], H[0], H[1], H[2], H[3]}
__device__ __forceinline__ void ssd_prep_item(Frame& F, int g, int c) {
    const int w = F.wave, r32 = F.lane & 31, h = F.lane >> 5, jt = w >> 1, it0 = (w & 1) * 2;
    const bf16_t* cv = F_CV + (size_t)(c * 128) * 4608; const bf16_t* Bm = cv + 1024 + g * 128; const bf16_t* Cm = cv + 1280 + g * 128;
    f32x16 acc0 = {}, acc1 = {};
#pragma unroll
    for (int s8 = 0; s8 < 8; ++s8) {
        const bf16x8 a = *(const bf16x8*)(Bm + (size_t)(32 * jt + r32) * 4608 + 16 * s8 + 8 * h);
        const bf16x8 b0 = *(const bf16x8*)(Cm + (size_t)(32 * it0 + r32) * 4608 + 16 * s8 + 8 * h);
        const bf16x8 b1 = *(const bf16x8*)(Cm + (size_t)(32 * it0 + 32 + r32) * 4608 + 16 * s8 + 8 * h);
        acc0 = __builtin_amdgcn_mfma_f32_32x32x16_bf16(a, b0, acc0, 0, 0, 0); acc1 = __builtin_amdgcn_mfma_f32_32x32x16_bf16(a, b1, acc1, 0, 0, 0);
    }
    bf16_t* cb = F_CB + (size_t)(g * 66 + c) * 128 * 128;
#pragma unroll
    for (int q = 0; q < 4; ++q) { const int j0 = 32 * jt + 8 * q + 4 * h;
        *(uint2*)(cb + (32 * it0 + r32) * 128 + j0) = make_uint2(pk2(acc0[4 * q], acc0[4 * q + 1]), pk2(acc0[4 * q + 2], acc0[4 * q + 3]));
        *(uint2*)(cb + (32 * it0 + 32 + r32) * 128 + j0) = make_uint2(pk2(acc1[4 * q], acc1[4 * q + 1]), pk2(acc1[4 * q + 2], acc1[4 * q + 3])); }
}
constexpr int SSD_RX = 192, SSD_RB = 320, SSD_RM = 272, SSD_RS = 272;
constexpr int SSD_XS = 0, SSD_BW = SSD_XS + 128 * SSD_RX, SSD_MS = SSD_BW + 128 * SSD_RB, SSD_SS = SSD_MS + 128 * SSD_RM, SSD_VEC = SSD_SS + 64 * SSD_RS, SSD_LDS_END = SSD_VEC + 2560;
static_assert(SSD_LDS_END <= 131072, "SSD LDS");
__device__ __forceinline__ int ssd_chunk(int dir, int s) { return dir == 0 ? s : (s < 2 ? 1 - s : 67 - s); }
__device__ __forceinline__ void ssd_scan(Frame& F, int head, int dir, bf16_t* ydst, int yld, int ycol0) {
    const int tid = F.tid, lane = F.lane, w = F.wave, r32 = lane & 31, h = lane >> 5, g = head >> 3;
    LAS unsigned char* L = F.lds;
    LAS float* vac = (LAS float*)(L + SSD_VEC); LAS float* veac = vac + 128; LAS float* vw = vac + 256; LAS float* vdt = vac + 384; LAS float* vsc = vac + 512;
    const float a = -__expf(F.in[I_SALOG][dir * 16 + head]);
    const int it = w >> 1, pt = w & 1;
    const int srow = tid >> 2, sq = tid & 3;
    const unsigned trq = (unsigned)(8 * h + ((lane & 15) >> 2)), trc = (unsigned)((16 * ((lane >> 4) & 1) + 4 * (lane & 3)) * 2);
    const unsigned vbX = (unsigned)(uintptr_t)(F.ldsg + SSD_XS) + trq * SSD_RX + (unsigned)(64 * pt) + trc;
    const unsigned vbB = (unsigned)(uintptr_t)(F.ldsg + SSD_BW) + trq * SSD_RB + (unsigned)(64 * it) + trc;
    f32x16 accS = {};
    for (int i = tid; i < 64 * SSD_RS / 4; i += NTHREADS) ((LAS unsigned*)(L + SSD_SS))[i] = 0u;
    u32x4 px[2], pb[4], pcb[4]; bf16x8 pc[8]; float pdt0 = 0.f, pdt1 = 0.f;
#define SSD_ISSUE_MAIN(cc) do { const bf16_t* rowp = F_CV + (size_t)((cc) * 128 + srow) * 4608; \
        px[0] = *(const u32x4*)(rowp + head * 64 + sq * 16); px[1] = *(const u32x4*)(rowp + head * 64 + sq * 16 + 8); \
        _Pragma("unroll") for (int k = 0; k < 4; ++k) { pb[k] = *(const u32x4*)(rowp + 1024 + g * 128 + sq * 32 + 8 * k); \
            pcb[k] = *(const u32x4*)(F_CB + ((size_t)(g * 66 + (cc)) * 128 + srow) * 128 + sq * 32 + 8 * k); } \
        if (w == 0) { pdt0 = F_ABS[(size_t)((cc) * 128 + 2 * lane) * 64 + dir * 16 + head]; pdt1 = F_ABS[(size_t)((cc) * 128 + 2 * lane + 1) * 64 + dir * 16 + head]; } } while (0)
#define SSD_ISSUE_C(cc) do { const bf16_t* cp = F_CV + (size_t)((cc) * 128 + 32 * it + r32) * 4608 + 1280 + g * 128 + 8 * h; \
        _Pragma("unroll") for (int k = 0; k < 8; ++k) pc[k] = *(const bf16x8*)(cp + 16 * k); } while (0)
    { const int c0 = ssd_chunk(dir, 0); SSD_ISSUE_MAIN(c0); SSD_ISSUE_C(c0); }
    for (int s = 0; s < 66; ++s) {
        const int c = ssd_chunk(dir, s);
        if (w == 0) {
            const float d0 = pdt0 * a, d1 = pdt1 * a, ps = d0 + d1; float inc = ps;
            if (dir == 0) {
#pragma unroll
                for (int o = 1; o < 64; o <<= 1) { const float t = __shfl_up(inc, o); if (lane >= o) inc += t; }
            } else {
#pragma unroll
                for (int o = 1; o < 64; o <<= 1) { const float t = __shfl_down(inc, o); if (lane + o < 64) inc += t; }
            }
            const float tot = __shfl(inc, dir == 0 ? 63 : 0);
            const float ac0 = dir == 0 ? inc - d1 : inc, ac1 = dir == 0 ? inc : inc - d0;
            vac[2 * lane] = ac0; vac[2 * lane + 1] = ac1; veac[2 * lane] = __expf(ac0); veac[2 * lane + 1] = __expf(ac1);
            vw[2 * lane] = __expf(tot - ac0) * pdt0; vw[2 * lane + 1] = __expf(tot - ac1) * pdt1; vdt[2 * lane] = pdt0; vdt[2 * lane + 1] = pdt1;
            if (lane == 0) vsc[0] = __expf(tot);
        }
        __syncthreads();
        {
            const float wr_ = vw[srow], acr = vac[srow];
            *(LAS u32x4*)(L + SSD_XS + srow * SSD_RX + sq * 32) = px[0]; *(LAS u32x4*)(L + SSD_XS + srow * SSD_RX + sq * 32 + 16) = px[1];
#pragma unroll
            for (int k = 0; k < 4; ++k) {
                u32x4 o;
#pragma unroll
                for (int e = 0; e < 4; ++e) o[e] = pk2(bflo(pb[k][e]) * wr_, bfhi(pb[k][e]) * wr_);
                *(LAS u32x4*)(L + SSD_BW + srow * SSD_RB + sq * 64 + k * 16) = o;
                const int j0 = sq * 32 + 8 * k;
                const f32x4 aj0 = *(const LAS f32x4*)(vac + j0), aj1 = *(const LAS f32x4*)(vac + j0 + 4), dj0 = *(const LAS f32x4*)(vdt + j0), dj1 = *(const LAS f32x4*)(vdt + j0 + 4);
                float m[8];
#pragma unroll
                for (int e = 0; e < 8; ++e) { const int j = j0 + e; const bool keep = dir == 0 ? (j <= srow) : (j >= srow);
                    const float aj = e < 4 ? aj0[e & 3] : aj1[e & 3], dj = e < 4 ? dj0[e & 3] : dj1[e & 3]; const unsigned wv = pcb[k][e >> 1]; const float cbv = (e & 1) ? bfhi(wv) : bflo(wv);
                    m[e] = keep ? cbv * __expf(acr - aj) * dj : 0.f;
#if DEBUG_SSD
                    if (!(m[e] == m[e]) || fabsf(m[e]) > 1e30f) atomicOr((unsigned*)(F.ws + WS_CTL) + 203, 16u);
                    if (!(cbv == cbv) || fabsf(cbv) > 1e30f) atomicOr((unsigned*)(F.ws + WS_CTL) + 203, 32u);
                    if (keep && (acr - aj) > 1e-3f) atomicOr((unsigned*)(F.ws + WS_CTL) + 203, 64u);
                    if (!(dj == dj) || fabsf(dj) > 1e30f) atomicOr((unsigned*)(F.ws + WS_CTL) + 203, 128u);
#endif
                    }
                u32x4 mo; mo[0] = pk2(m[0], m[1]); mo[1] = pk2(m[2], m[3]); mo[2] = pk2(m[4], m[5]); mo[3] = pk2(m[6], m[7]);
                *(LAS u32x4*)(L + SSD_MS + srow * SSD_RM + sq * 64 + k * 16) = mo;
            }
        }
        if (s + 1 < 66) { const int cn = ssd_chunk(dir, s + 1); SSD_ISSUE_MAIN(cn); }
        __syncthreads();
        f32x16 acc = {};
#pragma unroll
        for (int k = 0; k < 8; ++k) { const bf16x8 bs = *(const LAS bf16x8*)(L + SSD_SS + (32 * pt + r32) * SSD_RS + (16 * k + 8 * h) * 2); acc = __builtin_amdgcn_mfma_f32_32x32x16_bf16(pc[k], bs, acc, 0, 0, 0); }
        if (s + 1 < 66) { const int cn = ssd_chunk(dir, s + 1); SSD_ISSUE_C(cn); }
#if DEBUG_SSD
        { bool bn = false; for (int r = 0; r < 16; ++r) bn |= !(acc[r] == acc[r]) || fabsf(acc[r]) > 1e30f; if (bn) atomicOr((unsigned*)(F.ws + WS_CTL) + 203, 2u);
          bool vn = false; for (int r = 0; r < 2; ++r) { const float t0 = vac[lane + 64 * r], t1 = veac[lane + 64 * r], t2 = vw[lane + 64 * r]; vn |= !(t0 == t0) || !(t1 == t1) || !(t2 == t2) || fabsf(t2) > 1e30f; } if (vn) atomicOr((unsigned*)(F.ws + WS_CTL) + 203, 1u); }
#endif
#pragma unroll
        for (int r = 0; r < 16; ++r) acc[r] *= veac[32 * it + crow32(r, h)];
        { const float el = vsc[0];
#pragma unroll
          for (int r = 0; r < 16; ++r) accS[r] *= el; }
        { const int klo = dir == 0 ? 0 : 2 * it, khi = dir == 0 ? 2 * it + 1 : 7;
#pragma unroll
          for (int half = 0; half < 2; ++half) {
            s16x4 xl[4], xh[4], bl[4], bh[4];
#pragma unroll
            for (int k = 0; k < 4; ++k) { const int kk = 4 * half + k; xl[k] = tr_read_b64(vbX + (unsigned)((16 * kk) * SSD_RX)); xh[k] = tr_read_b64(vbX + (unsigned)((16 * kk + 4) * SSD_RX));
                bl[k] = tr_read_b64(vbB + (unsigned)((16 * kk) * SSD_RB)); bh[k] = tr_read_b64(vbB + (unsigned)((16 * kk + 4) * SSD_RB)); }
            LGKM_WAIT0();
#pragma unroll
            for (int k = 0; k < 4; ++k) { const int kk = 4 * half + k;
                if (kk >= klo && kk <= khi) { const bf16x8 am = *(const LAS bf16x8*)(L + SSD_MS + (32 * it + r32) * SSD_RM + (16 * kk + 8 * h) * 2);
                    acc = __builtin_amdgcn_mfma_f32_32x32x16_bf16(am, PK8(xl[k], xh[k]), acc, 0, 0, 0); }
                accS = __builtin_amdgcn_mfma_f32_32x32x16_bf16(PK8(bl[k], bh[k]), PK8(xl[k], xh[k]), accS, 0, 0, 0); }
          } }
#if DEBUG_SSD
        { bool bn = false, sn = false; for (int r = 0; r < 16; ++r) { bn |= !(acc[r] == acc[r]) || fabsf(acc[r]) > 1e30f; sn |= !(accS[r] == accS[r]) || fabsf(accS[r]) > 1e30f; }
          if (bn) atomicOr((unsigned*)(F.ws + WS_CTL) + 203, 4u); if (sn) atomicOr((unsigned*)(F.ws + WS_CTL) + 203, 8u); }
#endif
        { bf16_t* yp = ydst + ((size_t)dir * TB + c * 128 + 32 * it) * yld + ycol0 + head * 64 + 32 * pt + r32;
#pragma unroll
          for (int r = 0; r < 16; ++r) yp[(size_t)crow32(r, h) * yld] = f2bf(acc[r]); }
        __syncthreads();
#pragma unroll
        for (int q = 0; q < 4; ++q) *(LAS u32x2*)(L + SSD_SS + (32 * pt + r32) * SSD_RS + (32 * it + 8 * q + 4 * h) * 2) = (u32x2){pk2(accS[4 * q], accS[4 * q + 1]), pk2(accS[4 * q + 2], accS[4 * q + 3])};
    }
    __syncthreads();
#undef SSD_ISSUE_MAIN
#undef SSD_ISSUE_C
}


__device__ __forceinline__ int gdn_chunk(int dir, int s) { return dir == 0 ? s : (s < 4 ? 3 - s : 135 - s); }
#define GT_PTR(h_, dir_, c_) (F.ws + AR_GT + ((size_t)((h_) * 2 + (dir_)) * 132 + (c_)) * GT_STRIDE)
__device__ __forceinline__ void gdn_prep_round(Frame& F, int round) {
    LAS float* Aw = (LAS float*)F.lds;
    const int w = F.wave, lane = F.lane, r32 = lane & 31, hh = lane >> 5;
    for (int li = 0; li < 4; ++li) {
        const int item = round * 4 + li; if (item >= 1056) break;
        const int h = item / 132, c = item - h * 132;
        const float* ab = F_ABS + (size_t)(c * 64 + lane) * 64;
        const float gf = ab[48 + h], gb = ab[56 + h], btf = ab[32 + h], btb = ab[40 + h];
        float gcf = gf, gcb = gb;
#pragma unroll
        for (int o = 1; o < 64; o <<= 1) { const float t = __shfl_up(gcf, o); if (lane >= o) gcf += t; const float t2 = __shfl_down(gcb, o); if (lane + o < 64) gcb += t2; }
        const int kind = w >> 2, it = (w >> 1) & 1, jt = w & 1;
        const bf16_t* rowsrc = F_CV + (size_t)(c * 64 + 32 * it + r32) * 4608 + (kind ? 1536 : 2560) + h * 128 + 8 * hh;
        const bf16_t* colsrc = F_CV + (size_t)(c * 64 + 32 * jt + r32) * 4608 + 2560 + h * 128 + 8 * hh;
        bf16x8 fa[8], fb[8];
#pragma unroll
        for (int s8 = 0; s8 < 8; ++s8) { fa[s8] = *(const bf16x8*)(rowsrc + 16 * s8); fb[s8] = *(const bf16x8*)(colsrc + 16 * s8); }
        f32x16 G = {};
#pragma unroll
        for (int s8 = 0; s8 < 8; ++s8) G = __builtin_amdgcn_mfma_f32_32x32x16_bf16(fa[s8], fb[s8], G, 0, 0, 0);
        const int j = 32 * jt + r32; const float gcf_j = __shfl(gcf, j), gcb_j = __shfl(gcb, j);
        bf16_t* qkf = (bf16_t*)(GT_PTR(h, 0, c) + 8192); bf16_t* qkb = (bf16_t*)(GT_PTR(h, 1, c) + 8192);
#pragma unroll
        for (int r = 0; r < 16; ++r) {
            const int i = 32 * it + crow32(r, hh); const float g = G[r];
            const float ef = __expf(fminf(__shfl(gcf, i) - gcf_j, 0.f)), eb = __expf(fminf(__shfl(gcb, i) - gcb_j, 0.f));
            if (kind == 0) { const float bi_f = __shfl(btf, i), bi_b = __shfl(btb, i);
                Aw[((li * 2 + 0) * 64 + i) * 64 + j] = (j < i) ? bi_f * g * ef : 0.f;
                Aw[((li * 2 + 1) * 64 + (63 - i)) * 64 + (63 - j)] = (j > i) ? bi_b * g * eb : 0.f;
            } else {
                qkf[i * 64 + j] = f2bf((j <= i) ? g * ef : 0.f);
                qkb[(63 - i) * 64 + (63 - j)] = f2bf((j >= i) ? g * eb : 0.f);
            }
        }
    }
    __syncthreads();
    {
        const int li = w >> 1, dir = w & 1, item = round * 4 + li;
        if (item < 1056) {
            const int h = item / 132, c = item - h * 132; const int tok = dir ? 63 - lane : lane;
            const float* ab = F_ABS + (size_t)(c * 64 + tok) * 64; const float g = ab[48 + dir * 8 + h], bt = ab[32 + dir * 8 + h];
            float gc = g;
#pragma unroll
            for (int o = 1; o < 64; o <<= 1) { const float t = __shfl_up(gc, o); if (lane >= o) gc += t; }
            const float gl = __shfl(gc, 63);
            float* vec = (float*)(GT_PTR(h, dir, c) + 16384);
            vec[lane] = __expf(gc); vec[64 + lane] = __expf(gl - gc); if (lane == 0) vec[128] = __expf(gl);
            const LAS float* A = Aw + (size_t)w * 64 * 64;
            bf16_t* tb = (bf16_t*)GT_PTR(h, dir, c);
            float x[64];
#pragma unroll
            for (int i = 0; i < 64; ++i) {
                float xi = (lane == i) ? 1.f : 0.f;
#pragma unroll
                for (int j4 = 0; j4 < (i + 3) / 4; ++j4) { const f32x4 a4 = *(const LAS f32x4*)(A + i * 64 + 4 * j4);
#pragma unroll
                    for (int e = 0; e < 4; ++e) if (4 * j4 + e < i) xi = fmaf(-a4[e], x[4 * j4 + e], xi); }
                x[i] = xi;
                tb[i * 64 + lane] = f2bf(xi * bt);
            }
        }
    }
    __syncthreads();
}
constexpr int GL_K = 0, GL_Q = GL_K + 64 * 272, GL_V = GL_Q + 64 * 272, GL_TB = GL_V + 64 * 144, GL_QK = GL_TB + 64 * 144, GL_VEC = GL_QK + 64 * 144, GL_BUF = GL_VEC + 768;
static_assert(2 * GL_BUF <= 131072, "GDN LDS");
__device__ __forceinline__ bf16x8 ld2x8(const LAS unsigned char* p0, const LAS unsigned char* p1) { const u32x2 a = *(const LAS u32x2*)p0, b = *(const LAS u32x2*)p1; u32x4 w = {a[0], a[1], b[0], b[1]}; return *reinterpret_cast<bf16x8*>(&w); }
__device__ __forceinline__ bf16x8 pack2t(const f32x4 t0, const f32x4 t1) { u32x4 w = {pk2(t0[0], t0[1]), pk2(t0[2], t0[3]), pk2(t1[0], t1[1]), pk2(t1[2], t1[3])}; return *reinterpret_cast<bf16x8*>(&w); }
__device__ __forceinline__ void gdn_scan(Frame& F, int h, int dir, int eb, bf16_t* ydst, int yld, int ycol0) {
    const int tid = F.tid, lane = F.lane, w = F.wave, m = lane & 15, q = lane >> 4;
    LAS unsigned char* L = F.lds;
    const int st = tid - 256;
#define GDN_STAGE(cc, bufo) do { const int tokb = (cc) * 64; const unsigned char* gt = GT_PTR(h, dir, (cc)); \
        u32x4 rk[4], rq[4], rv[2], rt[2], rqk[2], rvec = {0u, 0u, 0u, 0u}; \
        _Pragma("unroll") for (int i = 0; i < 4; ++i) { const int p = st + 256 * i, row = p >> 4, c16 = p & 15; const bf16_t* src = F_CV + (size_t)(tokb + (dir ? 63 - row : row)) * 4608 + h * 128 + c16 * 8; \
            rk[i] = *(const u32x4*)(src + 2560); rq[i] = *(const u32x4*)(src + 1536); } \
        _Pragma("unroll") for (int i = 0; i < 2; ++i) { const int p = st + 256 * i, row = p >> 3, c16 = p & 7; \
            rv[i] = *(const u32x4*)(F_CV + (size_t)(tokb + (dir ? 63 - row : row)) * 4608 + 3584 + h * 128 + eb * 64 + c16 * 8); \
            rt[i] = *(const u32x4*)(gt + row * 128 + c16 * 16); rqk[i] = *(const u32x4*)(gt + 8192 + row * 128 + c16 * 16); } \
        if (st < 48) rvec = *(const u32x4*)(gt + 16384 + st * 16); \
        _Pragma("unroll") for (int i = 0; i < 4; ++i) { const int p = st + 256 * i, row = p >> 4, c16 = p & 15; \
            *(LAS u32x4*)(L + (bufo) + GL_K + row * 272 + c16 * 16) = rk[i]; *(LAS u32x4*)(L + (bufo) + GL_Q + row * 272 + c16 * 16) = rq[i]; } \
        _Pragma("unroll") for (int i = 0; i < 2; ++i) { const int p = st + 256 * i, row = p >> 3, c16 = p & 7; \
            *(LAS u32x4*)(L + (bufo) + GL_V + row * 144 + c16 * 16) = rv[i]; *(LAS u32x4*)(L + (bufo) + GL_TB + row * 144 + c16 * 16) = rt[i]; *(LAS u32x4*)(L + (bufo) + GL_QK + row * 144 + c16 * 16) = rqk[i]; } \
        if (st < 48) *(LAS u32x4*)(L + (bufo) + GL_VEC + st * 16) = rvec; } while (0)
    f32x4 S[8];
#pragma unroll
    for (int i = 0; i < 8; ++i) S[i] = (f32x4){0.f, 0.f, 0.f, 0.f};
    if (w >= 4) { GDN_STAGE(gdn_chunk(dir, 0), 0); }
    __syncthreads();
    const int qp = (lane & 15) >> 2, pp = lane & 3;
    for (int s = 0; s < 132; ++s) {
        const int bo = (s & 1) * GL_BUF;
        if (w >= 4) {
            if (s + 1 < 132) { GDN_STAGE(gdn_chunk(dir, s + 1), GL_BUF - bo); }
        } else {
            const int c = gdn_chunk(dir, s), cw = w;
            const LAS unsigned char* Kp = L + bo + GL_K; const LAS unsigned char* Qp = L + bo + GL_Q; const LAS unsigned char* TBp = L + bo + GL_TB; const LAS unsigned char* QKp = L + bo + GL_QK;
            const LAS float* egc = (const LAS float*)(L + bo + GL_VEC); const LAS float* w2 = egc + 64;
            const float egl = egc[128];
            bf16x8 sb[4];
#pragma unroll
            for (int k = 0; k < 4; ++k) sb[k] = pack2t(S[2 * k], S[2 * k + 1]);
            f32x4 KS[4], QS[4];
#pragma unroll
            for (int it = 0; it < 4; ++it) { KS[it] = (f32x4){0.f, 0.f, 0.f, 0.f}; QS[it] = (f32x4){0.f, 0.f, 0.f, 0.f};
#pragma unroll
                for (int k = 0; k < 4; ++k) { const int ro = (16 * it + m) * 272 + (32 * k + 4 * q) * 2;
                    KS[it] = __builtin_amdgcn_mfma_f32_16x16x32_bf16(ld2x8(Kp + ro, Kp + ro + 32), sb[k], KS[it], 0, 0, 0);
                    QS[it] = __builtin_amdgcn_mfma_f32_16x16x32_bf16(ld2x8(Qp + ro, Qp + ro + 32), sb[k], QS[it], 0, 0, 0); } }
            f32x4 eg4[4];
#pragma unroll
            for (int it = 0; it < 4; ++it) eg4[it] = *(const LAS f32x4*)(egc + 16 * it + 4 * q);
            bf16x8 ksb[2], vfr[2];
#pragma unroll
            for (int k = 0; k < 2; ++k) ksb[k] = pack2t(-(eg4[2 * k] * KS[2 * k]), -(eg4[2 * k + 1] * KS[2 * k + 1]));
            { const unsigned vb = (unsigned)(uintptr_t)(F.ldsg + bo + GL_V) + (unsigned)((8 * q + qp) * 144 + (16 * cw + 4 * pp) * 2);
              const s16x4 a0 = tr_read_b64(vb), a1 = tr_read_b64(vb + 4 * 144), b0 = tr_read_b64(vb + 32 * 144), b1 = tr_read_b64(vb + 36 * 144);
              LGKM_WAIT0(); vfr[0] = PK8(a0, a1); vfr[1] = PK8(b0, b1); }
            f32x4 VN[4];
#pragma unroll
            for (int it = 0; it < 4; ++it) { VN[it] = (f32x4){0.f, 0.f, 0.f, 0.f};
#pragma unroll
                for (int k = 0; k < 2; ++k) { const int rn = (16 * it + m) * 144 + (32 * k + 8 * q) * 2, rp = (16 * it + m) * 144 + (32 * k + 4 * q) * 2;
                    VN[it] = __builtin_amdgcn_mfma_f32_16x16x32_bf16(*(const LAS bf16x8*)(TBp + rn), vfr[k], VN[it], 0, 0, 0);
                    VN[it] = __builtin_amdgcn_mfma_f32_16x16x32_bf16(ld2x8(TBp + rp, TBp + rp + 32), ksb[k], VN[it], 0, 0, 0); } }
            bf16x8 vnb[2], vnw[2];
#pragma unroll
            for (int k = 0; k < 2; ++k) { vnb[k] = pack2t(VN[2 * k], VN[2 * k + 1]);
                const f32x4 wa = *(const LAS f32x4*)(w2 + 32 * k + 4 * q), wb = *(const LAS f32x4*)(w2 + 32 * k + 16 + 4 * q); vnw[k] = pack2t(wa * VN[2 * k], wb * VN[2 * k + 1]); }
#pragma unroll
            for (int it = 0; it < 4; ++it) { f32x4 o = eg4[it] * QS[it];
#pragma unroll
                for (int k = 0; k < 2; ++k) { const int rp = (16 * it + m) * 144 + (32 * k + 4 * q) * 2; o = __builtin_amdgcn_mfma_f32_16x16x32_bf16(ld2x8(QKp + rp, QKp + rp + 32), vnb[k], o, 0, 0, 0); }
#pragma unroll
                for (int r = 0; r < 4; ++r) { const int ip = 16 * it + 4 * q + r, tok = c * 64 + (dir ? 63 - ip : ip);
                    ydst[((size_t)dir * TB + tok) * yld + ycol0 + h * 128 + eb * 64 + 16 * cw + m] = f2bf(o[r]); } }
            { const unsigned kb = (unsigned)(uintptr_t)(F.ldsg + bo + GL_K) + (unsigned)((4 * q + qp) * 272 + (4 * pp) * 2);
#pragma unroll
              for (int dt = 0; dt < 8; ++dt) {
                  const s16x4 a0 = tr_read_b64(kb + dt * 32), a1 = tr_read_b64(kb + dt * 32 + 16 * 272), b0 = tr_read_b64(kb + dt * 32 + 32 * 272), b1 = tr_read_b64(kb + dt * 32 + 48 * 272);
                  LGKM_WAIT0();
                  f32x4 sn = S[dt] * egl;
                  sn = __builtin_amdgcn_mfma_f32_16x16x32_bf16(PK8(a0, a1), vnw[0], sn, 0, 0, 0);
                  sn = __builtin_amdgcn_mfma_f32_16x16x32_bf16(PK8(b0, b1), vnw[1], sn, 0, 0, 0);
                  S[dt] = sn; } }
        }
        __syncthreads();
    }
#undef GDN_STAGE
}
__device__ __forceinline__ void trread_selftest(Frame& F) {
    if (F.bid != 0) return;
    LAS unsigned short* tile = (LAS unsigned short*)(F.lds + 65536);
    for (int i = F.tid; i < 32 * 32; i += NTHREADS) tile[i] = (unsigned short)i;
    __syncthreads();
    if (F.wave == 1) {
        const int lane = F.lane, h = lane >> 5; const unsigned trq = (unsigned)(8 * h + ((lane & 15) >> 2)), trc = (unsigned)((16 * ((lane >> 4) & 1) + 4 * (lane & 3)) * 2);
        const unsigned vb = (unsigned)(uintptr_t)(F.ldsg + 65536) + trq * 64 + trc;
        const s16x4 lo = tr_read_b64(vb), hi = tr_read_b64(vb + 4 * 64);
        LGKM_WAIT0();
        bool bad = false;
#pragma unroll
        for (int e = 0; e < 4; ++e) { bad |= ((unsigned short)lo[e] != (unsigned short)((8 * h + e) * 32 + (lane & 31))); bad |= ((unsigned short)hi[e] != (unsigned short)((8 * h + 4 + e) * 32 + (lane & 31))); }
        if (bad) atomicOr((unsigned*)(F.ws + WS_CTL) + 200, 1u);
    }
    __syncthreads();
}
__device__ __forceinline__ void phase_finish(Frame& F, int b) {
    const int gw = F.bid * 8 + F.wave, NGW = F.G * 8;
    for (int it = gw; it < TB * 10; it += NGW) {
        const int u = it / 10, k = it - u * 10;
        if (k < 2) {
            const int c0 = k * 512 + F.lane * 8; float y[8]; float ss = 0.f;
#pragma unroll
            for (int j = 0; j < 8; ++j) { const int c = c0 + j; const float xs = bf2f(F_CV[(size_t)u * 4608 + c]), z = bf2f(F_ZG[(size_t)u * 2048 + c]);
                y[j] = (bf2f(F_YD[(size_t)u * 2048 + c]) + bf2f(F_YD[((size_t)TB + u) * 2048 + c]) + xs * F.in[I_SD][c >> 6]) * silu_f(z); ss += y[j] * y[j]; }
            const float rstd = 1.0f / sqrtf(wave_sum(ss) * (1.f / 512.f) + NEPS);
#pragma unroll
            for (int j = 0; j < 8; ++j) F_Y[(size_t)u * 2048 + c0 + j] = f2bf(y[j] * rstd * F.in[I_SNORM][c0 + j]);
        } else {
            const int h = k - 2, e0 = F.lane * 2; float y[2]; float ss = 0.f;
#pragma unroll
            for (int j = 0; j < 2; ++j) { y[j] = bf2f(F_YD[(size_t)u * 2048 + 1024 + h * 128 + e0 + j]) + bf2f(F_YD[((size_t)TB + u) * 2048 + 1024 + h * 128 + e0 + j]); ss += y[j] * y[j]; }
            const float rstd = 1.0f / sqrtf(wave_sum(ss) * (1.f / 128.f) + NEPS);
#pragma unroll
            for (int j = 0; j < 2; ++j) { const float gt = bf2f(F_ZG[(size_t)u * 2048 + 1024 + h * 128 + e0 + j]);
                F_Y[(size_t)u * 2048 + 1024 + h * 128 + e0 + j] = f2bf(y[j] * rstd * F.in[I_GNORM][e0 + j] * silu_f(gt)); }
        }
    }
}
__device__ __forceinline__ void phase_qknorm_rope(Frame& F) {
    const int gw = F.bid * 8 + F.wave, NGW = F.G * 8;
    const int j = F.lane; const float invf = exp2f(-(float)(j & 31) * (13.287712379549449f / 32.f));
    for (int it = gw; it < TT * 12; it += NGW) {
        const int r = it / 12, hs = it - r * 12; const int b = r / TB, u = r - b * TB; const bool isctx = u < CTXL;
        if (isctx && hs < 8) continue;
        bf16_t* p = F_QKV + (size_t)r * 2048 + hs * 128; const float* w = hs < 8 ? F.in[I_QNORM] : F.in[I_KNORM];
        const float x1 = bf2f(p[j]), x2 = bf2f(p[j + 64]);
        const float rstd = 1.0f / sqrtf(wave_sum(x1 * x1 + x2 * x2) * (1.f / 128.f) + NEPS);
        float n1 = x1 * rstd * w[j], n2 = x2 * rstd * w[j + 64];
        if (!isctx) { const int t = u - CTXL; const float pos = (float)(j < 32 ? (t >> 6) : (t & 63)); const float ang = pos * invf;
            const float rev = ang * 0.15915494309189535f; const float fr = rev - rintf(rev);
            const float cs = __builtin_amdgcn_cosf(fr), sn = __builtin_amdgcn_sinf(fr);
            const float o1 = n1 * cs - n2 * sn, o2 = n2 * cs + n1 * sn; n1 = o1; n2 = o2; }
        p[j] = f2bf(n1); p[j + 64] = f2bf(n2);
    }
}
__device__ __forceinline__ void phase_attention(Frame& F) {
    for (int un = F.bid; un < 512; un += F.G) {
        const int qb = un & 31, hq = (un >> 5) & 7, b = un >> 8, kh = hq >> 1;
        const bf16_t* Qb = F_QKV + (size_t)(b * TB + CTXL + qb * 256) * 2048 + hq * 128;
        const bf16_t* Kh = F_QKV + (size_t)(b * TB) * 2048 + 1024 + kh * 128;
        const bf16_t* Vh = F_QKV + (size_t)(b * TB) * 2048 + 1536 + kh * 128;
        bf16_t* Ob = F_AO + (size_t)(b * TB + CTXL + qb * 256) * DM + hq * 128;
        att::attn_dense_body(Qb, Kh, Vh, Ob, TB, (char*)F.ldsg, F.tid);
        __syncthreads();
    }
}

constexpr int LDS_BYTES = 147456;
constexpr int MISC_OFF = 131072;

__global__ void __launch_bounds__(NTHREADS, 2) mk_fwd(Args args) {
    extern __shared__ __attribute__((aligned(16))) unsigned char lds_raw[];
    Frame F;
    F.in = args.in; F.out = args.out; F.ws = args.ws; F.dxc = (float*)(args.ws + WS_XC) - args.out; F.dcin = args.in[I_CTX] - args.in[I_X];
    F.lds = (LAS unsigned char*)lds_raw; F.ldsg = lds_raw;
    F.tid = threadIdx.x; F.lane = F.tid & 63; F.wave = __builtin_amdgcn_readfirstlane(F.tid >> 6); F.G = gridDim.x; F.bid = blockIdx.x;
    volatile LAS unsigned* MISC = (volatile LAS unsigned*)(F.lds + MISC_OFF);
    if (F.tid < 64) MISC[F.tid] = 0u;
    __syncthreads();
    XcdBarrier bar = xcd_barrier_post((unsigned*)(args.ws + WS_CTL), MISC + 8);
    const int lo = args.ph_lo, hi = args.ph_hi; int ph = 0;
#define LAUNDER_PTR(T, dst, src) do { unsigned long long v_ = (unsigned long long)(src); unsigned lo_ = (unsigned)v_, hi_ = (unsigned)(v_ >> 32), lo2_, hi2_; \
        asm volatile("s_mov_b32 %0, %2\n\ts_mov_b32 %1, %3" : "=s"(lo2_), "=s"(hi2_) : "s"(lo_), "s"(hi_)); dst = (T)(((unsigned long long)hi2_ << 32) | lo2_); } while (0)
#define PH_BEGIN if (ph >= lo && ph < hi) { F.tid = threadIdx.x; asm volatile("" : "+v"(F.tid)); F.lane = F.tid & 63; F.wave = __builtin_amdgcn_readfirstlane(F.tid >> 6); \
        LAUNDER_PTR(unsigned char*, F.ws, args.ws); LAUNDER_PTR(float*, F.out, args.out); F.bid = blockIdx.x; F.G = gridDim.x; asm volatile("" : "+s"(F.bid), "+s"(F.G));
#define PH_END   if (ph + 1 < hi) xcd_barrier(bar); } ++ph;

    PH_BEGIN phase_modtab(F); trread_selftest(F); PH_END
    unsigned char* wb = F.ws + WS_W;
#define GEMM(EPI, A_, B_, K_, nM_, nN_, pm0_, mode_) do { pg8::Gemm g_{(const bf16_t*)(A_), (const bf16_t*)(B_), (K_)}; pg8::Order S_; S_.init((nM_), (nN_), F.G, F.bid, (pm0_), (mode_)); pg8::gemm_phase(F.lds, g_, S_, EPI, F.tid); } while (0)
    for (int l = 0; l < 2; ++l) {
        const float* mt = F_MT + l * 3 * 9216;
        PH_BEGIN phase_convert(F, l); phase_norm(F, l, 0, l == 0, false); PH_END
        PH_BEGIN { pg8::EpiSwigluP E{F_HID}; GEMM(E, F_HN, wb + W_FFIN0, DM, 66, 22, 0, 0); } PH_END
        PH_BEGIN { pg8::EpiResidP E{l == 0 ? F.in[I_X] : F.out, l == 0 ? F.dcin : F.dxc, F.out, F.dxc, mt, 2, 0.5f}; GEMM(E, F_HID, wb + W_FFOUT0, DFF, 66, 4, 0, 0); } PH_END
        PH_BEGIN phase_norm(F, l, 1, false, false); PH_END
        if (l == 0) {
            for (int b = 0; b < NBATCH; ++b) {
                PH_BEGIN { pg8::EpiABP E{F_ZG, F_RAW, F_ABS, b * TB}; GEMM(E, F_HN, wb + W_MIXIN, DM, 33, 27, b * 33, 0); } PH_END
                PH_BEGIN phase_conv(F, b); PH_END
                PH_BEGIN { for (int it_ = F.bid; it_ < 132; it_ += F.G) ssd_prep_item(F, it_ / 66, it_ % 66); } PH_END
                PH_BEGIN { for (int rd_ = F.bid; rd_ < 264; rd_ += F.G) gdn_prep_round(F, rd_); } PH_END
#if DEBUG_GDN
                PH_BEGIN { if (F.bid < 32) ssd_scan(F, F.bid >> 1, F.bid & 1, F_YD, 2048, 0); else if (F.bid < 40) gdn_naive(F, F.bid - 32); } PH_END
                PH_BEGIN { if (F.bid < 32) gdn_scan(F, F.bid >> 2, (F.bid >> 1) & 1, F.bid & 1, (bf16_t*)(F.ws + WS_TEST), 1024, 0); } PH_END
                PH_BEGIN { unsigned* dg = (unsigned*)(F.ws + WS_CTL) + 200; float mx = 0.f; unsigned nn = 0; const bf16_t* tst = (const bf16_t*)(F.ws + WS_TEST);
                    for (size_t i = (size_t)F.bid * NTHREADS + F.tid; i < (size_t)2 * TB * 1024; i += (size_t)F.G * NTHREADS) { const size_t d = i / ((size_t)TB * 1024), rem = i - d * (size_t)TB * 1024, u = rem >> 10, cc = rem & 1023;
                        const float a = bf2f(tst[i]), bb = bf2f(F_YD[(d * TB + u) * 2048 + 1024 + cc]); const float df = fabsf(a - bb) / (fabsf(bb) + 0.05f); if (!(df == df) || df > 1e30f) ++nn; else mx = fmaxf(mx, df); }
                    atomicMax(dg + 1, __float_as_uint(mx)); if (nn) atomicAdd(dg + 2, nn); } PH_END
#else
                PH_BEGIN { if (F.bid < 32) ssd_scan(F, F.bid >> 1, F.bid & 1, F_YD, 2048, 0); else if (F.bid < 64) { const int g_ = F.bid - 32; gdn_scan(F, g_ >> 2, (g_ >> 1) & 1, g_ & 1, F_YD, 2048, 1024); } } PH_END
#endif
                PH_BEGIN phase_finish(F, b); PH_END
                PH_BEGIN { pg8::EpiResidP E{F.out, F.dxc, F.out, F.dxc, mt, 5, 1.0f}; GEMM(E, F_Y - (size_t)b * TB * 2048, wb + W_MIXOUT, 2048, 33, 4, b * 33, 0); } PH_END
            }
        } else {
            PH_BEGIN { pg8::EpiBf16P E{F_QKV, 2048}; GEMM(E, F_HN, wb + W_MIXIN, DM, 66, 8, 0, 0); } PH_END
            PH_BEGIN phase_qknorm_rope(F); PH_END
#ifndef NO_ATT
            PH_BEGIN phase_attention(F); PH_END
#endif
            PH_BEGIN { pg8::EpiResidP E{F.out, F.dxc, F.out, F.dxc, mt, 5, 1.0f}; GEMM(E, F_AO, wb + W_MIXOUT, DM, 64, 4, 0, 1); } PH_END
        }
        const bool skipc = (l == 1);
        PH_BEGIN phase_norm(F, l, 2, false, skipc); PH_END
        PH_BEGIN { pg8::EpiSwigluP E{F_HID}; GEMM(E, F_HN, wb + W_FFIN1, DM, skipc ? 64 : 66, 22, 0, skipc ? 1 : 0); } PH_END
        PH_BEGIN { pg8::EpiResidP E{F.out, F.dxc, F.out, F.dxc, mt, 8, 0.5f}; GEMM(E, F_HID, wb + W_FFOUT1, DFF, skipc ? 64 : 66, 4, 0, skipc ? 1 : 0); } PH_END
    }
#undef GEMM
    if (F.bid == 0 && threadIdx.x == 0 && hi > 900) { __builtin_amdgcn_s_waitcnt(0); unsigned* dg = (unsigned*)(F.ws + WS_CTL) + 200; const unsigned st = __hip_atomic_load(dg, __ATOMIC_RELAXED, __HIP_MEMORY_SCOPE_AGENT);
        float poison = st ? 100.f : 0.f;
#if DEBUG_GDN
        const float mx = __uint_as_float(__hip_atomic_load(dg + 1, __ATOMIC_RELAXED, __HIP_MEMORY_SCOPE_AGENT)); const unsigned nn = __hip_atomic_load(dg + 2, __ATOMIC_RELAXED, __HIP_MEMORY_SCOPE_AGENT);
        const unsigned bits = __hip_atomic_load(dg + 3, __ATOMIC_RELAXED, __HIP_MEMORY_SCOPE_AGENT); const int code = nn ? (int)(16 + bits) : (mx < 0.03f ? 0 : (mx < 0.1f ? 1 : (mx < 0.5f ? 2 : (mx < 2.f ? 3 : 4)))); poison += 1000.f * (1 + code);
#endif
        if (poison != 0.f) F.out[0] += poison; }
#undef PH_BEGIN
#undef PH_END
}

extern "C" void kernel_launch(void* const* d_in, const int* in_sizes, int n_in, void* d_out, int out_size, void* d_ws, size_t ws_size, hipStream_t stream) {
    static int grid = 0;
    if (grid == 0) {
        if (n_in != 25 || out_size != NBATCH * SEQ * DM || ws_size < WS_END) { fprintf(stderr, "kernel_launch: unexpected shapes (n_in %d out %d ws %zu need %zu)\n", n_in, out_size, ws_size, (size_t)WS_END); grid = -1; return; }
        int dev = 0, cus = 0, per_cu = 0;
        if (hipGetDevice(&dev) != hipSuccess || hipDeviceGetAttribute(&cus, hipDeviceAttributeMultiprocessorCount, dev) != hipSuccess) { grid = -1; return; }
        if (hipFuncSetAttribute((const void*)mk_fwd, hipFuncAttributeMaxDynamicSharedMemorySize, LDS_BYTES) != hipSuccess) { fprintf(stderr, "kernel_launch: hipFuncSetAttribute failed\n"); grid = -1; return; }
        if (hipOccupancyMaxActiveBlocksPerMultiprocessor(&per_cu, (const void*)mk_fwd, NTHREADS, LDS_BYTES) != hipSuccess || per_cu < 1) { fprintf(stderr, "kernel_launch: occupancy query says %d blocks per CU\n", per_cu); grid = -1; (void)hipGetLastError(); return; }
        grid = cus;
    }
    if (grid < 0) return;
    (void)hipMemsetAsync((char*)d_ws + WS_CTL, 0, CTL_BYTES, stream);
    Args a{};
    for (int i = 0; i < 25; ++i) a.in[i] = (const float*)d_in[i];
    a.out = (float*)d_out; a.ws = (unsigned char*)d_ws; a.ph_lo = 0; a.ph_hi = 1000;
    hipLaunchKernelGGL(mk_fwd, dim3(grid), dim3(NTHREADS), LDS_BYTES, stream, a);
    const hipError_t le = hipPeekAtLastError();
    if (le != hipSuccess) fprintf(stderr, "kernel_launch: launch failed: %s\n", hipGetErrorName(le));
}
```

```cpp
#include <hip/hip_runtime.h>
#include <cstdio>
#include <cstdint>

#define LAS __attribute__((address_space(3)))
typedef unsigned short bf16_t;
typedef short bf16x8 __attribute__((ext_vector_type(8)));
typedef short s16x4 __attribute__((ext_vector_type(4)));
typedef float f32x4 __attribute__((ext_vector_type(4)));
typedef float f32x8 __attribute__((ext_vector_type(8)));
typedef float f32x16 __attribute__((ext_vector_type(16)));
typedef unsigned u32x4 __attribute__((ext_vector_type(4)));
typedef unsigned u32x2 __attribute__((ext_vector_type(2)));

#define DEBUG_SSD 0
#define REP_ATT 1
#define REP_SWIGLU 1
#define REP_NORM 1
#define EXTRA_SSD 0
#define EXTRA_GDN 0
#define TIMING 0
#define TA0 28
#define TA1 29
#define TB0 0
#define TB1 0
#define DEBUG_GDN 0
#if DEBUG_SSD || DEBUG_GDN
#define NO_ATT 1
#endif
constexpr int DM = 1024, NBATCH = 2, SEQ = 8192, CTXL = 256, TB = SEQ + CTXL  , TT = NBATCH * TB, DFF = 2816;
constexpr int NTHREADS = 512;
constexpr float NEPS = 1e-6f;

constexpr size_t AL(size_t x) { return (x + 255) / 256 * 256; }
constexpr size_t WS_CTL = 0;
constexpr size_t CTL_BYTES = 65536;
constexpr size_t WS_MT = WS_CTL + CTL_BYTES;
constexpr size_t WS_MTP = WS_MT + AL((size_t)2 * 3 * 9216 * 4);
constexpr size_t WS_XC = WS_MTP + AL((size_t)2 * 16 * 3 * 9216 * 4);
constexpr size_t WS_RSP = WS_XC + AL((size_t)2 * CTXL * DM * 4);
constexpr size_t WS_BIAS = WS_RSP + AL((size_t)TT * 16 * 4);
constexpr size_t WS_HN = WS_BIAS + AL((size_t)2 * 3 * 6912 * 4);
constexpr size_t WS_W  = WS_HN + AL((size_t)TT * DM * 2);
constexpr size_t W_FFIN0 = 0, W_FFOUT0 = W_FFIN0 + (size_t)2 * DFF * DM * 2, W_FFIN1 = W_FFOUT0 + (size_t)DM * DFF * 2, W_FFOUT1 = W_FFIN1 + (size_t)2 * DFF * DM * 2,
                 W_MIXIN = W_FFOUT1 + (size_t)DM * DFF * 2, W_MIXOUT = W_MIXIN + (size_t)6912 * DM * 2, W_BYTES = W_MIXOUT + (size_t)DM * 2048 * 2;
constexpr size_t WS_AR = WS_W + AL(W_BYTES);
constexpr size_t AR_HID = WS_AR;
constexpr size_t AR_ZG  = WS_AR;
constexpr size_t AR_RAW = AR_ZG + AL((size_t)TB * 2048 * 2);
constexpr size_t AR_YD  = AR_RAW;
constexpr size_t AR_Y   = AR_YD;
constexpr size_t AR_GSEG = AR_YD + (size_t)2 * TB * 2048 * 2;
static_assert((size_t)16 * 3 * 65536 * 2 + (size_t)16 * 2 * 32768 <= (size_t)TB * 4608 * 2 - (size_t)2 * TB * 2048 * 2, "segment buffers must fit behind Yd");
constexpr size_t AR_ABS = AR_RAW + AL((size_t)TB * 4608 * 2);
constexpr size_t AR_CV  = AR_ABS + AL((size_t)TB * 64 * 4);
constexpr size_t AR_CB  = AR_CV + AL((size_t)TB * 4608 * 2);
constexpr size_t AR_GT  = AR_CB + AL((size_t)2 * 66 * 128 * 128 * 2);
constexpr size_t GT_STRIDE = 8192 + 8192 + 768;
constexpr size_t AR_SST = AR_GT + AL((size_t)8 * 2 * 132 * GT_STRIDE);
constexpr size_t AR_SEL = AR_SST + AL((size_t)32 * 66 * 8192 * 2);
constexpr size_t AR_END0 = AR_SEL + AL((size_t)32 * 66 * 4);
constexpr size_t WS_DBG = 0;
constexpr size_t AR_QKV = WS_AR;
constexpr size_t AR_AO  = AR_QKV + AL((size_t)TT * 2048 * 2);
constexpr size_t AR_X16F = AR_AO + AL((size_t)TT * DM * 2);
constexpr size_t AR_END1 = AR_X16F + AL((size_t)NBATCH * SEQ * DM * 2);
constexpr size_t WS_END0 = AR_END0 > AR_END1 ? AR_END0 : AR_END1;
constexpr size_t WS_TEST = WS_END0;
constexpr size_t WS_END = WS_END0 + (DEBUG_GDN ? AL((size_t)2 * TB * 1024 * 2) : 0);

typedef float f32x2_t __attribute__((ext_vector_type(2)));
typedef __bf16 bf16x2_t __attribute__((ext_vector_type(2)));
__device__ __forceinline__ unsigned pk2(float lo, float hi) { f32x2_t v = {lo, hi}; bf16x2_t b = __builtin_convertvector(v, bf16x2_t); return *reinterpret_cast<unsigned*>(&b); }
__device__ __forceinline__ bf16_t f2bf(float f) { return (bf16_t)(pk2(f, 0.f) & 0xffffu); }
__device__ __forceinline__ float bf2f(bf16_t b) { return __uint_as_float(((unsigned)b) << 16); }
typedef _Float16 h16;
typedef _Float16 h16x2_t __attribute__((ext_vector_type(2)));
__device__ __forceinline__ unsigned pkh2(float lo, float hi) { f32x2_t v = {lo, hi}; h16x2_t h = __builtin_convertvector(v, h16x2_t); return __builtin_bit_cast(unsigned, h); }
__device__ __forceinline__ f32x2_t unh2(unsigned w) { return __builtin_convertvector(__builtin_bit_cast(h16x2_t, w), f32x2_t); }
__device__ __forceinline__ void st_nt(void* p, u32x4 v) { __builtin_nontemporal_store(v, (u32x4*)p); }
__device__ __forceinline__ void st_ntf(void* p, f32x4 v) { __builtin_nontemporal_store(v, (f32x4*)p); }
__device__ __forceinline__ float bflo(unsigned w) { return __uint_as_float(w << 16); }
__device__ __forceinline__ float bfhi(unsigned w) { return __uint_as_float(w & 0xffff0000u); }
__device__ __forceinline__ float silu_f(float x) { return x * __builtin_amdgcn_rcpf(1.f + __expf(-x)); }
__device__ __forceinline__ float softplus_f(float x) { return fmaxf(x, 0.f) + __logf(1.f + __expf(-fabsf(x))); }
__device__ __forceinline__ float sigmoid_f(float x) { return __builtin_amdgcn_rcpf(1.f + __expf(-x)); }
#define LAUNDER_PTR(T, AS_, dst, src) do { unsigned long long v_ = (unsigned long long)(src); unsigned lo_ = (unsigned)v_, hi_ = (unsigned)(v_ >> 32), lo2_, hi2_; \
        asm volatile("s_mov_b32 %0, %2\n\ts_mov_b32 %1, %3" : "=s"(lo2_), "=s"(hi2_) : "s"(lo_), "s"(hi_)); dst = (T)(__attribute__((address_space(AS_))) char*)(((unsigned long long)hi2_ << 32) | lo2_); } while (0)
__device__ __forceinline__ float wave_sum(float v) {
#pragma unroll
    for (int o = 1; o < 64; o <<= 1) v += __shfl_xor(v, o);
    return v;
}

#define XB_TMO      128
#define XB_XCNT(j)  (256  + 64 * (j))
#define XB_XSUB(j)  (1280 + 64 * (j))
#define XB_XGEN(j)  (2304 + 64 * (j))
#define XB_TOP      3328
#define XB_TOPGEN   3392
#define XCD_BAR_WORDS 3456
#define XB_SPIN_CAP (1u << 24)
__device__ __forceinline__ unsigned xb_ld(unsigned* p)              { return __hip_atomic_load(p, __ATOMIC_RELAXED, __HIP_MEMORY_SCOPE_AGENT); }
__device__ __forceinline__ unsigned xb_add(unsigned* p, unsigned v) { return __hip_atomic_fetch_add(p, v, __ATOMIC_RELAXED, __HIP_MEMORY_SCOPE_AGENT); }
__device__ __forceinline__ unsigned xb_xcc_id() { return (unsigned)__builtin_amdgcn_s_getreg((3 << 11) | 20) & 0xFu; }
#define XB_SPIN(cond, bar) do { unsigned _sp = 0; while (cond) { __builtin_amdgcn_s_sleep(16); \
    if ((++_sp & 255u) == 0u) { if (xb_ld(&(bar)[XB_TMO])) break; if (_sp > XB_SPIN_CAP) { atomicAdd(&(bar)[XB_TMO], 1u); break; } } } } while (0)
struct XcdBarrier { unsigned* bar; unsigned x; volatile LAS unsigned* st; };
__device__ __forceinline__ XcdBarrier xcd_barrier_post(unsigned* bar, volatile LAS unsigned* st, int tid) {
    XcdBarrier b; b.bar = bar; b.x = xb_xcc_id(); b.st = st;
    if (tid == 0) (void)xb_add(&bar[XB_XCNT(b.x)], 1u);
    return b;
}
__device__ __forceinline__ void xcd_barrier_complete(unsigned* bar, unsigned x, unsigned& nloc, unsigned& nx) {
    const unsigned G = gridDim.x * gridDim.y * gridDim.z;
    unsigned sum, cnt, mine, sp = 0u;
    for (;;) {
        sum = 0u; cnt = 0u; mine = 0u;
#pragma unroll
        for (unsigned j = 0; j < 16; ++j) { const unsigned c = xb_ld(&bar[XB_XCNT(j)]); sum += c; cnt += (c > 0u) ? 1u : 0u; mine = (j == x) ? c : mine; }
        if (sum == G) break;
        __builtin_amdgcn_s_sleep(1);
        if ((++sp & 255u) == 0u) { if (xb_ld(&bar[XB_TMO])) break; if (sp > XB_SPIN_CAP) { atomicAdd(&bar[XB_TMO], 1u); break; } }
    }
    nloc = mine > 0u ? mine : 1u; nx = cnt > 0u ? cnt : 1u;
}
__device__ __forceinline__ void xcd_barrier(const XcdBarrier& b, int wave_s) {
    asm volatile("s_waitcnt vmcnt(0)" ::: "memory");
    __syncthreads();
    int lid_; asm volatile("v_mbcnt_lo_u32_b32 %0, -1, 0\n\tv_mbcnt_hi_u32_b32 %0, -1, %0" : "=v"(lid_));
    if (wave_s == 0 && lid_ == 0) {
        unsigned* bar = b.bar;
        __builtin_amdgcn_s_waitcnt(0);
        unsigned nloc = b.st[0], nx = b.st[1];
        if (nloc == 0u) { xcd_barrier_complete(bar, b.x, nloc, nx); b.st[0] = nloc; b.st[1] = nx; }
        const unsigned old = xb_add(&bar[XB_XSUB(b.x)], 1u);
        const unsigned gen = old / nloc;
        if (old + 1u == (gen + 1u) * nloc) {
            __builtin_amdgcn_fence(__ATOMIC_RELEASE, "agent");
            asm volatile("s_waitcnt vmcnt(0)" ::: "memory");
            const unsigned og = xb_add(&bar[XB_TOP], 1u);
            const unsigned tg = og / nx;
            if (og + 1u == (tg + 1u) * nx) xb_add(&bar[XB_TOPGEN], 1u);
            else XB_SPIN(xb_ld(&bar[XB_TOPGEN]) == tg, bar);
            __builtin_amdgcn_fence(__ATOMIC_ACQUIRE, "agent");
            xb_add(&bar[XB_XGEN(b.x)], 1u);
            asm volatile("s_waitcnt vmcnt(0)" ::: "memory");
        } else {
            XB_SPIN(xb_ld(&bar[XB_XGEN(b.x)]) == gen, bar);
            __builtin_amdgcn_fence(__ATOMIC_ACQUIRE, "agent");
            asm volatile("s_waitcnt vmcnt(0)" ::: "memory");
        }
    }
    __syncthreads();
}

struct Args { const float* in[25]; float* out; unsigned char* ws; int ph_lo, ph_hi; };
enum { I_X = 0, I_C, I_CTX, I_CCTX, I_WMOD, I_BMOD, I_NORMG, I_WFFIN, I_WFFOUT, I_ABWIN, I_SCONVW, I_SCONVB, I_SALOG, I_SDTB, I_SD, I_SNORM,
       I_GCONVW, I_GALOG, I_GDTB, I_GNORM, I_ABWOUT, I_WQKV, I_QNORM, I_KNORM, I_WO };

typedef const float* cfp_t;
typedef const __attribute__((address_space(4))) cfp_t* KIN;
struct Frame {
    KIN in; float* out; unsigned char* ws; long dxc, dcin;
    LAS unsigned char* lds; unsigned char* ldsg;
    int tid, lane, wave, G, bid;
};
#define F_MT   ((float*)(F.ws + WS_MT))
#define F_XC   ((float*)(F.ws + WS_XC))
#define F_X16L ((h16*)F.out)
#define F_X16C ((h16*)(F.ws + WS_XC))
#define F_X16F ((h16*)(F.ws + AR_X16F))
#define F_DXC16 ((long)(F_X16C - F_X16L))
#define F_RSP  ((float*)(F.ws + WS_RSP))
#define F_BIAS ((float*)(F.ws + WS_BIAS))
#define F_HN   ((bf16_t*)(F.ws + WS_HN))
#define F_HID  ((bf16_t*)(F.ws + AR_HID))
#define F_ZG   ((bf16_t*)(F.ws + AR_ZG))
#define F_RAW  ((bf16_t*)(F.ws + AR_RAW))
#define F_YD   ((bf16_t*)(F.ws + AR_YD))
#define F_CB   ((bf16_t*)(F.ws + AR_CB))
#define F_GT   ((bf16_t*)(F.ws + AR_GT))
#define F_SST  ((bf16_t*)(F.ws + AR_SST))
#define F_SEL  ((float*)(F.ws + AR_SEL))
#define F_GBT  ((float*)(F.ws + AR_GSEG))
#define F_GPH  ((bf16_t*)(F.ws + AR_GSEG + (size_t)16 * 3 * 65536))
#define F_GSS  ((float*)(F.ws + AR_GSEG + (size_t)16 * 3 * 65536 + (size_t)16 * 2 * 32768))
#define F_ABS  ((float*)(F.ws + AR_ABS))
#define F_CV   ((bf16_t*)(F.ws + AR_CV))
#define F_Y    ((bf16_t*)(F.ws + AR_Y))
#define F_QKV  ((bf16_t*)(F.ws + AR_QKV))
#define F_AO   ((bf16_t*)(F.ws + AR_AO))
__device__ __forceinline__ long xoff(int r, long dctx, bool& isctx) { const int b = r / TB, u = r - b * TB; isctx = u < CTXL; return isctx ? dctx + (long)(b * CTXL + u) * DM : (long)(b * SEQ + u - CTXL) * DM; }

template <bool DUAL, class Epi>
__device__ __forceinline__ void sgemm(Frame& F, const bf16_t* A, int lda, const float* W, int ldw, int dual_off, int row0, int nrows, int N, int K, bool skip_ctx, const Epi& epi) {
    LAS bf16_t* sA = (LAS bf16_t*)F.lds; LAS bf16_t* sB = sA + 128 * 40; LAS bf16_t* sB2 = sB + 64 * 40;
    const int tid = F.tid, lane = F.lane, wid = F.wave;
    const int ntn = N / 64, ntiles = (nrows / 128) * ntn;
    for (int t = F.bid; t < ntiles; t += F.G) {
        const int tm = t / ntn, tn = t - tm * ntn, m0 = row0 + tm * 128, n0 = tn * 64;
        if (skip_ctx && (m0 % TB) < CTXL) continue;
        f32x4 acc[4], acc2[4];
#pragma unroll
        for (int j = 0; j < 4; ++j) { acc[j] = (f32x4){0.f, 0.f, 0.f, 0.f}; acc2[j] = (f32x4){0.f, 0.f, 0.f, 0.f}; }
        for (int k0 = 0; k0 < K; k0 += 32) {
            { const int r = tid >> 2, kq = (tid & 3) * 8; const u32x4 v = *(const u32x4*)(A + (size_t)(m0 + r) * lda + k0 + kq); *(LAS u32x4*)(sA + r * 40 + kq) = v; }
            { const int k = tid >> 4, n4 = (tid & 15) * 4; const f32x4 w = *(const f32x4*)(W + (size_t)(k0 + k) * ldw + n0 + n4);
              sB[(n4 + 0) * 40 + k] = f2bf(w[0]); sB[(n4 + 1) * 40 + k] = f2bf(w[1]); sB[(n4 + 2) * 40 + k] = f2bf(w[2]); sB[(n4 + 3) * 40 + k] = f2bf(w[3]);
              if (DUAL) { const f32x4 w2 = *(const f32x4*)(W + (size_t)(k0 + k) * ldw + n0 + n4 + dual_off);
                  sB2[(n4 + 0) * 40 + k] = f2bf(w2[0]); sB2[(n4 + 1) * 40 + k] = f2bf(w2[1]); sB2[(n4 + 2) * 40 + k] = f2bf(w2[2]); sB2[(n4 + 3) * 40 + k] = f2bf(w2[3]); } }
            __syncthreads();
            const bf16x8 a = *(const LAS bf16x8*)(sA + (16 * wid + (lane & 15)) * 40 + 8 * (lane >> 4));
#pragma unroll
            for (int j = 0; j < 4; ++j) { const bf16x8 b = *(const LAS bf16x8*)(sB + (16 * j + (lane & 15)) * 40 + 8 * (lane >> 4));
                acc[j] = __builtin_amdgcn_mfma_f32_16x16x32_bf16(a, b, acc[j], 0, 0, 0);
                if (DUAL) { const bf16x8 b2 = *(const LAS bf16x8*)(sB2 + (16 * j + (lane & 15)) * 40 + 8 * (lane >> 4)); acc2[j] = __builtin_amdgcn_mfma_f32_16x16x32_bf16(a, b2, acc2[j], 0, 0, 0); } }
            __syncthreads();
        }
#pragma unroll
        for (int j = 0; j < 4; ++j)
#pragma unroll
            for (int r = 0; r < 4; ++r) epi(m0 + 16 * wid + 4 * (lane >> 4) + r, n0 + 16 * j + (lane & 15), acc[j][r], acc2[j][r]);
    }
}
struct EpiSwiglu { bf16_t* hid; __device__ __forceinline__ void operator()(int r, int c, float g, float u) const { hid[(size_t)r * DFF + c] = f2bf(silu_f(g) * u); } };
struct EpiResid {
    const float* base; long dbase; float* out; long dxc; const float* mt; int gidx; float coef;
    __device__ __forceinline__ void operator()(int r, int c, float v, float) const {
        bool isctx; const long ob = xoff(r, dbase, isctx) + c; const long oo = xoff(r, dxc, isctx) + c; const int s = isctx ? 2 : r / TB;
        out[oo] = base[ob] + coef * mt[(s * 9 + gidx) * DM + c] * v;
    }
};
struct EpiAB {
    bf16_t* abp; float* abs_; int row0;
    __device__ __forceinline__ void operator()(int r, int c, float v, float) const {
        const int u = r - row0;
        if (c < 2560) abp[(size_t)u * 6656 + c] = f2bf(v);
        else if (c < 2592) abs_[u * 64 + (c - 2560)] = v;
        else if (c < 6688) abp[(size_t)u * 6656 + (c - 32)] = f2bf(v);
        else abs_[u * 64 + 32 + (c - 6688)] = v;
    }
};
struct EpiBf16Store { bf16_t* o; int ldo; __device__ __forceinline__ void operator()(int r, int c, float v, float) const { o[(size_t)r * ldo + c] = f2bf(v); } };


namespace pg8 {
constexpr int BM = 256, BK = 64, HALF = 128, HTB = HALF * BK * 2, STAGE_BYTES = 8 * HTB, NXCD = 8, WGM = 8;
__host__ __device__ __forceinline__ int lds_byte(int r, int c) { const int st = (r >> 4) * 2 + (c >> 5), rr = r & 15, cc = c & 31, ob = rr * 64 + cc * 2; return st * 1024 + (ob ^ (((ob >> 9) & 1) << 5)); }
__host__ __device__ __forceinline__ void stage_rc(int b, int& R, int& C) { const int st = b / 1024, sb = b % 1024, swz = sb ^ (((sb >> 9) & 1) << 5); R = (st >> 1) * 16 + swz / 64; C = (st & 1) * 32 + (swz % 64) / 2; }
__host__ __device__ __forceinline__ int perm32(int rho) { const int n = rho >> 4, i = rho & 15; return 8 * (i >> 2) + 4 * n + (i & 3); }
struct Unit { int pm, pn, k0, nk; };
struct Gemm { const bf16_t* A; const bf16_t* Bt; int K; };
struct Order {
    int nM, nN, nwg, G, c, pm0, mode, nkfull;
    __device__ __forceinline__ void init(int nM_, int nN_, int G_, int c_, int pm0_, int mode_, int nkfull_) { nM = nM_; nN = nN_; nwg = nM * nN; G = G_; c = c_; pm0 = pm0_; mode = mode_; nkfull = nkfull_; }
    __device__ __forceinline__ bool next(int i, Unit& u) const {
        u.k0 = 0; u.nk = nkfull;
        if (mode == 2 && i >= 1) {
            if (i > 1 || c >= 88) return false;
            const int uc = c / 11; u.pm = (uc >> 2) * 33; u.pn = uc & 3; u.k0 = (c - uc * 11) * 4; u.nk = 4; return true; }
        const long L = (long)i * G + c; if (L >= nwg) return false;
        int wgid = (int)L; { const int q = nwg / NXCD, r = nwg % NXCD, xcd = wgid % NXCD, off = wgid / NXCD; wgid = (xcd < r ? xcd * (q + 1) : r * (q + 1) + (xcd - r) * q) + off; }
        const int nig = WGM * nN, gid = wgid / nig, fm = gid * WGM, gsz = (nM - fm) < WGM ? (nM - fm) : WGM;
        int pm = fm + ((wgid % nig) % gsz); u.pn = (wgid % nig) / gsz;
        u.pm = mode ? (pm / 32) * 33 + 1 + (pm % 32) : pm0 + pm; return true;
    }
};
__device__ __forceinline__ unsigned cvt_pk_bf16(float lo, float hi) { return pk2(lo, hi); }

constexpr int LDS_RS = 131072, LDS_BIAS = LDS_RS + 6 * 256 * 4, NB_STRIDE = 6912;
struct NormIn { const float* rsp; const float* bias; };
__device__ __forceinline__ void norm_prologue(LAS unsigned char* lds, const Order& S, const NormIn& ni, int tid) {
    LAS float* rs = (LAS float*)(lds + LDS_RS); LAS float* bi = (LAS float*)(lds + LDS_BIAS);
    const int row = tid >> 1, h = tid & 1;
    if (ni.rsp) {
        f32x4 a[6], b[6]; float bv[6]; bool ok[6];
#pragma unroll
        for (int ui = 0; ui < 6; ++ui) { Unit u; ok[ui] = S.next(ui, u); a[ui] = (f32x4){0.f, 0.f, 0.f, 0.f}; b[ui] = a[ui]; bv[ui] = 0.f;
            if (ok[ui]) { const float* p = ni.rsp + ((size_t)u.pm * 256 + row) * 16 + h * 8; a[ui] = *(const f32x4*)p; b[ui] = *(const f32x4*)(p + 4);
                if (tid < 256) { const int bq = u.pm / 33, sidx = (u.pm - bq * 33 == 0) ? 2 : bq; bv[ui] = ni.bias[(size_t)sidx * NB_STRIDE + u.pn * 256 + tid]; } } }
#pragma unroll
        for (int ui = 0; ui < 6; ++ui) if (ok[ui]) {
            float sq = ((a[ui][0] + a[ui][1]) + (a[ui][2] + a[ui][3])) + ((b[ui][0] + b[ui][1]) + (b[ui][2] + b[ui][3])); sq += __shfl_xor(sq, 1);
            if (h == 0) rs[ui * 256 + row] = 1.0f / sqrtf(sq * (1.f / DM) + NEPS);
            if (tid < 256) bi[ui * 256 + tid] = bv[ui]; }
    } else {
#pragma unroll
        for (int ui = 0; ui < 6; ++ui) { if (h == 0) rs[ui * 256 + row] = 1.f; if (tid < 256) bi[ui * 256 + tid] = 0.f; }
    }
    __syncthreads();
}
template <class Epi>
__device__ __forceinline__ void gemm_phase(LAS unsigned char* lds, const Gemm g, const Order& S, const Epi& E, int tid, const NormIn ni = NormIn{nullptr, nullptr}) {
    if constexpr (Epi::NORM_IN) norm_prologue(lds, S, ni, tid);
    const int wid = __builtin_amdgcn_readfirstlane(tid >> 6), lane = tid & 63, wr = wid >> 2, wc = wid & 3, fr = lane & 15, fq = lane >> 4;
    const int K = g.K;
    unsigned voffA[2], voffB[2];
#pragma unroll
    for (int i = 0; i < 2; ++i) { int R, C; stage_rc(tid * 16 + i * 8192, R, C); const int Rb = Epi::PERM ? ((R & ~31) + perm32(R & 31)) : R;
        voffA[i] = (unsigned)(R * K + C) * 2u; voffB[i] = (unsigned)(Rb * K + C) * 2u; }
    const size_t kstep = (size_t)(BK * 2);
    const size_t hstep = (size_t)HALF * K * 2;
    const size_t tstep = 2 * hstep;
    const unsigned ldsw = (unsigned)wid * 1024u;
    const int aoff = lds_byte(wr * 64 + fr, fq * 8), boff = lds_byte(wc * 32 + fr, fq * 8);
#define PG8_SA(b, h) (((b) * 2 + (h)) * HTB)
#define PG8_SB(b, h) ((4 + (b) * 2 + (h)) * HTB)
#define PG8_STAGE(bufoff, gbase, voff) do { _Pragma("unroll") for (int _i = 0; _i < 2; ++_i) \
        __builtin_amdgcn_global_load_lds((const unsigned*)((const char*)(gbase) + (voff)[_i]), (LAS unsigned*)(lds + (bufoff) + ldsw + _i * 8192), 16, 0, 0); } while (0)
#define PG8_LDA(dst, b, h) do { _Pragma("unroll") for (int m = 0; m < 4; ++m) _Pragma("unroll") for (int k = 0; k < 2; ++k) dst[m][k] = *(const LAS bf16x8*)(lds + PG8_SA(b, h) + aoff + m * 2048 + k * 1024); } while (0)
#define PG8_LDB(dst, b, h) do { _Pragma("unroll") for (int n = 0; n < 2; ++n) _Pragma("unroll") for (int k = 0; k < 2; ++k) dst[n][k] = *(const LAS bf16x8*)(lds + PG8_SB(b, h) + boff + n * 2048 + k * 1024); } while (0)
#define PG8_MMA(ai, bj, At, Bt) do { __builtin_amdgcn_s_setprio(1); _Pragma("unroll") for (int m = 0; m < 4; ++m) _Pragma("unroll") for (int n = 0; n < 2; ++n) _Pragma("unroll") for (int k = 0; k < 2; ++k) \
        acc[ai][bj][m][n] = __builtin_amdgcn_mfma_f32_16x16x32_bf16(Bt[n][k], At[m][k], acc[ai][bj][m][n], 0, 0, 0); __builtin_amdgcn_s_setprio(0); } while (0)
#define PG8_WAIT_V(n) asm volatile("s_waitcnt vmcnt(" #n ")" ::: "memory")
#define PG8_WAIT_L(n) asm volatile("s_waitcnt lgkmcnt(" #n ")" ::: "memory")
#define PG8_BAR __builtin_amdgcn_s_barrier()
#define PG8_SCHED __builtin_amdgcn_sched_barrier(0)
    Unit cur, nxt; int ui = 0;
    if (!S.next(0, cur)) return;
    f32x4 acc[2][2][4][2];
#pragma unroll
    for (int a = 0; a < 2; ++a)
#pragma unroll
        for (int b = 0; b < 2; ++b)
#pragma unroll
            for (int m = 0; m < 4; ++m)
#pragma unroll
                for (int n = 0; n < 2; ++n) acc[a][b][m][n] = (f32x4){0.f, 0.f, 0.f, 0.f};
    bf16x8 At[4][2], B0[2][2], B1[2][2];
    const char* cA = (const char*)g.A + (size_t)cur.pm * tstep + (size_t)cur.k0 * kstep; const char* cB = (const char*)g.Bt + (size_t)cur.pn * tstep + (size_t)cur.k0 * kstep;
    PG8_STAGE(PG8_SB(0, 0), cB, voffB); PG8_STAGE(PG8_SA(0, 0), cA, voffA); PG8_STAGE(PG8_SB(0, 1), cB + hstep, voffB); PG8_STAGE(PG8_SA(0, 1), cA + hstep, voffA);
    if (wr == 1) PG8_BAR;
    PG8_WAIT_V(4); PG8_BAR;
    PG8_STAGE(PG8_SB(1, 0), cB + kstep, voffB); PG8_STAGE(PG8_SA(1, 0), cA + kstep, voffA); PG8_STAGE(PG8_SB(1, 1), cB + hstep + kstep, voffB);
    PG8_WAIT_V(6); PG8_BAR;
    for (;;) {
        const bool has_next = S.next(ui + 1, nxt);
        const char* nA = has_next ? (const char*)g.A + (size_t)nxt.pm * tstep + (size_t)nxt.k0 * kstep : cA; const char* nB = has_next ? (const char*)g.Bt + (size_t)nxt.pn * tstep + (size_t)nxt.k0 * kstep : cB;
        const int nt = cur.nk;
        for (int t = 0; t < nt; t += 2) {
            const bool last = (t == nt - 2);
            const char* a1 = cA + (size_t)(t + 1) * kstep;
            const char* a2 = last ? nA : cA + (size_t)(t + 2) * kstep; const char* b2 = last ? nB : cB + (size_t)(t + 2) * kstep;
            const char* a3 = a2 + kstep; const char* b3 = b2 + kstep;
            PG8_LDB(B0, 0, 0); PG8_SCHED; PG8_LDA(At, 0, 0); PG8_STAGE(PG8_SA(1, 1), a1 + hstep, voffA);
            PG8_WAIT_L(8); PG8_BAR; PG8_WAIT_L(0); PG8_MMA(0, 0, At, B0); PG8_BAR; PG8_SCHED;
            PG8_LDB(B1, 0, 1); PG8_STAGE(PG8_SB(0, 0), b2, voffB);
            PG8_BAR; PG8_WAIT_L(0); PG8_MMA(0, 1, At, B1); PG8_BAR;
            PG8_LDA(At, 0, 1); PG8_STAGE(PG8_SA(0, 0), a2, voffA);
            PG8_BAR; PG8_WAIT_L(0); PG8_MMA(1, 0, At, B0); PG8_BAR; PG8_SCHED;
            PG8_STAGE(PG8_SB(0, 1), b2 + hstep, voffB);
            PG8_WAIT_V(6); PG8_BAR; PG8_MMA(1, 1, At, B1); PG8_BAR;
            PG8_LDB(B0, 1, 0); PG8_SCHED; PG8_LDA(At, 1, 0); PG8_STAGE(PG8_SA(0, 1), a2 + hstep, voffA);
            PG8_WAIT_L(8); PG8_BAR; PG8_WAIT_L(0); PG8_MMA(0, 0, At, B0); PG8_BAR; PG8_SCHED;
            PG8_LDB(B1, 1, 1); PG8_STAGE(PG8_SB(1, 0), b3, voffB);
            PG8_BAR; PG8_WAIT_L(0); PG8_MMA(0, 1, At, B1); PG8_BAR;
            PG8_LDA(At, 1, 1); PG8_STAGE(PG8_SA(1, 0), a3, voffA);
            PG8_BAR; PG8_WAIT_L(0); PG8_MMA(1, 0, At, B0); PG8_BAR; PG8_SCHED;
            PG8_STAGE(PG8_SB(1, 1), b3 + hstep, voffB);
            PG8_WAIT_V(6); PG8_BAR; PG8_MMA(1, 1, At, B1); PG8_BAR;
        }
        E(acc, cur, wr, wc, fr, fq, ui, lds);
        if (!has_next) break;
#pragma unroll
        for (int a = 0; a < 2; ++a)
#pragma unroll
            for (int b = 0; b < 2; ++b)
#pragma unroll
                for (int m = 0; m < 4; ++m)
#pragma unroll
                    for (int n = 0; n < 2; ++n) acc[a][b][m][n] = (f32x4){0.f, 0.f, 0.f, 0.f};
        cur = nxt; cA = nA; cB = nB; ++ui;
    }
    PG8_WAIT_V(0);
    if (wr == 0) PG8_BAR;
    PG8_BAR;
#undef PG8_SA
#undef PG8_SB
#undef PG8_STAGE
#undef PG8_LDA
#undef PG8_LDB
#undef PG8_MMA
#undef PG8_WAIT_V
#undef PG8_WAIT_L
#undef PG8_BAR
#undef PG8_SCHED
}
struct EpiSwigluP {
    static constexpr bool PERM = true, NORM_IN = true; bf16_t* hid;
    __device__ __forceinline__ void operator()(const f32x4 (&acc)[2][2][4][2], const Unit& u, int wr, int wc, int fr, int fq, int ui, LAS unsigned char* lds) const {
        const int row0 = u.pm * BM + wr * 64 + fr, col0 = u.pn * 128 + wc * 32 + 8 * fq;
        const LAS float* rs = (const LAS float*)(lds + LDS_RS) + ui * 256 + wr * 64 + fr; const LAS float* bi = (const LAS float*)(lds + LDS_BIAS) + ui * 256 + wc * 32 + 8 * fq;
        f32x4 bg[2], bu[2];
#pragma unroll
        for (int n = 0; n < 2; ++n) { bg[n] = *(const LAS f32x4*)(bi + 4 * n); bu[n] = *(const LAS f32x4*)(bi + 128 + 4 * n); }
#pragma unroll
        for (int ai = 0; ai < 2; ++ai)
#pragma unroll
            for (int m = 0; m < 4; ++m) { float h[8]; const float r = rs[ai * HALF + m * 16];
#pragma unroll
                for (int n = 0; n < 2; ++n)
#pragma unroll
                    for (int i = 0; i < 4; ++i) h[n * 4 + i] = silu_f(fmaf(r, acc[ai][0][m][n][i], bg[n][i])) * fmaf(r, acc[ai][1][m][n][i], bu[n][i]);
                u32x4 w; w.x = cvt_pk_bf16(h[0], h[1]); w.y = cvt_pk_bf16(h[2], h[3]); w.z = cvt_pk_bf16(h[4], h[5]); w.w = cvt_pk_bf16(h[6], h[7]);
                st_nt(hid + (size_t)(row0 + ai * HALF + m * 16) * DFF + col0, w); }
    }
};
struct EpiResidP {
    static constexpr bool PERM = true, NORM_IN = false; const void* base; long dbase; void* out; long dxc; const float* mt; int gidx; const float* gn; int kn; bool fuse, in32, out32; unsigned char* wsb; float coef;
    __device__ __forceinline__ void operator()(const f32x4 (&acc)[2][2][4][2], const Unit& u, int wr, int wc, int fr, int fq, int, LAS unsigned char*) const {
        asm volatile("" : "+v"(fr), "+v"(fq));
        float cf = coef; asm volatile("" : "+v"(cf));
        const int b = u.pm / 33, j = u.pm - b * 33; const bool isctx = (j == 0); const int s = isctx ? 2 : b;
        const long rb = isctx ? (long)(b * CTXL) * DM : (long)(b * SEQ + (j - 1) * 256) * DM;
        const long bo = rb + (isctx ? dbase : 0), oo = rb + (isctx ? dxc : 0);
        const float* bp32 = (const float*)base + bo; const h16* bp16 = (const h16*)base + bo; float* op32 = (float*)out + oo; h16* op16 = (h16*)out + oo;
        bf16_t* hn = (bf16_t*)(wsb + WS_HN) + (size_t)u.pm * BM * DM; float* rsp = (float*)(wsb + WS_RSP) + (size_t)u.pm * BM * 16 + u.pn * 4 + wc;
        const int col0 = u.pn * BM + wc * 32 + 8 * fq; const float* gv = mt + (s * 9 + gidx) * DM; const float* scn = mt + (s * 9 + kn * 3 + 1) * DM;
        float ss[2][4];
#pragma unroll
        for (int ai = 0; ai < 2; ++ai)
#pragma unroll
            for (int m = 0; m < 4; ++m) ss[ai][m] = 0.f;
#define RESID_ROW(ai_, m_, xb0_, xb1_) do { const unsigned off = (unsigned)((ai_) * HALF + wr * 64 + (m_) * 16 + fr) * DM + col0 + bj * HALF; \
            const f32x4 x0 = (xb0_) + g4[0] * acc[ai_][bj][m_][0], x1 = (xb1_) + g4[1] * acc[ai_][bj][m_][1]; \
            if (out32) { st_ntf(op32 + off, x0); st_ntf(op32 + (off + 4), x1); } \
            else st_nt(op16 + off, (u32x4){pkh2(x0[0], x0[1]), pkh2(x0[2], x0[3]), pkh2(x1[0], x1[1]), pkh2(x1[2], x1[3])}); \
            if (fuse) { ss[ai_][m_] += ((x0[0] * x0[0] + x0[1] * x0[1]) + (x0[2] * x0[2] + x0[3] * x0[3])) + ((x1[0] * x1[0] + x1[1] * x1[1]) + (x1[2] * x1[2] + x1[3] * x1[3])); \
                const f32x4 y0 = x0 * a4[0], y1 = x1 * a4[1]; \
                st_nt(hn + off, (u32x4){cvt_pk_bf16(y0[0], y0[1]), cvt_pk_bf16(y0[2], y0[3]), cvt_pk_bf16(y1[0], y1[1]), cvt_pk_bf16(y1[2], y1[3])}); } } while (0)
#pragma unroll
        for (int bj = 0; bj < 2; ++bj) {
            f32x4 g4[2], a4[2];
#pragma unroll
            for (int n = 0; n < 2; ++n) { const unsigned c = (unsigned)(col0 + bj * HALF + n * 4); g4[n] = *(const f32x4*)(gv + c) * cf;
                if (fuse) a4[n] = *(const f32x4*)(gn + c) * (1.f + *(const f32x4*)(scn + c)); else a4[n] = (f32x4){0.f, 0.f, 0.f, 0.f}; }
            if (in32) {
#pragma unroll
                for (int ai = 0; ai < 2; ++ai) {
                    f32x4 bs[4][2];
#pragma unroll
                    for (int m = 0; m < 4; ++m) { const unsigned off = (unsigned)(ai * HALF + wr * 64 + m * 16 + fr) * DM + col0 + bj * HALF; bs[m][0] = *(const f32x4*)(bp32 + off); bs[m][1] = *(const f32x4*)(bp32 + (off + 4)); }
#pragma unroll
                    for (int m = 0; m < 4; ++m) RESID_ROW(ai, m, bs[m][0], bs[m][1]);
                    asm volatile("" ::: "memory");
                }
            } else {
                u32x4 bh[2][4];
#pragma unroll
                for (int ai = 0; ai < 2; ++ai)
#pragma unroll
                    for (int m = 0; m < 4; ++m) { const unsigned off = (unsigned)(ai * HALF + wr * 64 + m * 16 + fr) * DM + col0 + bj * HALF; bh[ai][m] = *(const u32x4*)(bp16 + off); }
#pragma unroll
                for (int ai = 0; ai < 2; ++ai)
#pragma unroll
                    for (int m = 0; m < 4; ++m) { const f32x2_t c0 = unh2(bh[ai][m][0]), c1 = unh2(bh[ai][m][1]), c2 = unh2(bh[ai][m][2]), c3 = unh2(bh[ai][m][3]);
                        RESID_ROW(ai, m, ((f32x4){c0[0], c0[1], c1[0], c1[1]}), ((f32x4){c2[0], c2[1], c3[0], c3[1]})); }
                asm volatile("" ::: "memory");
            }
        }
#undef RESID_ROW
        if (fuse) {
#pragma unroll
            for (int ai = 0; ai < 2; ++ai)
#pragma unroll
                for (int m = 0; m < 4; ++m) { float t = ss[ai][m]; t += __shfl_xor(t, 16); t += __shfl_xor(t, 32); if (fq == 0) rsp[(unsigned)(ai * HALF + wr * 64 + m * 16 + fr) * 16] = t; }
        }
    }
};
struct EpiABP {
    static constexpr bool PERM = true, NORM_IN = true; bf16_t* zg; bf16_t* raw; float* abs_; int row0;
    __device__ __forceinline__ void operator()(const f32x4 (&acc)[2][2][4][2], const Unit& u, int wr, int wc, int fr, int fq, int ui, LAS unsigned char* lds) const {
        const int u0 = u.pm * BM - row0 + wr * 64 + fr;
        const LAS float* rs = (const LAS float*)(lds + LDS_RS) + ui * 256 + wr * 64 + fr; const LAS float* bi = (const LAS float*)(lds + LDS_BIAS) + ui * 256 + wc * 32 + 8 * fq;
        f32x4 b4[2][2];
#pragma unroll
        for (int bj = 0; bj < 2; ++bj)
#pragma unroll
            for (int n = 0; n < 2; ++n) b4[bj][n] = *(const LAS f32x4*)(bi + bj * HALF + 4 * n);
        if (u.pn < 26) {
            const bool israw = (u.pn >= 4 && u.pn < 22); const int ld = israw ? 4608 : 2048;
            bf16_t* dst = israw ? raw + (u.pn - 4) * BM : (u.pn < 4 ? zg + u.pn * BM : zg + 1024 + (u.pn - 22) * BM); const int col0 = wc * 32 + 8 * fq;
#pragma unroll
            for (int ai = 0; ai < 2; ++ai)
#pragma unroll
                for (int m = 0; m < 4; ++m) { const float r = rs[ai * HALF + m * 16];
#pragma unroll
                    for (int bj = 0; bj < 2; ++bj) { const f32x4 v0 = acc[ai][bj][m][0] * r + b4[bj][0], v1 = acc[ai][bj][m][1] * r + b4[bj][1];
                        u32x4 w; w.x = cvt_pk_bf16(v0[0], v0[1]); w.y = cvt_pk_bf16(v0[2], v0[3]); w.z = cvt_pk_bf16(v1[0], v1[1]); w.w = cvt_pk_bf16(v1[2], v1[3]);
                        st_nt(dst + (size_t)(u0 + ai * HALF + m * 16) * ld + col0 + bj * HALF, w); } }
        } else if (wc < 2) {
#pragma unroll
            for (int ai = 0; ai < 2; ++ai)
#pragma unroll
                for (int m = 0; m < 4; ++m) { float* p = abs_ + (size_t)(u0 + ai * HALF + m * 16) * 64 + wc * 32 + 8 * fq; const float r = rs[ai * HALF + m * 16];
                    *(f32x4*)p = acc[ai][0][m][0] * r + b4[0][0]; *(f32x4*)(p + 4) = acc[ai][0][m][1] * r + b4[0][1]; }
        }
    }
};
struct EpiBf16P {
    static constexpr bool PERM = true, NORM_IN = true; bf16_t* O; int ldc;
    __device__ __forceinline__ void operator()(const f32x4 (&acc)[2][2][4][2], const Unit& u, int wr, int wc, int fr, int fq, int ui, LAS unsigned char* lds) const {
        const int row0 = u.pm * BM + wr * 64 + fr, col0 = u.pn * BM + wc * 32 + 8 * fq;
        const LAS float* rs = (const LAS float*)(lds + LDS_RS) + ui * 256 + wr * 64 + fr; const LAS float* bi = (const LAS float*)(lds + LDS_BIAS) + ui * 256 + wc * 32 + 8 * fq;
        f32x4 b4[2][2];
#pragma unroll
        for (int bj = 0; bj < 2; ++bj)
#pragma unroll
            for (int n = 0; n < 2; ++n) b4[bj][n] = *(const LAS f32x4*)(bi + bj * HALF + 4 * n);
#pragma unroll
        for (int ai = 0; ai < 2; ++ai)
#pragma unroll
            for (int m = 0; m < 4; ++m) { const float r = rs[ai * HALF + m * 16];
#pragma unroll
                for (int bj = 0; bj < 2; ++bj) { const f32x4 v0 = acc[ai][bj][m][0] * r + b4[bj][0], v1 = acc[ai][bj][m][1] * r + b4[bj][1];
                    u32x4 w; w.x = cvt_pk_bf16(v0[0], v0[1]); w.y = cvt_pk_bf16(v0[2], v0[3]); w.z = cvt_pk_bf16(v1[0], v1[1]); w.w = cvt_pk_bf16(v1[2], v1[3]);
                    st_nt(O + (size_t)(row0 + ai * HALF + m * 16) * ldc + col0 + bj * HALF, w); } }
    }
};
}

__device__ __forceinline__ void cvt_item(const float* W, int ldw, int K, bf16_t* WT, int dest_row0, int src_col0, int kb, LAS float* scr, int lane) {
    const int k0 = 64 * kb;
    float v[32];
    const float* wp = W + (size_t)(k0 + (lane >> 5)) * ldw + (src_col0 >= 0 ? src_col0 : 0) + (lane & 31);
#pragma unroll
    for (int i = 0; i < 32; ++i) v[i] = wp[(size_t)(2 * i) * ldw];
#pragma unroll
    for (int i = 0; i < 32; ++i) { const int kk = 2 * i + (lane >> 5); scr[kk * 33 + (lane & 31)] = src_col0 >= 0 ? v[i] : 0.f; }
    asm volatile("s_waitcnt lgkmcnt(0)" ::: "memory");
    const int c = lane & 7;
#pragma unroll
    for (int j = 0; j < 4; ++j) { const int n = (lane >> 3) + 8 * j; const LAS float* sp = scr + (8 * c) * 33 + n;
        u32x4 o; o.x = pg8::cvt_pk_bf16(sp[0 * 33], sp[1 * 33]); o.y = pg8::cvt_pk_bf16(sp[2 * 33], sp[3 * 33]); o.z = pg8::cvt_pk_bf16(sp[4 * 33], sp[5 * 33]); o.w = pg8::cvt_pk_bf16(sp[6 * 33], sp[7 * 33]);
        *(u32x4*)(WT + (size_t)(dest_row0 + n) * K + k0 + 8 * c) = o; }
    asm volatile("s_waitcnt lgkmcnt(0)" ::: "memory");
}
__device__ __forceinline__ int map_ffin(int nb) { const int r0 = nb * 32, pn = r0 >> 8, j = r0 & 255; return j < 128 ? pn * 128 + j : DFF + pn * 128 + (j - 128); }
__device__ __forceinline__ int map_abin(int nb) { const int r0 = nb * 32; return r0 < 2560 ? r0 : (r0 < 6656 ? r0 + 32 : (r0 == 6656 ? 2560 : (r0 == 6688 ? 6688 : -1))); }
__device__ __forceinline__ void phase_convert(Frame& F, int l) {
    LAS float* scr = (LAS float*)(F.lds + F.wave * 8448);
    unsigned char* wb = F.ws + WS_W;
    const int gw = F.bid * 8 + F.wave, NGW = F.G * 8;
    constexpr int I_FFIN = 16 * 176, I_FFOUT = 44 * 32;
    const int n_in = l == 0 ? 216 : 64, I_MIN = 16 * n_in, kb_out = l == 0 ? 32 : 16, I_MOUT = kb_out * 32;
    const int total = 2 * I_FFIN + 2 * I_FFOUT + I_MIN + I_MOUT;
    for (int it = gw; it < total; it += NGW) {
        int r = it;
        if (r < 2 * I_FFIN) { const int w = r / I_FFIN; r -= w * I_FFIN; const int kb = r / 176, nb = r - kb * 176;
            cvt_item(F.in[I_WFFIN] + (size_t)(l * 2 + w) * DM * 2 * DFF, 2 * DFF, DM, (bf16_t*)(wb + (w ? W_FFIN1 : W_FFIN0)), nb * 32, map_ffin(nb), kb, scr, F.lane); continue; }
        r -= 2 * I_FFIN;
        if (r < 2 * I_FFOUT) { const int w = r / I_FFOUT; r -= w * I_FFOUT; const int kb = r / 32, nb = r - kb * 32;
            cvt_item(F.in[I_WFFOUT] + (size_t)(l * 2 + w) * DFF * DM, DM, DFF, (bf16_t*)(wb + (w ? W_FFOUT1 : W_FFOUT0)), nb * 32, nb * 32, kb, scr, F.lane); continue; }
        r -= 2 * I_FFOUT;
        if (r < I_MIN) { const int kb = r / n_in, nb = r - kb * n_in;
            if (l == 0) cvt_item(F.in[I_ABWIN], 6720, DM, (bf16_t*)(wb + W_MIXIN), nb * 32, map_abin(nb), kb, scr, F.lane);
            else cvt_item(F.in[I_WQKV], 2048, DM, (bf16_t*)(wb + W_MIXIN), nb * 32, nb * 32, kb, scr, F.lane);
            continue; }
        r -= I_MIN;
        { const int kb = r / 32, nb = r - kb * 32;
          if (l == 0) cvt_item(F.in[I_ABWOUT], DM, 2048, (bf16_t*)(wb + W_MIXOUT), nb * 32, nb * 32, kb, scr, F.lane);
          else cvt_item(F.in[I_WO], DM, DM, (bf16_t*)(wb + W_MIXOUT), nb * 32, nb * 32, kb, scr, F.lane); }
    }
}

namespace att {
constexpr int D = 128, NW = 8, QBLK = 32, KVBLK = 64;
constexpr float SCALE = 0.088388347648318440f;
constexpr float THR = 8.f;
constexpr int SDEPTH = 1;
constexpr int LDQ = 2048, LDK = 2048, LDO = 1024;
constexpr size_t SHM_V = KVBLK * D * 2, SHM_K = KVBLK * D * 2, SHM_Q = 256 * D * 2, SHM_ATTN = 2 * SHM_V + 2 * SHM_K + NW * 64 * 4 + SHM_Q;
#define KSWZ(row, colB) ((row) * 256 + ((colB) ^ (((row) & 7) << 4)))
#define SBAR() __builtin_amdgcn_sched_barrier(0)
__device__ __forceinline__ int crow(int r, int hi) { return (r & 3) + 8 * (r >> 2) + 4 * hi; }
__device__ __forceinline__ unsigned cvtpk(float lo, float hi) { unsigned r; asm volatile("v_cvt_pk_bf16_f32 %0, %1, %2" : "=v"(r) : "v"(lo), "v"(hi)); return r; }
__device__ __forceinline__ bf16x8 ld8(const bf16_t* p) { return *reinterpret_cast<const bf16x8*>(p); }
__device__ __forceinline__ void partialSM(f32x16& p0, f32x16& p1, float& m_reg, float& mn, float& alpha) {
  constexpr float C = SCALE * 1.4426950408889634f;
  float pmax = p0[0]; for (int r = 1; r < 16; ++r) pmax = fmaxf(pmax, p0[r]); for (int r = 0; r < 16; ++r) pmax = fmaxf(pmax, p1[r]);
  { auto rr = __builtin_amdgcn_permlane32_swap(__float_as_uint(pmax), __float_as_uint(pmax), false, false);
    pmax = fmaxf(__uint_as_float(rr[0]), __uint_as_float(rr[1])); }
  if (__builtin_expect(__all(pmax - m_reg <= THR / SCALE), 1)) { mn = m_reg; alpha = 1.f; }
  else { mn = fmaxf(m_reg, pmax); alpha = __builtin_amdgcn_exp2f((m_reg - mn) * C); m_reg = mn; }
  float mnC = -mn * C;
  for (int r = 0; r < 16; ++r) p0[r] = fmaf(p0[r], C, mnC); for (int r = 0; r < 16; ++r) p1[r] = fmaf(p1[r], C, mnC);
  for (int r = 0; r < 16; ++r) p0[r] = __builtin_amdgcn_exp2f(p0[r]);
}
__device__ __forceinline__ void finishSM(f32x16& p0, f32x16& p1, float alpha, float& l_reg, bf16x8& pa0, bf16x8& pa1, bf16x8& pa2, bf16x8& pa3) {
  for (int r = 0; r < 16; ++r) p1[r] = __builtin_amdgcn_exp2f(p1[r]);
  float ps = 0; for (int r = 0; r < 16; ++r) ps += p0[r]; for (int r = 0; r < 16; ++r) ps += p1[r];
  { auto rr = __builtin_amdgcn_permlane32_swap(__float_as_uint(ps), __float_as_uint(ps), false, false);
    ps = __uint_as_float(rr[0]) + __uint_as_float(rr[1]); }
  l_reg = l_reg * alpha + ps;
#define PK4(P, BASE, OUT) do { unsigned a0 = cvtpk(P[BASE + 0], P[BASE + 1]), a1 = cvtpk(P[BASE + 2], P[BASE + 3]);   \
    unsigned b0 = cvtpk(P[BASE + 4], P[BASE + 5]), b1 = cvtpk(P[BASE + 6], P[BASE + 7]);                              \
    auto r0 = __builtin_amdgcn_permlane32_swap(a0, b0, false, false); auto r1 = __builtin_amdgcn_permlane32_swap(a1, b1, false, false); \
    u32x4 w = {r0[0], r1[0], r0[1], r1[1]}; OUT = *reinterpret_cast<bf16x8*>(&w); } while (0)
  PK4(p0, 0, pa0); PK4(p0, 8, pa1); PK4(p1, 0, pa2); PK4(p1, 8, pa3);
#undef PK4
}
__device__ __forceinline__ void qkt(f32x16& p0, f32x16& p1, const bf16_t* Ks, const bf16x8 (&qreg)[8], int qrow, int r32, int hi) {
  p0 = f32x16{}; p1 = f32x16{};
  for (int d0 = 0; d0 < 8; ++d0) { int cb = (d0 * 16 + hi * 8) * 2; const bf16x8 qf = qreg[d0];
    bf16x8 b0 = *reinterpret_cast<const bf16x8*>((const char*)Ks + KSWZ(r32, cb));
    bf16x8 b1 = *reinterpret_cast<const bf16x8*>((const char*)Ks + KSWZ(32 + r32, cb));
    p0 = __builtin_amdgcn_mfma_f32_32x32x16_bf16(b0, qf, p0, 0, 0, 0);
    p1 = __builtin_amdgcn_mfma_f32_32x32x16_bf16(b1, qf, p1, 0, 0, 0); }
}
__device__ __forceinline__ int v_st(int k, int c) { const int kk = (k & ~0xC) | ((k & 4) << 1) | ((k & 8) >> 1); return ((kk >> 3) * 4 + (c >> 5)) * 512 + ((kk & 7) * 32 + (c & 31)) * 2; }
__device__ __forceinline__ int v_rd_base(int lane) { return ((lane & 3) << 3) | (((lane >> 2) & 3) << 6) | (((lane >> 4) & 1) << 5) | (((lane >> 5) & 1) << 8); }
constexpr int v_rd_off(int d0, int ks, int half) { return d0 * 512 + ks * 4096 + half * 2048; }
template <int OFF> __device__ __forceinline__ s16x4 tr_read(int vb) {
  s16x4 r; asm volatile("ds_read_b64_tr_b16 %0, %1 offset:%2" : "=&v"(r) : "v"(vb), "i"(OFF) : "memory"); return r;
}
template <int D0> __device__ __forceinline__ void pv_one(f32x16& od, int vb, bf16x8 pa0, bf16x8 pa1, bf16x8 pa2, bf16x8 pa3) {
  const s16x4 l0 = tr_read<v_rd_off(D0, 0, 0)>(vb), h0 = tr_read<v_rd_off(D0, 0, 1)>(vb), l1 = tr_read<v_rd_off(D0, 1, 0)>(vb), h1 = tr_read<v_rd_off(D0, 1, 1)>(vb);
  const s16x4 l2 = tr_read<v_rd_off(D0, 2, 0)>(vb), h2 = tr_read<v_rd_off(D0, 2, 1)>(vb), l3 = tr_read<v_rd_off(D0, 3, 0)>(vb), h3 = tr_read<v_rd_off(D0, 3, 1)>(vb);
  asm volatile("s_waitcnt lgkmcnt(0)" ::: "memory"); SBAR();
#define PK(L, H) (bf16x8){L[0], L[1], L[2], L[3], H[0], H[1], H[2], H[3]}
  od = __builtin_amdgcn_mfma_f32_32x32x16_bf16(pa0, PK(l0, h0), od, 0, 0, 0);
  od = __builtin_amdgcn_mfma_f32_32x32x16_bf16(pa1, PK(l1, h1), od, 0, 0, 0);
  od = __builtin_amdgcn_mfma_f32_32x32x16_bf16(pa2, PK(l2, h2), od, 0, 0, 0);
  od = __builtin_amdgcn_mfma_f32_32x32x16_bf16(pa3, PK(l3, h3), od, 0, 0, 0);
#undef PK
}
__device__ __forceinline__ void pv_d0(f32x16* o, int vb, bf16x8 pa0, bf16x8 pa1, bf16x8 pa2, bf16x8 pa3) {
  pv_one<0>(o[0], vb, pa0, pa1, pa2, pa3); pv_one<1>(o[1], vb, pa0, pa1, pa2, pa3); pv_one<2>(o[2], vb, pa0, pa1, pa2, pa3); pv_one<3>(o[3], vb, pa0, pa1, pa2, pa3);
}
__device__ __forceinline__ void attn_dense_body(const bf16_t* __restrict__ Qb, const bf16_t* __restrict__ Kh, const bf16_t* __restrict__ Vh,
                                                bf16_t* __restrict__ Ob, int  , char* lds, int tid) {
  constexpr int seq = TB;
  const int wid = tid >> 6, lane = tid & 63, r32 = lane & 31, hi = lane >> 5;
  bf16_t* V_lds = (bf16_t*)lds; bf16_t* K_lds = (bf16_t*)(lds + 3 * SHM_V);
  float* ws = (float*)(lds + 3 * SHM_V + 3 * SHM_K) + wid * 64; float* li_l = ws; float* al_l = ws + 32;
  float m_reg = -1e30f, l_reg = 0; f32x16 o[4] = {};
  const int qrow = wid * QBLK + r32;
  bf16x8 Qs[8];
  { const bf16_t* Qw = Qb + (long)qrow * LDQ + hi * 8;
#pragma unroll
    for (int d0 = 0; d0 < 8; ++d0) Qs[d0] = ld8(Qw + d0 * 16); }
  const int sr = tid >> 4, sc = (tid & 15) * 8, vst0 = v_st(sr, sc), vst1 = v_st(32 + sr, sc);
  const int vb0 = (int)(uintptr_t)V_lds + v_rd_base(lane);
  static_assert(SDEPTH == 1 && SHM_V == SHM_K, "ring form: K/V register-staged one tile ahead");
  struct { bf16x8 vs0, vs1, ks0, ks1; } sr_;
#define SLOAD(k0) do { sr_.vs0 = ld8(&Vh[(long)((k0) + sr) * LDK + sc]); sr_.vs1 = ld8(&Vh[(long)((k0) + 32 + sr) * LDK + sc]); \
    sr_.ks0 = ld8(&Kh[(long)((k0) + sr) * LDK + sc]); sr_.ks1 = ld8(&Kh[(long)((k0) + 32 + sr) * LDK + sc]); } while (0)
#define SWRITE(bo) do { *(bf16x8*)((char*)V_lds + (bo) + vst0) = sr_.vs0; *(bf16x8*)((char*)V_lds + (bo) + vst1) = sr_.vs1; int kc = sc * 2;               \
    *(bf16x8*)((char*)K_lds + (bo) + KSWZ(sr, kc)) = sr_.ks0; *(bf16x8*)((char*)K_lds + (bo) + KSWZ(32 + sr, kc)) = sr_.ks1; } while (0)
#define SWAIT() asm volatile("s_waitcnt vmcnt(0)" ::: "memory")
#define RESC(a) do { if (__any((a) < 1.f)) { if (hi == 0) al_l[r32] = (a); asm volatile("s_waitcnt lgkmcnt(0)" ::: "memory"); \
    for (int d = 0; d < 4; ++d) for (int r = 0; r < 16; ++r) o[d][r] *= al_l[crow(r, hi)]; } } while (0)
#define ROT() do { bprev = bcur; bcur = bnext; bnext = (bnext == 2 * (int)SHM_V) ? 0 : bnext + (int)SHM_V; } while (0)
  f32x16 pA0, pA1, pB0, pB1; float mnA, mnB, alA, alB; bf16x8 pa0, pa1, pa2, pa3; const int NT = seq / KVBLK;
  int bprev = 0, bcur = (int)SHM_V, bnext = 2 * (int)SHM_V;
  SLOAD(0); asm volatile("s_waitcnt vmcnt(0)" ::: "memory"); SWRITE(0); __syncthreads();
  qkt(pA0, pA1, K_lds, Qs, qrow, r32, hi); partialSM(pA0, pA1, m_reg, mnA, alA);
  SLOAD(KVBLK); SWAIT(); SWRITE((int)SHM_V); __syncthreads();
  for (int j = 1; j + 1 < NT; j += 2) {
    SBAR(); qkt(pB0, pB1, (bf16_t*)((char*)K_lds + bcur), Qs, qrow, r32, hi);
    finishSM(pA0, pA1, alA, l_reg, pa0, pa1, pa2, pa3); SBAR();
    SLOAD((j + 1) * KVBLK); SBAR();
    pv_d0(o, vb0 + bprev, pa0, pa1, pa2, pa3); partialSM(pB0, pB1, m_reg, mnB, alB);
    SWAIT(); SWRITE(bnext);
    RESC(alB); __syncthreads(); ROT();
    SBAR(); qkt(pA0, pA1, (bf16_t*)((char*)K_lds + bcur), Qs, qrow, r32, hi);
    finishSM(pB0, pB1, alB, l_reg, pa0, pa1, pa2, pa3); SBAR();
    SLOAD((j + 2) * KVBLK); SBAR();
    pv_d0(o, vb0 + bprev, pa0, pa1, pa2, pa3); partialSM(pA0, pA1, m_reg, mnA, alA);
    SWAIT(); SWRITE(bnext);
    RESC(alA); __syncthreads(); ROT();
  }
  SBAR(); qkt(pB0, pB1, (bf16_t*)((char*)K_lds + bcur), Qs, qrow, r32, hi);
  finishSM(pA0, pA1, alA, l_reg, pa0, pa1, pa2, pa3); SBAR();
  pv_d0(o, vb0 + bprev, pa0, pa1, pa2, pa3); partialSM(pB0, pB1, m_reg, mnB, alB);
  RESC(alB);
  finishSM(pB0, pB1, alB, l_reg, pa0, pa1, pa2, pa3); SBAR();
  pv_d0(o, vb0 + bcur, pa0, pa1, pa2, pa3);
  if (hi == 0) li_l[r32] = l_reg; asm volatile("s_waitcnt lgkmcnt(0)" ::: "memory");
  float rli[16];
#pragma unroll
  for (int r = 0; r < 16; ++r) rli[r] = __builtin_amdgcn_rcpf(li_l[crow(r, hi)]);
  bf16_t* Ow = Ob + (long)(wid * QBLK) * LDO;
#pragma unroll
  for (int r = 0; r < 16; ++r) { int orow = crow(r, hi);
    for (int d0 = 0; d0 < 4; ++d0) Ow[(long)orow * LDO + d0 * 32 + r32] = f2bf(o[d0][r] * rli[r]); }
#undef SLOAD
#undef SWRITE
#undef SWAIT
#undef RESC
#undef ROT
}
}

__device__ __forceinline__ void phase_modtab(Frame& F) {
    LAS float* sc = (LAS float*)F.lds;
    for (int i = F.tid; i < 3 * DM; i += NTHREADS) { const int s = i / DM, k = i - s * DM; const float c = s < 2 ? F.in[I_C][s * DM + k] : F.in[I_CCTX][k]; sc[i] = silu_f(c); }
    __syncthreads();
    float* mtp = (float*)(F.ws + WS_MTP);
    for (int it = F.bid; it < 2 * 16 * 18; it += F.G) {
        const int l = it / 288, r = it - l * 288, kc = r / 18, nc = r - kc * 18, n = nc * 512 + F.tid;
        const float* w = F.in[I_WMOD] + ((size_t)l * DM + kc * 64) * 9216 + n; float a0 = 0.f, a1 = 0.f, a2 = 0.f;
        float wv[64];
#pragma unroll
        for (int k = 0; k < 64; ++k) wv[k] = w[(size_t)k * 9216];
#pragma unroll
        for (int k = 0; k < 64; ++k) { a0 = fmaf(sc[kc * 64 + k], wv[k], a0); a1 = fmaf(sc[DM + kc * 64 + k], wv[k], a1); a2 = fmaf(sc[2 * DM + kc * 64 + k], wv[k], a2); }
        float* o = mtp + ((size_t)(l * 16 + kc) * 3) * 9216 + n; o[0] = a0; o[9216] = a1; o[2 * 9216] = a2;
    }
    __syncthreads();
}
__device__ __forceinline__ float modtab_sum(Frame& F, int l, int s, int n) {
    const float* p = (const float*)(F.ws + WS_MTP) + ((size_t)(l * 16) * 3 + s) * 9216 + n; float a = F.in[I_BMOD][l * 9216 + n];
#pragma unroll
    for (int kc = 0; kc < 16; ++kc) a += p[(size_t)kc * 3 * 9216];
    return a;
}
__device__ __forceinline__ void phase_modtab_reduce(Frame& F) {
    for (int i = F.bid * NTHREADS + F.tid; i < 2 * 3 * 9216; i += F.G * NTHREADS) { const int l = i / 27648, r = i - l * 27648, s = r / 9216, n = r - s * 9216; F_MT[i] = modtab_sum(F, l, s, n); }
}
__device__ __forceinline__ void phase_norm(Frame& F, int l, int which, bool from_input, bool skip_ctx, bool lds_tab = false) {
    const float* g = F.in[I_NORMG] + (l * 3 + which) * DM;
    const float* src = F.in[I_X]; const h16* src16 = F_X16L; const long dsrc = from_input ? F.dcin : F_DXC16;
    const int gw = F.bid * 8 + F.wave, NGW = F.G * 8;
    for (int r0 = gw; r0 < TT; r0 += 2 * NGW) {
        f32x4 vv[2][4];
#pragma unroll
        for (int q = 0; q < 2; ++q) { const int r = r0 + q * NGW; bool isctx = false; const long o = r < TT ? xoff(r, dsrc, isctx) : 0; const bool ok = r < TT && !(skip_ctx && isctx);
#pragma unroll
            for (int j = 0; j < 4; ++j) { if (!ok) vv[q][j] = (f32x4){0.f, 0.f, 0.f, 0.f}; else if (from_input) vv[q][j] = *(const f32x4*)(src + o + j * 256 + F.lane * 4);
                else { const u32x2 w = *(const u32x2*)(src16 + o + j * 256 + F.lane * 4); const f32x2_t c0 = unh2(w[0]), c1 = unh2(w[1]); vv[q][j] = (f32x4){c0[0], c0[1], c1[0], c1[1]}; } } }
#pragma unroll
        for (int q = 0; q < 2; ++q) { const int r = r0 + q * NGW; if (r >= TT) continue;
            bool isctx; (void)xoff(r, dsrc, isctx); if (skip_ctx && isctx) continue;
            const int s = isctx ? 2 : r / TB;
            const float* sh = F_MT + ((l * 3 + s) * 9 + which * 3 + 0) * DM; const float* sc = sh + DM; const LAS float* lsh = (const LAS float*)(F.lds + 69632) + s * 2 * DM;
            float ss = 0.f;
#pragma unroll
            for (int j = 0; j < 4; ++j) { const f32x4 v = vv[q][j]; ss += (v[0] * v[0] + v[1] * v[1]) + (v[2] * v[2] + v[3] * v[3]); }
            const float rstd = 1.0f / sqrtf(wave_sum(ss) * (1.f / DM) + NEPS);
#pragma unroll
            for (int j = 0; j < 4; ++j) { const f32x4 v = vv[q][j]; const int c = j * 256 + F.lane * 4; const f32x4 gv = *(const f32x4*)(g + c), shv = lds_tab ? *(const LAS f32x4*)(lsh + c) : *(const f32x4*)(sh + c), scv = lds_tab ? *(const LAS f32x4*)(lsh + DM + c) : *(const f32x4*)(sc + c);
                unsigned w0, w1; { const float a = v[0] * rstd * gv[0] * (1.f + scv[0]) + shv[0], b = v[1] * rstd * gv[1] * (1.f + scv[1]) + shv[1]; w0 = (unsigned)f2bf(a) | ((unsigned)f2bf(b) << 16); }
                { const float a = v[2] * rstd * gv[2] * (1.f + scv[2]) + shv[2], b = v[3] * rstd * gv[3] * (1.f + scv[3]) + shv[3]; w1 = (unsigned)f2bf(a) | ((unsigned)f2bf(b) << 16); }
                *(uint2*)(F_HN + (size_t)r * DM + c) = make_uint2(w0, w1); }
        }
    }
}
__device__ __forceinline__ void phase_conv(Frame& F, int b) {
    const int gw = F.bid * 8 + F.wave, NGW = F.G * 8, lane = F.lane;
    constexpr int NSEG = 224, SEGL = 38;
    for (int it = gw; it < 9 * NSEG; it += NGW) {
        const int cg = it / NSEG, sg = it - cg * NSEG, c0 = cg * 512 + lane * 8;
        const bool ssd = c0 < 1536; const float* cw = ssd ? F.in[I_SCONVW] : F.in[I_GCONVW]; const int cc = ssd ? c0 : c0 - 1536, cn = ssd ? 1536 : 3072;
        float wt[5][8], bias[8];
#pragma unroll
        for (int i = 0; i < 5; ++i) { const f32x4 a = *(const f32x4*)(cw + i * cn + cc), bq = *(const f32x4*)(cw + i * cn + cc + 4);
#pragma unroll
            for (int e = 0; e < 4; ++e) { wt[i][e] = a[e]; wt[i][4 + e] = bq[e]; } }
#pragma unroll
        for (int e = 0; e < 8; ++e) bias[e] = ssd ? F.in[I_SCONVB][cc + e] : 0.f;
        const int norm_kind = (c0 >= 1536 && c0 < 2560) ? 1 : ((c0 >= 2560 && c0 < 3584) ? 2 : 0);
        int t0 = sg * SEGL, t1 = t0 + SEGL; if (t1 > TB) t1 = TB; if (t0 >= TB) continue;
        while (t0 < t1) {
            const int seg_lo = t0 < CTXL ? 0 : CTXL, seg_hi = t0 < CTXL ? CTXL : TB; const int te = t1 < seg_hi ? t1 : seg_hi;
            u32x4 win[4], nw[8];
#pragma unroll
            for (int i = 0; i < 4; ++i) { const int uu = t0 + i - 2; win[i] = (uu >= seg_lo && uu < seg_hi) ? *(const u32x4*)(F_RAW + (size_t)uu * 4608 + c0) : (u32x4){0u, 0u, 0u, 0u}; }
#pragma unroll
            for (int j = 0; j < 8; ++j) { const int uu = t0 + 2 + j; nw[j] = (uu < seg_hi) ? *(const u32x4*)(F_RAW + (size_t)uu * 4608 + c0) : (u32x4){0u, 0u, 0u, 0u}; }
            for (int u = t0; u < te; u += 8) {
                u32x4 cur[8];
#pragma unroll
                for (int j = 0; j < 8; ++j) cur[j] = nw[j];
                if (u + 8 < te) {
#pragma unroll
                    for (int j = 0; j < 8; ++j) { const int uu = u + 10 + j; nw[j] = (uu < seg_hi) ? *(const u32x4*)(F_RAW + (size_t)uu * 4608 + c0) : (u32x4){0u, 0u, 0u, 0u}; } }
#pragma unroll
                for (int j = 0; j < 8; ++j) if (u + j < te) {
                    float acc[8];
#pragma unroll
                    for (int e = 0; e < 8; ++e) acc[e] = bias[e];
#pragma unroll
                    for (int i = 0; i < 5; ++i) { const u32x4 wv = i < 4 ? win[i] : cur[j];
#pragma unroll
                        for (int e = 0; e < 4; ++e) { acc[2 * e] = fmaf(wt[i][2 * e], bflo(wv[e]), acc[2 * e]); acc[2 * e + 1] = fmaf(wt[i][2 * e + 1], bfhi(wv[e]), acc[2 * e + 1]); } }
                    float ss = 0.f;
#pragma unroll
                    for (int e = 0; e < 8; ++e) { acc[e] = silu_f(acc[e]); ss = fmaf(acc[e], acc[e], ss); }
                    if (norm_kind) { ss += __shfl_xor(ss, 1); ss += __shfl_xor(ss, 2); ss += __shfl_xor(ss, 4); ss += __shfl_xor(ss, 8);
                        float sc = 1.0f / sqrtf(ss + NEPS); if (norm_kind == 1) sc *= 0.08838834764831845f;
#pragma unroll
                        for (int e = 0; e < 8; ++e) acc[e] *= sc; }
                    *(u32x4*)(F_CV + (size_t)(u + j) * 4608 + c0) = (u32x4){pk2(acc[0], acc[1]), pk2(acc[2], acc[3]), pk2(acc[4], acc[5]), pk2(acc[6], acc[7])};
                    win[0] = win[1]; win[1] = win[2]; win[2] = win[3]; win[3] = cur[j];
                }
            }
            t0 = te;
        }
    }
    for (int i = F.bid * NTHREADS + F.tid; i < TB * 64; i += F.G * NTHREADS) {
        const int j = i & 63; float v = F_ABS[i];
        if (j < 32) v = softplus_f(v + F.in[I_SDTB][j]);
        else if (j < 48) v = sigmoid_f(v);
        else v = -__expf(F.in[I_GALOG][j - 48]) * softplus_f(v + F.in[I_GDTB][j - 48]);
        F_ABS[i] = v;
    }
}
__device__ __forceinline__ int scan_tok(int dir, int i) { return dir == 0 ? i : (i < CTXL ? CTXL - 1 - i : TB + CTXL - 1 - i); }
__device__ __forceinline__ void ssd_naive(Frame& F, int head) {
    const int p = F.tid >> 3, nq = F.tid & 7, g = head >> 3;
    for (int dir = 0; dir < 2; ++dir) {
        const float a = -__expf(F.in[I_SALOG][dir * 16 + head]);
        float S[16];
#pragma unroll
        for (int j = 0; j < 16; ++j) S[j] = 0.f;
        for (int i = 0; i < TB; ++i) {
            const int u = scan_tok(dir, i); const bf16_t* row = F_CV + (size_t)u * 4608;
            const float x = bf2f(row[head * 64 + p]), dt = F_ABS[u * 64 + dir * 16 + head];
            const u32x4 b0 = *(const u32x4*)(row + 1024 + g * 128 + nq * 16), b1 = *(const u32x4*)(row + 1024 + g * 128 + nq * 16 + 8);
            const u32x4 c0 = *(const u32x4*)(row + 1280 + g * 128 + nq * 16), c1 = *(const u32x4*)(row + 1280 + g * 128 + nq * 16 + 8);
            const float dA = __expf(dt * a), xdt = x * dt; float y = 0.f;
#pragma unroll
            for (int j = 0; j < 4; ++j) {
                S[2 * j] = fmaf(S[2 * j], dA, xdt * bflo(b0[j])); y = fmaf(bflo(c0[j]), S[2 * j], y);
                S[2 * j + 1] = fmaf(S[2 * j + 1], dA, xdt * bfhi(b0[j])); y = fmaf(bfhi(c0[j]), S[2 * j + 1], y);
                S[8 + 2 * j] = fmaf(S[8 + 2 * j], dA, xdt * bflo(b1[j])); y = fmaf(bflo(c1[j]), S[8 + 2 * j], y);
                S[8 + 2 * j + 1] = fmaf(S[8 + 2 * j + 1], dA, xdt * bfhi(b1[j])); y = fmaf(bfhi(c1[j]), S[8 + 2 * j + 1], y); }
            y += __shfl_xor(y, 1); y += __shfl_xor(y, 2); y += __shfl_xor(y, 4);
            if (nq == 0) F_YD[((size_t)dir * TB + u) * 2048 + head * 64 + p] = f2bf(y);
        }
    }
}
__device__ __forceinline__ void gdn_naive(Frame& F, int h) {
    const int e = F.tid >> 2, dq = F.tid & 3;
    for (int dir = 0; dir < 2; ++dir) {
        float S[32];
#pragma unroll
        for (int j = 0; j < 32; ++j) S[j] = 0.f;
        for (int i = 0; i < TB; ++i) {
            const int u = scan_tok(dir, i); const bf16_t* row = F_CV + (size_t)u * 4608;
            const float v = bf2f(row[3584 + h * 128 + e]), beta = F_ABS[u * 64 + 32 + dir * 8 + h], eg = __expf(F_ABS[u * 64 + 48 + dir * 8 + h]);
            u32x4 kk[4], qq[4];
#pragma unroll
            for (int j = 0; j < 4; ++j) { kk[j] = *(const u32x4*)(row + 2560 + h * 128 + dq * 32 + j * 8); qq[j] = *(const u32x4*)(row + 1536 + h * 128 + dq * 32 + j * 8); }
            float ks = 0.f;
#pragma unroll
            for (int j = 0; j < 4; ++j)
#pragma unroll
                for (int w = 0; w < 4; ++w) { ks = fmaf(bflo(kk[j][w]), S[j * 8 + 2 * w], ks); ks = fmaf(bfhi(kk[j][w]), S[j * 8 + 2 * w + 1], ks); }
            ks += __shfl_xor(ks, 1); ks += __shfl_xor(ks, 2);
            const float vn = beta * (v - eg * ks); float o = 0.f;
#pragma unroll
            for (int j = 0; j < 4; ++j)
#pragma unroll
                for (int w = 0; w < 4; ++w) {
                    S[j * 8 + 2 * w] = fmaf(eg, S[j * 8 + 2 * w], bflo(kk[j][w]) * vn); o = fmaf(bflo(qq[j][w]), S[j * 8 + 2 * w], o);
                    S[j * 8 + 2 * w + 1] = fmaf(eg, S[j * 8 + 2 * w + 1], bfhi(kk[j][w]) * vn); o = fmaf(bfhi(qq[j][w]), S[j * 8 + 2 * w + 1], o); }
            o += __shfl_xor(o, 1); o += __shfl_xor(o, 2);
            if (dq == 0) F_YD[((size_t)dir * TB + u) * 2048 + 1024 + h * 128 + e] = f2bf(o);
        }
    }
}

__device__ __forceinline__ int crow32(int r, int hi) { return (r & 3) + 8 * (r >> 2) + 4 * hi; }
__device__ __forceinline__ s16x4 tr_read_b64(unsigned addr) { s16x4 r; asm volatile("ds_read_b64_tr_b16 %0, %1" : "=&v"(r) : "v"(addr) : "memory"); return r; }
#define LGKM_WAIT0() do { asm volatile("s_waitcnt lgkmcnt(0)" ::: "memory"); __builtin_amdgcn_sched_barrier(0); } while (0)
#define PK8(L, H) (bf16x8){L[0], L[1], L[2], L[3], H[0], H[1], H[2], H[3]}
__device__ __forceinline__ void ssd_prep_item(Frame& F, int g, int c) {
    const int w = F.wave, r32 = F.lane & 31, h = F.lane >> 5, jt = w >> 1, it0 = (w & 1) * 2;
    const bf16_t* cv = F_CV + (size_t)(c * 128) * 4608; const bf16_t* Bm = cv + 1024 + g * 128; const bf16_t* Cm = cv + 1280 + g * 128;
    f32x16 acc0 = {}, acc1 = {};
#pragma unroll
    for (int s8 = 0; s8 < 8; ++s8) {
        const bf16x8 a = *(const bf16x8*)(Bm + (size_t)(32 * jt + r32) * 4608 + 16 * s8 + 8 * h);
        const bf16x8 b0 = *(const bf16x8*)(Cm + (size_t)(32 * it0 + r32) * 4608 + 16 * s8 + 8 * h);
        const bf16x8 b1 = *(const bf16x8*)(Cm + (size_t)(32 * it0 + 32 + r32) * 4608 + 16 * s8 + 8 * h);
        acc0 = __builtin_amdgcn_mfma_f32_32x32x16_bf16(a, b0, acc0, 0, 0, 0); acc1 = __builtin_amdgcn_mfma_f32_32x32x16_bf16(a, b1, acc1, 0, 0, 0);
    }
    bf16_t* cb = F_CB + (size_t)(g * 66 + c) * 128 * 128;
#pragma unroll
    for (int q = 0; q < 4; ++q) { const int j0 = 32 * jt + 8 * q + 4 * h;
        *(uint2*)(cb + (32 * it0 + r32) * 128 + j0) = make_uint2(pk2(acc0[4 * q], acc0[4 * q + 1]), pk2(acc0[4 * q + 2], acc0[4 * q + 3]));
        *(uint2*)(cb + (32 * it0 + 32 + r32) * 128 + j0) = make_uint2(pk2(acc1[4 * q], acc1[4 * q + 1]), pk2(acc1[4 * q + 2], acc1[4 * q + 3])); }
}
constexpr int SSD_RX = 144, SSD_RB = 272, SSD_RM = 272, SSD_RS = 272, SSD_RC = 272;
constexpr int SSD_XS = 0, SSD_BW = SSD_XS + 128 * SSD_RX, SSD_MS = SSD_BW + 128 * SSD_RB, SSD_CS = SSD_MS + 128 * SSD_RM, SSD_SS = SSD_CS + 128 * SSD_RC, SSD_VEC = SSD_SS + 64 * SSD_RS, SSD_LDS_END = SSD_VEC + 2560;
static_assert(SSD_LDS_END <= 147456 - 512, "SSD LDS");
__device__ __forceinline__ int ssd_chunk(int dir, int s) { return dir == 0 ? s : (s < 2 ? 1 - s : 67 - s); }
__device__ __forceinline__ void ssd_scan(Frame& F, int head, int dir, bf16_t* ydst, int yld, int ycol0) {
    const int tid = F.tid, lane = F.lane, w = F.wave, r32 = lane & 31, h = lane >> 5, g = head >> 3;
    LAS unsigned char* L = F.lds;
    LAS float* vac = (LAS float*)(L + SSD_VEC); LAS float* veac = vac + 128; LAS float* vw = vac + 256; LAS float* vdt = vac + 384; LAS float* vsc = vac + 512;
    const float a = -__expf(F.in[I_SALOG][dir * 16 + head]);
    const int it = w >> 1, pt = w & 1;
    const int srow = tid >> 2, sq = tid & 3;
    const unsigned trq = (unsigned)(8 * h + ((lane & 15) >> 2)), trc = (unsigned)((16 * ((lane >> 4) & 1) + 4 * (lane & 3)) * 2);
    const unsigned vbX = (unsigned)(uintptr_t)(F.ldsg + SSD_XS) + trq * SSD_RX + (unsigned)(64 * pt) + trc;
    const unsigned vbB = (unsigned)(uintptr_t)(F.ldsg + SSD_BW) + trq * SSD_RB + (unsigned)(64 * it) + trc;
    f32x16 accS = {};
    for (int i = tid; i < 64 * SSD_RS / 4; i += NTHREADS) ((LAS unsigned*)(L + SSD_SS))[i] = 0u;
    u32x4 px[2], pb[4], pcb[4], pcc[4]; float pdt0 = 0.f, pdt1 = 0.f;
#define SSD_ISSUE_MAIN(cc) do { const bf16_t* rowp = F_CV + (size_t)((cc) * 128 + srow) * 4608; \
        px[0] = *(const u32x4*)(rowp + head * 64 + sq * 16); px[1] = *(const u32x4*)(rowp + head * 64 + sq * 16 + 8); \
        _Pragma("unroll") for (int k = 0; k < 4; ++k) { pb[k] = *(const u32x4*)(rowp + 1024 + g * 128 + sq * 32 + 8 * k); pcc[k] = *(const u32x4*)(rowp + 1280 + g * 128 + sq * 32 + 8 * k); \
            pcb[k] = *(const u32x4*)(F_CB + ((size_t)(g * 66 + (cc)) * 128 + srow) * 128 + sq * 32 + 8 * k); } \
        pdt0 = F_ABS[(size_t)((cc) * 128 + 2 * lane) * 64 + dir * 16 + head]; pdt1 = F_ABS[(size_t)((cc) * 128 + 2 * lane + 1) * 64 + dir * 16 + head]; } while (0)
    f32x16 yprev = {}; int cprev = 0;
#define SSD_STORE_Y() do { bf16_t* yp = ydst + ((size_t)dir * TB + cprev * 128 + 32 * it + r32) * yld + ycol0 + head * 64 + 32 * pt + 4 * h; \
        _Pragma("unroll") for (int q_ = 0; q_ < 4; ++q_) *(u32x2*)(yp + 8 * q_) = (u32x2){pk2(yprev[4 * q_], yprev[4 * q_ + 1]), pk2(yprev[4 * q_ + 2], yprev[4 * q_ + 3])}; } while (0)
    { const int c0 = ssd_chunk(dir, 0); SSD_ISSUE_MAIN(c0); }
    __syncthreads();
    for (int s = 0; s < 66; ++s) {
        const int c = ssd_chunk(dir, s);
        {
            const float d0 = pdt0 * a, d1 = pdt1 * a, ps = d0 + d1; float inc = ps;
            if (dir == 0) {
#pragma unroll
                for (int o = 1; o < 64; o <<= 1) { const float t = __shfl_up(inc, o); if (lane >= o) inc += t; }
            } else {
#pragma unroll
                for (int o = 1; o < 64; o <<= 1) { const float t = __shfl_down(inc, o); if (lane + o < 64) inc += t; }
            }
            const float tot = __shfl(inc, dir == 0 ? 63 : 0);
            const float ac0 = dir == 0 ? inc - d1 : inc, ac1 = dir == 0 ? inc : inc - d0;
            vac[2 * lane] = ac0; vac[2 * lane + 1] = ac1; veac[2 * lane] = __expf(ac0); veac[2 * lane + 1] = __expf(ac1);
            vw[2 * lane] = __expf(tot - ac0) * pdt0; vw[2 * lane + 1] = __expf(tot - ac1) * pdt1; vdt[2 * lane] = pdt0; vdt[2 * lane + 1] = pdt1;
            if (lane == 0) vsc[0] = __expf(tot);
            asm volatile("s_waitcnt lgkmcnt(0)" ::: "memory");
        }
        {
            const float wr_ = vw[srow], acr = vac[srow];
            *(LAS u32x4*)(L + SSD_XS + srow * SSD_RX + sq * 32) = px[0]; *(LAS u32x4*)(L + SSD_XS + srow * SSD_RX + sq * 32 + 16) = px[1];
#pragma unroll
            for (int k = 0; k < 4; ++k) {
                u32x4 o;
#pragma unroll
                for (int e = 0; e < 4; ++e) o[e] = pk2(bflo(pb[k][e]) * wr_, bfhi(pb[k][e]) * wr_);
                *(LAS u32x4*)(L + SSD_BW + srow * SSD_RB + sq * 64 + k * 16) = o; *(LAS u32x4*)(L + SSD_CS + srow * SSD_RC + sq * 64 + k * 16) = pcc[k];
                const int j0 = sq * 32 + 8 * k;
                const f32x4 aj0 = *(const LAS f32x4*)(vac + j0), aj1 = *(const LAS f32x4*)(vac + j0 + 4), dj0 = *(const LAS f32x4*)(vdt + j0), dj1 = *(const LAS f32x4*)(vdt + j0 + 4);
                float m[8];
#pragma unroll
                for (int e = 0; e < 8; ++e) { const int j = j0 + e; const bool keep = dir == 0 ? (j <= srow) : (j >= srow);
                    const float aj = e < 4 ? aj0[e & 3] : aj1[e & 3], dj = e < 4 ? dj0[e & 3] : dj1[e & 3]; const unsigned wv = pcb[k][e >> 1]; const float cbv = (e & 1) ? bfhi(wv) : bflo(wv);
                    m[e] = keep ? cbv * __expf(acr - aj) * dj : 0.f;
#if DEBUG_SSD
                    if (!(m[e] == m[e]) || fabsf(m[e]) > 1e30f) atomicOr((unsigned*)(F.ws + WS_CTL) + 203, 16u);
                    if (!(cbv == cbv) || fabsf(cbv) > 1e30f) atomicOr((unsigned*)(F.ws + WS_CTL) + 203, 32u);
                    if (keep && (acr - aj) > 1e-3f) atomicOr((unsigned*)(F.ws + WS_CTL) + 203, 64u);
                    if (!(dj == dj) || fabsf(dj) > 1e30f) atomicOr((unsigned*)(F.ws + WS_CTL) + 203, 128u);
#endif
                    }
                u32x4 mo; mo[0] = pk2(m[0], m[1]); mo[1] = pk2(m[2], m[3]); mo[2] = pk2(m[4], m[5]); mo[3] = pk2(m[6], m[7]);
                *(LAS u32x4*)(L + SSD_MS + srow * SSD_RM + sq * 64 + k * 16) = mo;
            }
        }
        if (s + 1 < 66) { const int cn = ssd_chunk(dir, s + 1); SSD_ISSUE_MAIN(cn); }
        if (s > 0) { SSD_STORE_Y(); }
        __syncthreads();
        f32x16 acc = {};
#pragma unroll
        for (int k = 0; k < 8; ++k) { const bf16x8 bs = *(const LAS bf16x8*)(L + SSD_SS + (32 * pt + r32) * SSD_RS + (16 * k + 8 * h) * 2); const bf16x8 cf = *(const LAS bf16x8*)(L + SSD_CS + (32 * it + r32) * SSD_RC + (16 * k + 8 * h) * 2);
            acc = __builtin_amdgcn_mfma_f32_32x32x16_bf16(bs, cf, acc, 0, 0, 0); }
#if DEBUG_SSD
        { bool bn = false; for (int r = 0; r < 16; ++r) bn |= !(acc[r] == acc[r]) || fabsf(acc[r]) > 1e30f; if (bn) atomicOr((unsigned*)(F.ws + WS_CTL) + 203, 2u);
          bool vn = false; for (int r = 0; r < 2; ++r) { const float t0 = vac[lane + 64 * r], t1 = veac[lane + 64 * r], t2 = vw[lane + 64 * r]; vn |= !(t0 == t0) || !(t1 == t1) || !(t2 == t2) || fabsf(t2) > 1e30f; } if (vn) atomicOr((unsigned*)(F.ws + WS_CTL) + 203, 1u); }
#endif
        { const float ea = veac[32 * it + r32];
#pragma unroll
          for (int r = 0; r < 16; ++r) acc[r] *= ea; }
        { const float el = vsc[0];
#pragma unroll
          for (int r = 0; r < 16; ++r) accS[r] *= el; }
        { const int klo = dir == 0 ? 0 : 2 * it, khi = dir == 0 ? 2 * it + 1 : 7;
#pragma unroll
          for (int half = 0; half < 2; ++half) {
            s16x4 xl[4], xh[4], bl[4], bh[4];
#pragma unroll
            for (int k = 0; k < 4; ++k) { const int kk = 4 * half + k; xl[k] = tr_read_b64(vbX + (unsigned)((16 * kk) * SSD_RX)); xh[k] = tr_read_b64(vbX + (unsigned)((16 * kk + 4) * SSD_RX));
                bl[k] = tr_read_b64(vbB + (unsigned)((16 * kk) * SSD_RB)); bh[k] = tr_read_b64(vbB + (unsigned)((16 * kk + 4) * SSD_RB)); }
            LGKM_WAIT0();
#pragma unroll
            for (int k = 0; k < 4; ++k) { const int kk = 4 * half + k;
                if (kk >= klo && kk <= khi) { const bf16x8 am = *(const LAS bf16x8*)(L + SSD_MS + (32 * it + r32) * SSD_RM + (16 * kk + 8 * h) * 2);
                    acc = __builtin_amdgcn_mfma_f32_32x32x16_bf16(PK8(xl[k], xh[k]), am, acc, 0, 0, 0); }
                accS = __builtin_amdgcn_mfma_f32_32x32x16_bf16(PK8(bl[k], bh[k]), PK8(xl[k], xh[k]), accS, 0, 0, 0); }
          } }
#if DEBUG_SSD
        { bool bn = false, sn = false; for (int r = 0; r < 16; ++r) { bn |= !(acc[r] == acc[r]) || fabsf(acc[r]) > 1e30f; sn |= !(accS[r] == accS[r]) || fabsf(accS[r]) > 1e30f; }
          if (bn) atomicOr((unsigned*)(F.ws + WS_CTL) + 203, 4u); if (sn) atomicOr((unsigned*)(F.ws + WS_CTL) + 203, 8u); }
#endif
        yprev = acc; cprev = c;
        __syncthreads();
#pragma unroll
        for (int q = 0; q < 4; ++q) *(LAS u32x2*)(L + SSD_SS + (32 * pt + r32) * SSD_RS + (32 * it + 8 * q + 4 * h) * 2) = (u32x2){pk2(accS[4 * q], accS[4 * q + 1]), pk2(accS[4 * q + 2], accS[4 * q + 3])};
    }
    SSD_STORE_Y();
    __syncthreads();
#undef SSD_ISSUE_MAIN
#undef SSD_STORE_Y
}


template <int MODE>
__device__ __forceinline__ void ssd_items(Frame& F, int first, int stride, bf16_t* ydst, int yld, int ycol0) {
    LAUNDER_PTR(bf16_t*, 1, ydst, ydst);
    const int tid = F.tid, lane = F.lane, w = F.wave, r32 = lane & 31, h = lane >> 5;
    LAS unsigned char* L = F.lds;
    LAS float* vac = (LAS float*)(L + SSD_VEC); LAS float* veac = vac + 128; LAS float* vw = vac + 256; LAS float* vdt = vac + 384; LAS float* vsc = vac + 512;
    const int it = w >> 1, pt = w & 1, srow = tid >> 2, sq = tid & 3;
    const int mrow = 16 * w + (lane & 15), mcb = lane >> 4;
    const unsigned trq = (unsigned)(8 * h + ((lane & 15) >> 2)), trc = (unsigned)((16 * ((lane >> 4) & 1) + 4 * (lane & 3)) * 2);
    const unsigned vbX = (unsigned)(uintptr_t)(F.ldsg + SSD_XS) + trq * SSD_RX + (unsigned)(64 * pt) + trc;
    const unsigned vbB = (unsigned)(uintptr_t)(F.ldsg + SSD_BW) + trq * SSD_RB + (unsigned)(64 * it) + trc;
    u32x4 px[2], pb[4], pcb[4], pcc[4], psi[2]; float pdt0 = 0.f, pdt1 = 0.f;
#define SSDI_ISSUE(i_) do { const int gs_ = xcd + 8 * ((i_) >> 3), ss_ = gs_ >> 2, dr_ = (gs_ >> 1) & 1, gg_ = gs_ & 1, hd_ = gg_ * 8 + ((i_) & 7), ch_ = hd_ * 2 + dr_, cc_ = ssd_chunk(dr_, ss_); \
        const bf16_t* rowp = F_CV + (size_t)(cc_ * 128 + srow) * 4608; \
        px[0] = *(const u32x4*)(rowp + hd_ * 64 + sq * 16); px[1] = *(const u32x4*)(rowp + hd_ * 64 + sq * 16 + 8); \
        _Pragma("unroll") for (int k = 0; k < 4; ++k) { \
            if (MODE == 0) pb[k] = *(const u32x4*)(rowp + 1024 + gg_ * 128 + sq * 32 + 8 * k); \
            else { pcc[k] = *(const u32x4*)(rowp + 1280 + gg_ * 128 + sq * 32 + 8 * k); pcb[k] = *(const u32x4*)(F_CB + ((size_t)(gg_ * 66 + cc_) * 128 + mrow) * 128 + 32 * k + 8 * mcb); } } \
        if (MODE == 1) { if (ss_ > 0) { const bf16_t* sl = F_SST + ((size_t)ch_ * 66 + ssd_chunk(dr_, ss_ - 1)) * 8192 + (size_t)(tid >> 3) * 128 + (tid & 7) * 16; psi[0] = *(const u32x4*)sl; psi[1] = *(const u32x4*)(sl + 8); } \
                         else { psi[0] = (u32x4){0u, 0u, 0u, 0u}; psi[1] = psi[0]; } } \
        pdt0 = F_ABS[(size_t)(cc_ * 128 + 2 * lane) * 64 + dr_ * 16 + hd_]; pdt1 = F_ABS[(size_t)(cc_ * 128 + 2 * lane + 1) * 64 + dr_ * 16 + hd_]; } while (0)
    const int xcd = first & 7, nq = stride >> 3;
    if ((first >> 3) < 264) { SSDI_ISSUE(first >> 3); }
    for (int i = first >> 3; i < 264; i += nq) {
        const int gs = xcd + 8 * (i >> 3), spos = gs >> 2, dir = (gs >> 1) & 1, head = (gs & 1) * 8 + (i & 7), chain = head * 2 + dir, c = ssd_chunk(dir, spos);
        const float a = -__expf(F.in[I_SALOG][dir * 16 + head]);
        {
            const float d0 = pdt0 * a, d1 = pdt1 * a, ps = d0 + d1; float inc = ps;
            if (dir == 0) {
#pragma unroll
                for (int o = 1; o < 64; o <<= 1) { const float t = __shfl_up(inc, o); if (lane >= o) inc += t; }
            } else {
#pragma unroll
                for (int o = 1; o < 64; o <<= 1) { const float t = __shfl_down(inc, o); if (lane + o < 64) inc += t; }
            }
            const float tot = __shfl(inc, dir == 0 ? 63 : 0);
            const float ac0 = dir == 0 ? inc - d1 : inc, ac1 = dir == 0 ? inc : inc - d0;
            if (MODE == 0) { vw[2 * lane] = __expf(tot - ac0) * pdt0; vw[2 * lane + 1] = __expf(tot - ac1) * pdt1; if (lane == 0) vsc[0] = __expf(tot); }
            else { vac[2 * lane] = ac0 * 1.4426950408889634f; vac[2 * lane + 1] = ac1 * 1.4426950408889634f; veac[2 * lane] = __expf(ac0); veac[2 * lane + 1] = __expf(ac1); vdt[2 * lane] = pdt0; vdt[2 * lane + 1] = pdt1; }
            asm volatile("s_waitcnt lgkmcnt(0)" ::: "memory");
        }
        {
            *(LAS u32x4*)(L + SSD_XS + srow * SSD_RX + sq * 32) = px[0]; *(LAS u32x4*)(L + SSD_XS + srow * SSD_RX + sq * 32 + 16) = px[1];
            if (MODE == 0) { const float wr_ = vw[srow];
#pragma unroll
                for (int k = 0; k < 4; ++k) { u32x4 o;
#pragma unroll
                    for (int e = 0; e < 4; ++e) o[e] = pk2(bflo(pb[k][e]) * wr_, bfhi(pb[k][e]) * wr_);
                    *(LAS u32x4*)(L + SSD_BW + srow * SSD_RB + sq * 64 + k * 16) = o; }
            } else {
                *(LAS u32x4*)(L + SSD_SS + (tid >> 3) * SSD_RS + (tid & 7) * 32) = psi[0]; *(LAS u32x4*)(L + SSD_SS + (tid >> 3) * SSD_RS + (tid & 7) * 32 + 16) = psi[1];
#pragma unroll
                for (int k = 0; k < 4; ++k) *(LAS u32x4*)(L + SSD_CS + srow * SSD_RC + sq * 64 + k * 16) = pcc[k];
                const float acr = vac[mrow]; const int dq_ = w >> 1;
#pragma unroll
                for (int k = 0; k < 4; ++k) {
                    const bool need = dir == 0 ? (k <= dq_) : (k >= dq_);
                    if (need) {
                        const int j0 = 32 * k + 8 * mcb;
                        const f32x4 aj0 = *(const LAS f32x4*)(vac + j0), aj1 = *(const LAS f32x4*)(vac + j0 + 4), dj0 = *(const LAS f32x4*)(vdt + j0), dj1 = *(const LAS f32x4*)(vdt + j0 + 4);
                        float m[8];
#pragma unroll
                        for (int e = 0; e < 8; ++e) { const int j = j0 + e; const bool keep = dir == 0 ? (j <= mrow) : (j >= mrow);
                            const float aj = e < 4 ? aj0[e & 3] : aj1[e & 3], dj = e < 4 ? dj0[e & 3] : dj1[e & 3]; const unsigned wv = pcb[k][e >> 1]; const float cbv = (e & 1) ? bfhi(wv) : bflo(wv);
                            m[e] = keep ? cbv * __builtin_amdgcn_exp2f(acr - aj) * dj : 0.f; }
                        *(LAS u32x4*)(L + SSD_MS + mrow * SSD_RM + j0 * 2) = (u32x4){pk2(m[0], m[1]), pk2(m[2], m[3]), pk2(m[4], m[5]), pk2(m[6], m[7])};
                    }
                }
            }
        }
        if (i + nq < 264) { SSDI_ISSUE(i + nq); }
        __syncthreads();
        if (MODE == 0) {
            f32x16 accS = {};
#pragma unroll
            for (int half = 0; half < 2; ++half) {
                s16x4 xl[4], xh[4], bl[4], bh[4];
#pragma unroll
                for (int k = 0; k < 4; ++k) { const int kk = 4 * half + k; xl[k] = tr_read_b64(vbX + (unsigned)((16 * kk) * SSD_RX)); xh[k] = tr_read_b64(vbX + (unsigned)((16 * kk + 4) * SSD_RX));
                    bl[k] = tr_read_b64(vbB + (unsigned)((16 * kk) * SSD_RB)); bh[k] = tr_read_b64(vbB + (unsigned)((16 * kk + 4) * SSD_RB)); }
                LGKM_WAIT0();
#pragma unroll
                for (int k = 0; k < 4; ++k) accS = __builtin_amdgcn_mfma_f32_32x32x16_bf16(PK8(bl[k], bh[k]), PK8(xl[k], xh[k]), accS, 0, 0, 0);
            }
            bf16_t* slot = F_SST + ((size_t)chain * 66 + c) * 8192 + (size_t)(32 * pt + r32) * 128 + 32 * it + 4 * h;
#pragma unroll
            for (int q = 0; q < 4; ++q) *(u32x2*)(slot + 8 * q) = (u32x2){pk2(accS[4 * q], accS[4 * q + 1]), pk2(accS[4 * q + 2], accS[4 * q + 3])};
            if (tid == 0) F_SEL[chain * 66 + c] = vsc[0];
        } else {
            f32x16 acc = {};
#pragma unroll
            for (int k = 0; k < 8; ++k) { const bf16x8 bs = *(const LAS bf16x8*)(L + SSD_SS + (32 * pt + r32) * SSD_RS + (16 * k + 8 * h) * 2); const bf16x8 cf = *(const LAS bf16x8*)(L + SSD_CS + (32 * it + r32) * SSD_RC + (16 * k + 8 * h) * 2);
                acc = __builtin_amdgcn_mfma_f32_32x32x16_bf16(bs, cf, acc, 0, 0, 0); }
            { const float ea = veac[32 * it + r32];
#pragma unroll
              for (int r = 0; r < 16; ++r) acc[r] *= ea; }
            { const int klo = dir == 0 ? 0 : 2 * it, khi = dir == 0 ? 2 * it + 1 : 7;
#pragma unroll
              for (int half = 0; half < 2; ++half) {
                s16x4 xl[4], xh[4];
#pragma unroll
                for (int k = 0; k < 4; ++k) { const int kk = 4 * half + k; xl[k] = tr_read_b64(vbX + (unsigned)((16 * kk) * SSD_RX)); xh[k] = tr_read_b64(vbX + (unsigned)((16 * kk + 4) * SSD_RX)); }
                LGKM_WAIT0();
#pragma unroll
                for (int k = 0; k < 4; ++k) { const int kk = 4 * half + k;
                    if (kk >= klo && kk <= khi) { const bf16x8 am = *(const LAS bf16x8*)(L + SSD_MS + (32 * it + r32) * SSD_RM + (16 * kk + 8 * h) * 2);
                        acc = __builtin_amdgcn_mfma_f32_32x32x16_bf16(PK8(xl[k], xh[k]), am, acc, 0, 0, 0); } }
              } }
            bf16_t* yp = ydst + ((size_t)dir * TB + c * 128 + 32 * it + r32) * yld + ycol0 + head * 64 + 32 * pt + 4 * h;
#pragma unroll
            for (int q = 0; q < 4; ++q) *(u32x2*)(yp + 8 * q) = (u32x2){pk2(acc[4 * q], acc[4 * q + 1]), pk2(acc[4 * q + 2], acc[4 * q + 3])};
        }
        __syncthreads();
    }
#undef SSDI_ISSUE
}
__device__ __forceinline__ void ssd_state_scan(Frame& F, int chain) {
    const int tid = F.tid, dir = chain & 1;
    float S[16];
#pragma unroll
    for (int i = 0; i < 16; ++i) S[i] = 0.f;
    bf16_t* base = F_SST + (size_t)chain * 66 * 8192 + tid * 16;
    u32x4 r0[6], r1[6]; float rel[6];
#pragma unroll
    for (int j = 0; j < 6; ++j) { const int cn = ssd_chunk(dir, j); r0[j] = *(const u32x4*)(base + (size_t)cn * 8192); r1[j] = *(const u32x4*)(base + (size_t)cn * 8192 + 8); rel[j] = F_SEL[chain * 66 + cn]; }
    for (int s6 = 0; s6 < 66; s6 += 6) {
#pragma unroll
        for (int j = 0; j < 6; ++j) {
            const int s = s6 + j, c = ssd_chunk(dir, s); const u32x4 l0 = r0[j], l1 = r1[j]; const float el = rel[j];
            if (s + 6 < 66) { const int cn = ssd_chunk(dir, s + 6); r0[j] = *(const u32x4*)(base + (size_t)cn * 8192); r1[j] = *(const u32x4*)(base + (size_t)cn * 8192 + 8); rel[j] = F_SEL[chain * 66 + cn]; }
#pragma unroll
            for (int e = 0; e < 4; ++e) { S[2 * e] = fmaf(el, S[2 * e], bflo(l0[e])); S[2 * e + 1] = fmaf(el, S[2 * e + 1], bfhi(l0[e])); S[8 + 2 * e] = fmaf(el, S[8 + 2 * e], bflo(l1[e])); S[8 + 2 * e + 1] = fmaf(el, S[8 + 2 * e + 1], bfhi(l1[e])); }
            *(u32x4*)(base + (size_t)c * 8192) = (u32x4){pk2(S[0], S[1]), pk2(S[2], S[3]), pk2(S[4], S[5]), pk2(S[6], S[7])};
            *(u32x4*)(base + (size_t)c * 8192 + 8) = (u32x4){pk2(S[8], S[9]), pk2(S[10], S[11]), pk2(S[12], S[13]), pk2(S[14], S[15])};
        }
    }
}
__device__ __forceinline__ int gdn_chunk(int dir, int s) { return dir == 0 ? s : (s < 4 ? 3 - s : 135 - s); }
#define GT_PTR(h_, dir_, c_) (F.ws + AR_GT + ((size_t)((h_) * 2 + (dir_)) * 132 + (c_)) * GT_STRIDE)
__device__ __forceinline__ void gdn_prep_round(Frame& F, int item0, int nitems) {
    LAS float* Aw = (LAS float*)F.lds;
    const int w = F.wave, lane = F.lane, r32 = lane & 31, hh = lane >> 5;
    const int kind = w >> 2, it = (w >> 1) & 1, jt = w & 1;
    bf16x8 fa[8], fb[8];
#define GDNP_LOAD(li_) do { const int item_ = item0 + (li_), h_ = item_ / 132, c_ = item_ - h_ * 132; \
        const bf16_t* rowsrc = F_CV + (size_t)(c_ * 64 + 32 * it + r32) * 4608 + (kind ? 1536 : 2560) + h_ * 128 + 8 * hh; \
        const bf16_t* colsrc = F_CV + (size_t)(c_ * 64 + 32 * jt + r32) * 4608 + 2560 + h_ * 128 + 8 * hh; \
        _Pragma("unroll") for (int s8 = 0; s8 < 8; ++s8) { fa[s8] = *(const bf16x8*)(rowsrc + 16 * s8); fb[s8] = *(const bf16x8*)(colsrc + 16 * s8); } } while (0)
    GDNP_LOAD(0);
#pragma unroll 1
    for (int li = 0; li < nitems; ++li) {
        const int item = item0 + li;
        const int h = item / 132, c = item - h * 132;
        const float* ab = F_ABS + (size_t)(c * 64 + lane) * 64;
        const float gf = ab[48 + h], gb = ab[56 + h], btf = ab[32 + h], btb = ab[40 + h];
        float gcf = gf, gcb = gb;
#pragma unroll
        for (int o = 1; o < 64; o <<= 1) { const float t = __shfl_up(gcf, o); if (lane >= o) gcf += t; const float t2 = __shfl_down(gcb, o); if (lane + o < 64) gcb += t2; }
        f32x16 G = {};
#pragma unroll
        for (int s8 = 0; s8 < 8; ++s8) G = __builtin_amdgcn_mfma_f32_32x32x16_bf16(fa[s8], fb[s8], G, 0, 0, 0);
        if (li + 1 < nitems) GDNP_LOAD(li + 1);
        LAS float* vt = (LAS float*)(F.lds + 131072) + w * 256;
        vt[lane] = gcf; vt[64 + lane] = gcb; vt[128 + lane] = btf; vt[192 + lane] = btb;
        asm volatile("s_waitcnt lgkmcnt(0)" ::: "memory");
        const int j = 32 * jt + r32; const float gcf_j = vt[j], gcb_j = vt[64 + j];
        bf16_t* qkf = (bf16_t*)(GT_PTR(h, 0, c) + 8192); bf16_t* qkb = (bf16_t*)(GT_PTR(h, 1, c) + 8192);
        float gfi[16], gbi[16], bfi[16], bbi[16];
#pragma unroll
        for (int r = 0; r < 16; ++r) { const int i = 32 * it + crow32(r, hh); gfi[r] = vt[i]; gbi[r] = vt[64 + i]; bfi[r] = vt[128 + i]; bbi[r] = vt[192 + i]; }
#pragma unroll
        for (int r = 0; r < 16; ++r) {
            const int i = 32 * it + crow32(r, hh); const float g = G[r];
            const float ef = __expf(fminf(gfi[r] - gcf_j, 0.f)), eb = __expf(fminf(gbi[r] - gcb_j, 0.f));
            if (kind == 0) {
                Aw[((li * 2 + 0) * 64 + i) * 64 + j] = (j < i) ? bfi[r] * g * ef : 0.f;
                Aw[((li * 2 + 1) * 64 + (63 - i)) * 64 + (63 - j)] = (j > i) ? bbi[r] * g * eb : 0.f;
            } else {
                qkf[i * 64 + j] = f2bf((j <= i) ? g * ef : 0.f);
                qkb[(63 - i) * 64 + (63 - j)] = f2bf((j >= i) ? g * eb : 0.f);
            }
        }
    }
#undef GDNP_LOAD
    __syncthreads();
    {
        const int li = w >> 1, dir = w & 1, item = item0 + li;
        if (li < nitems) {
            const int h = item / 132, c = item - h * 132; const int tok = dir ? 63 - lane : lane;
            const float* ab = F_ABS + (size_t)(c * 64 + tok) * 64; const float g = ab[48 + dir * 8 + h], bt = ab[32 + dir * 8 + h];
            float gc = g;
#pragma unroll
            for (int o = 1; o < 64; o <<= 1) { const float t = __shfl_up(gc, o); if (lane >= o) gc += t; }
            const float gl = __shfl(gc, 63);
            float* vec = (float*)(GT_PTR(h, dir, c) + 16384);
            vec[lane] = __expf(gc); vec[64 + lane] = __expf(gl - gc); if (lane == 0) vec[128] = __expf(gl);
            const LAS float* A = Aw + (size_t)w * 64 * 64;
            bf16_t* tb = (bf16_t*)GT_PTR(h, dir, c);
            float x[64];
#pragma unroll
            for (int i = 0; i < 64; ++i) {
                int li_ = lane; asm volatile("" : "+v"(li_));
                float xi = (li_ == i) ? 1.f : 0.f, xa = 0.f, xb = 0.f, xc = 0.f;
#pragma unroll
                for (int j4 = 0; j4 < (i + 3) / 4; ++j4) { const f32x4 a4 = *(const LAS f32x4*)(A + i * 64 + 4 * j4);
                    if (4 * j4 + 0 < i) xi = fmaf(-a4[0], x[4 * j4 + 0], xi); if (4 * j4 + 1 < i) xa = fmaf(-a4[1], x[4 * j4 + 1], xa);
                    if (4 * j4 + 2 < i) xb = fmaf(-a4[2], x[4 * j4 + 2], xb); if (4 * j4 + 3 < i) xc = fmaf(-a4[3], x[4 * j4 + 3], xc); }
                xi = (xi + xa) + (xb + xc);
                x[i] = xi;
                tb[i * 64 + lane] = f2bf(xi * bt);
                asm volatile("" ::: "memory");
            }
        }
    }
    __syncthreads();
}

__device__ __forceinline__ void gdn_combine(Frame& F, int chain) {
    const int tid = F.tid, w = F.wave, r32 = F.lane & 31, hh = F.lane >> 5;
    const float* BT = F_GBT + (size_t)chain * 3 * 16384; const bf16_t* PH = F_GPH + (size_t)chain * 2 * 16384; float* SS = F_GSS + (size_t)chain * 3 * 16384;
    for (int i = tid; i < 4096; i += NTHREADS) ((f32x4*)SS)[i] = ((const f32x4*)BT)[i];
    __syncthreads();
    for (int g = 1; g < 3; ++g) {
        const float* So = SS + (size_t)(g - 1) * 16384; const bf16_t* Ph = PH + (size_t)(g - 1) * 16384; const float* Bg = BT + (size_t)g * 16384; float* Sn = SS + (size_t)g * 16384;
        const int dtile = w >> 1;
#pragma unroll
        for (int et = 0; et < 2; ++et) { const int etile = (w & 1) * 2 + et; f32x16 acc;
#pragma unroll
            for (int qd = 0; qd < 4; ++qd) { const f32x4 b4 = *(const f32x4*)(Bg + (size_t)(32 * etile + r32) * 128 + 32 * dtile + 8 * qd + 4 * hh); acc[4 * qd] = b4[0]; acc[4 * qd + 1] = b4[1]; acc[4 * qd + 2] = b4[2]; acc[4 * qd + 3] = b4[3]; }
#pragma unroll
            for (int k = 0; k < 8; ++k) { const bf16x8 a = *(const bf16x8*)(Ph + (size_t)(32 * dtile + r32) * 128 + 16 * k + 8 * hh);
                const f32x4 s0 = *(const f32x4*)(So + (size_t)(32 * etile + r32) * 128 + 16 * k + 8 * hh), s1 = *(const f32x4*)(So + (size_t)(32 * etile + r32) * 128 + 16 * k + 8 * hh + 4);
                u32x4 bw = {pk2(s0[0], s0[1]), pk2(s0[2], s0[3]), pk2(s1[0], s1[1]), pk2(s1[2], s1[3])};
                acc = __builtin_amdgcn_mfma_f32_32x32x16_bf16(a, *reinterpret_cast<bf16x8*>(&bw), acc, 0, 0, 0); }
#pragma unroll
            for (int qd = 0; qd < 4; ++qd) *(f32x4*)(Sn + (size_t)(32 * etile + r32) * 128 + 32 * dtile + 8 * qd + 4 * hh) = (f32x4){acc[4 * qd], acc[4 * qd + 1], acc[4 * qd + 2], acc[4 * qd + 3]};
        }
        __syncthreads();
    }
}
constexpr int GL_K = 0, GL_Q = GL_K + 64 * 272, GL_V = GL_Q + 64 * 272, GL_TB = GL_V + 64 * 144, GL_QK = GL_TB + 64 * 144, GL_VEC = GL_QK + 64 * 144, GL_BUF = GL_VEC + 768;
static_assert(2 * GL_BUF <= 131072, "GDN LDS");
__device__ __forceinline__ bf16x8 ld2x8(const LAS unsigned char* p0, const LAS unsigned char* p1) { const u32x2 a = *(const LAS u32x2*)p0, b = *(const LAS u32x2*)p1; u32x4 w = {a[0], a[1], b[0], b[1]}; return *reinterpret_cast<bf16x8*>(&w); }
__device__ __forceinline__ bf16x8 pack2t(const f32x4 t0, const f32x4 t1) { u32x4 w = {pk2(t0[0], t0[1]), pk2(t0[2], t0[3]), pk2(t1[0], t1[1]), pk2(t1[2], t1[3])}; return *reinterpret_cast<bf16x8*>(&w); }
__device__ __forceinline__ void gdn_scan(Frame& F, int h, int dir, int cb, int s0, int s1, const float* sinit, float* sfin, bf16_t* pfin, bool out_en, bf16_t* ydst, int yld, int ycol0) {
    LAUNDER_PTR(bf16_t*, 1, ydst, ydst);
    const bool phi = cb >= 2; const int eb = cb & 1;
    const int tid = F.tid, lane = F.lane, w = F.wave, m = lane & 15, q = lane >> 4;
    LAS unsigned char* L = F.lds;
    const int st = tid - 256;
#define GDN_TOUCH_HOOK do { asm volatile("" :: "v"(tch0), "v"(tch1)); \
        if (tc3 >= 0) { const int trow = st >> 2, tpart = st & 3; \
            tch0 = *(const unsigned*)(F_CV + (size_t)(tc3 * 64 + trow) * 4608 + h * 128 + ((tpart & 2) ? 1536 : 2560) + (tpart & 1) * 64); \
            if (st < 192) { const int which = st >> 6, r2 = st & 63; const unsigned char* gt3 = GT_PTR(h, dir, tc3); \
                tch1 = *(const unsigned*)(which == 0 ? (const unsigned char*)(F_CV + (size_t)(tc3 * 64 + r2) * 4608 + 3584 + h * 128 + eb * 64) : (gt3 + (which - 1) * 8192 + r2 * 128)); } } } while (0)
#define GDN_STAGE(cc, bufo) do { const int tokb = (cc) * 64; const unsigned char* gt = GT_PTR(h, dir, (cc)); \
        u32x4 rk[4], rq[4], rv[2], rt[2], rqk[2], rvec = {0u, 0u, 0u, 0u}; \
        _Pragma("unroll") for (int i = 0; i < 4; ++i) { const int p = st + 256 * i, row = p >> 4, c16 = p & 15; const bf16_t* src = F_CV + (size_t)(tokb + (dir ? 63 - row : row)) * 4608 + h * 128 + c16 * 8; \
            rk[i] = *(const u32x4*)(src + 2560); rq[i] = *(const u32x4*)(src + 1536); } \
        _Pragma("unroll") for (int i = 0; i < 2; ++i) { const int p = st + 256 * i, row = p >> 3, c16 = p & 7; \
            rv[i] = *(const u32x4*)(F_CV + (size_t)(tokb + (dir ? 63 - row : row)) * 4608 + 3584 + h * 128 + eb * 64 + c16 * 8); \
            rt[i] = *(const u32x4*)(gt + row * 128 + c16 * 16); rqk[i] = *(const u32x4*)(gt + 8192 + row * 128 + c16 * 16); } \
        if (st < 48) rvec = *(const u32x4*)(gt + 16384 + st * 16); \
        GDN_TOUCH_HOOK; \
        _Pragma("unroll") for (int i = 0; i < 4; ++i) { const int p = st + 256 * i, row = p >> 4, c16 = p & 15; \
            *(LAS u32x4*)(L + (bufo) + GL_K + row * 272 + c16 * 16) = rk[i]; *(LAS u32x4*)(L + (bufo) + GL_Q + row * 272 + c16 * 16) = rq[i]; } \
        _Pragma("unroll") for (int i = 0; i < 2; ++i) { const int p = st + 256 * i, row = p >> 3, c16 = p & 7; \
            *(LAS u32x4*)(L + (bufo) + GL_V + row * 144 + c16 * 16) = rv[i]; *(LAS u32x4*)(L + (bufo) + GL_TB + row * 144 + c16 * 16) = rt[i]; *(LAS u32x4*)(L + (bufo) + GL_QK + row * 144 + c16 * 16) = rqk[i]; } \
        if (st < 48) *(LAS u32x4*)(L + (bufo) + GL_VEC + st * 16) = rvec; } while (0)
    f32x4 S[8]; unsigned tch0 = 0u, tch1 = 0u;
#pragma unroll
    for (int i = 0; i < 8; ++i) {
        if (phi) {
#pragma unroll
            for (int r = 0; r < 4; ++r) S[i][r] = (16 * i + 4 * q + r == 64 * (cb - 2) + 16 * (w & 3) + m) ? 1.f : 0.f;
        } else if (sinit) S[i] = *(const f32x4*)(sinit + (size_t)(16 * (w & 3) + m) * 128 + 16 * i + 4 * q);
        else S[i] = (f32x4){0.f, 0.f, 0.f, 0.f};
    }
    int tc3 = -1;
    if (w >= 4) { tc3 = s0 + 2 < s1 ? gdn_chunk(dir, s0 + 2) : -1; GDN_STAGE(gdn_chunk(dir, s0), 0); }
    __syncthreads();
    const int qp = (lane & 15) >> 2, pp = lane & 3;
    for (int s = s0; s < s1; ++s) {
        const int bo = ((s - s0) & 1) * GL_BUF;
        if (w >= 4) {
            tc3 = s + 3 < s1 ? gdn_chunk(dir, s + 3) : -1;
            if (s + 1 < s1) { GDN_STAGE(gdn_chunk(dir, s + 1), GL_BUF - bo); }
        } else {
            const int c = gdn_chunk(dir, s), cw = w;
            const LAS unsigned char* Kp = L + bo + GL_K; const LAS unsigned char* Qp = L + bo + GL_Q; const LAS unsigned char* TBp = L + bo + GL_TB; const LAS unsigned char* QKp = L + bo + GL_QK;
            const LAS float* egc = (const LAS float*)(L + bo + GL_VEC); const LAS float* w2 = egc + 64;
            const float egl = egc[128];
            bf16x8 sb[4];
#pragma unroll
            for (int k = 0; k < 4; ++k) sb[k] = pack2t(S[2 * k], S[2 * k + 1]);
            f32x4 KS[4], QS[4];
#pragma unroll
            for (int it = 0; it < 4; ++it) { KS[it] = (f32x4){0.f, 0.f, 0.f, 0.f}; QS[it] = (f32x4){0.f, 0.f, 0.f, 0.f}; }
#pragma unroll
            for (int ih = 0; ih < 2; ++ih) {
                bf16x8 ak[2][4], aq[2][4];
#pragma unroll
                for (int i2 = 0; i2 < 2; ++i2)
#pragma unroll
                    for (int k = 0; k < 4; ++k) { const int ro = (16 * (2 * ih + i2) + m) * 272 + (32 * k + 4 * q) * 2; ak[i2][k] = ld2x8(Kp + ro, Kp + ro + 32); aq[i2][k] = ld2x8(Qp + ro, Qp + ro + 32); }
#pragma unroll
                for (int i2 = 0; i2 < 2; ++i2)
#pragma unroll
                    for (int k = 0; k < 4; ++k) { KS[2 * ih + i2] = __builtin_amdgcn_mfma_f32_16x16x32_bf16(ak[i2][k], sb[k], KS[2 * ih + i2], 0, 0, 0);
                        if (out_en) QS[2 * ih + i2] = __builtin_amdgcn_mfma_f32_16x16x32_bf16(sb[k], aq[i2][k], QS[2 * ih + i2], 0, 0, 0); }
            }
            f32x4 eg4[4];
#pragma unroll
            for (int it = 0; it < 4; ++it) eg4[it] = *(const LAS f32x4*)(egc + 16 * it + 4 * q);
            bf16x8 ksb[2], vfr[2], tn[4][2], tp[4][2];
            { const unsigned vb = (unsigned)(uintptr_t)(F.ldsg + bo + GL_V) + (unsigned)((8 * q + qp) * 144 + (16 * cw + 4 * pp) * 2);
              const s16x4 a0 = tr_read_b64(vb), a1 = tr_read_b64(vb + 4 * 144), b0 = tr_read_b64(vb + 32 * 144), b1 = tr_read_b64(vb + 36 * 144);
#pragma unroll
              for (int it = 0; it < 4; ++it)
#pragma unroll
                  for (int k = 0; k < 2; ++k) { const int rn = (16 * it + m) * 144 + (32 * k + 8 * q) * 2, rp = (16 * it + m) * 144 + (32 * k + 4 * q) * 2;
                      tn[it][k] = *(const LAS bf16x8*)(TBp + rn); tp[it][k] = ld2x8(TBp + rp, TBp + rp + 32); }
              LGKM_WAIT0(); vfr[0] = PK8(a0, a1); vfr[1] = PK8(b0, b1); }
#pragma unroll
            for (int k = 0; k < 2; ++k) ksb[k] = pack2t(-(eg4[2 * k] * KS[2 * k]), -(eg4[2 * k + 1] * KS[2 * k + 1]));
            f32x4 VN[4];
#pragma unroll
            for (int it = 0; it < 4; ++it) { VN[it] = (f32x4){0.f, 0.f, 0.f, 0.f};
#pragma unroll
                for (int k = 0; k < 2; ++k) {
                    if (!phi) VN[it] = __builtin_amdgcn_mfma_f32_16x16x32_bf16(tn[it][k], vfr[k], VN[it], 0, 0, 0);
                    VN[it] = __builtin_amdgcn_mfma_f32_16x16x32_bf16(tp[it][k], ksb[k], VN[it], 0, 0, 0); } }
            bf16x8 vnb[2], vnw[2];
#pragma unroll
            for (int k = 0; k < 2; ++k) { vnb[k] = pack2t(VN[2 * k], VN[2 * k + 1]);
                const f32x4 wa = *(const LAS f32x4*)(w2 + 32 * k + 4 * q), wb = *(const LAS f32x4*)(w2 + 32 * k + 16 + 4 * q); vnw[k] = pack2t(wa * VN[2 * k], wb * VN[2 * k + 1]); }
            bf16x8 qkf[4][2];
#pragma unroll
            for (int it = 0; it < 4; ++it)
#pragma unroll
                for (int k = 0; k < 2; ++k) { const int rp = (16 * it + m) * 144 + (32 * k + 4 * q) * 2; qkf[it][k] = ld2x8(QKp + rp, QKp + rp + 32); }
            const unsigned kb = (unsigned)(uintptr_t)(F.ldsg + bo + GL_K) + (unsigned)((4 * q + qp) * 272 + (4 * pp) * 2);
            s16x4 ka[4][4];
#pragma unroll
            for (int d4 = 0; d4 < 4; ++d4) { ka[d4][0] = tr_read_b64(kb + d4 * 32); ka[d4][1] = tr_read_b64(kb + d4 * 32 + 16 * 272); ka[d4][2] = tr_read_b64(kb + d4 * 32 + 32 * 272); ka[d4][3] = tr_read_b64(kb + d4 * 32 + 48 * 272); }
            if (out_en)
#pragma unroll
            for (int it = 0; it < 4; ++it) { f32x4 o = QS[it] * egc[16 * it + m];
#pragma unroll
                for (int k = 0; k < 2; ++k) o = __builtin_amdgcn_mfma_f32_16x16x32_bf16(vnb[k], qkf[it][k], o, 0, 0, 0);
                const int ip = 16 * it + m, tok = c * 64 + (dir ? 63 - ip : ip);
                *(u32x2*)(ydst + ((size_t)dir * TB + tok) * yld + ycol0 + h * 128 + eb * 64 + 16 * cw + 4 * q) = (u32x2){pk2(o[0], o[1]), pk2(o[2], o[3])}; }
            LGKM_WAIT0();
#pragma unroll
            for (int d4 = 0; d4 < 4; ++d4) { f32x4 sn = S[d4] * egl;
                sn = __builtin_amdgcn_mfma_f32_16x16x32_bf16(PK8(ka[d4][0], ka[d4][1]), vnw[0], sn, 0, 0, 0);
                sn = __builtin_amdgcn_mfma_f32_16x16x32_bf16(PK8(ka[d4][2], ka[d4][3]), vnw[1], sn, 0, 0, 0); S[d4] = sn; }
#pragma unroll
            for (int d4 = 0; d4 < 4; ++d4) { ka[d4][0] = tr_read_b64(kb + (4 + d4) * 32); ka[d4][1] = tr_read_b64(kb + (4 + d4) * 32 + 16 * 272); ka[d4][2] = tr_read_b64(kb + (4 + d4) * 32 + 32 * 272); ka[d4][3] = tr_read_b64(kb + (4 + d4) * 32 + 48 * 272); }
            LGKM_WAIT0();
#pragma unroll
            for (int d4 = 0; d4 < 4; ++d4) { f32x4 sn = S[4 + d4] * egl;
                sn = __builtin_amdgcn_mfma_f32_16x16x32_bf16(PK8(ka[d4][0], ka[d4][1]), vnw[0], sn, 0, 0, 0);
                sn = __builtin_amdgcn_mfma_f32_16x16x32_bf16(PK8(ka[d4][2], ka[d4][3]), vnw[1], sn, 0, 0, 0); S[4 + d4] = sn; }
        }
        __syncthreads();
    }
    if (w < 4) {
        if (sfin) {
#pragma unroll
            for (int i = 0; i < 8; ++i) *(f32x4*)(sfin + (size_t)(16 * w + m) * 128 + 16 * i + 4 * q) = S[i]; }
        if (pfin) {
#pragma unroll
            for (int i = 0; i < 8; ++i)
#pragma unroll
                for (int r = 0; r < 4; ++r) pfin[(size_t)(16 * i + 4 * q + r) * 128 + 64 * (cb - 2) + 16 * w + m] = f2bf(S[i][r]); }
    }
#undef GDN_STAGE
#undef GDN_TOUCH_HOOK
}
__device__ __forceinline__ void trread_selftest(Frame& F) {
    if (F.bid != 0) return;
    LAS unsigned short* tile = (LAS unsigned short*)(F.lds + 65536);
    for (int i = F.tid; i < 32 * 32; i += NTHREADS) tile[i] = (unsigned short)i;
    __syncthreads();
    if (F.wave == 1) {
        const int lane = F.lane, h = lane >> 5; const unsigned trq = (unsigned)(8 * h + ((lane & 15) >> 2)), trc = (unsigned)((16 * ((lane >> 4) & 1) + 4 * (lane & 3)) * 2);
        const unsigned vb = (unsigned)(uintptr_t)(F.ldsg + 65536) + trq * 64 + trc;
        const s16x4 lo = tr_read_b64(vb), hi = tr_read_b64(vb + 4 * 64);
        LGKM_WAIT0();
        bool bad = false;
#pragma unroll
        for (int e = 0; e < 4; ++e) { bad |= ((unsigned short)lo[e] != (unsigned short)((8 * h + e) * 32 + (lane & 31))); bad |= ((unsigned short)hi[e] != (unsigned short)((8 * h + 4 + e) * 32 + (lane & 31))); }
        if (bad) atomicOr((unsigned*)(F.ws + WS_CTL) + 200, 1u);
    }
    __syncthreads();
}
__device__ __forceinline__ void phase_finish(Frame& F, int b) {
    const int gw = F.bid * 8 + F.wave, NGW = F.G * 8, lane = F.lane;
    const int k = gw & 3, c0 = k * 512 + lane * 8;
    float wn0[8];
    { const float* np = k < 2 ? F.in[I_SNORM] + c0 : F.in[I_GNORM] + (lane & 15) * 8; const f32x4 n0 = *(const f32x4*)np, n1 = *(const f32x4*)(np + 4);
#pragma unroll
      for (int e = 0; e < 4; ++e) { wn0[e] = n0[e]; wn0[4 + e] = n1[e]; } }
    const float dsk = k < 2 ? F.in[I_SD][c0 >> 6] : 0.f;
    for (int it0 = gw; it0 < TB * 4; it0 += 4 * NGW) {
        u32x4 y0[4], y1[4], zg[4], xs[4];
#pragma unroll
        for (int q = 0; q < 4; ++q) { const int it = it0 + q * NGW, u = it >> 2;
            if (it < TB * 4) { y0[q] = *(const u32x4*)(F_YD + (size_t)u * 2048 + c0); y1[q] = *(const u32x4*)(F_YD + ((size_t)TB + u) * 2048 + c0); zg[q] = *(const u32x4*)(F_ZG + (size_t)u * 2048 + c0);
                xs[q] = k < 2 ? *(const u32x4*)(F_CV + (size_t)u * 4608 + c0) : (u32x4){0u, 0u, 0u, 0u}; }
            else { y0[q] = (u32x4){0u, 0u, 0u, 0u}; y1[q] = y0[q]; zg[q] = y0[q]; xs[q] = y0[q]; } }
#pragma unroll
        for (int q = 0; q < 4; ++q) { const int it = it0 + q * NGW, u = it >> 2;
            if (it < TB * 4) {
                float y[8], zz[8], wn[8]; float ss = 0.f;
#pragma unroll
                for (int e = 0; e < 4; ++e) { y[2 * e] = bflo(y0[q][e]) + bflo(y1[q][e]); y[2 * e + 1] = bfhi(y0[q][e]) + bfhi(y1[q][e]); zz[2 * e] = bflo(zg[q][e]); zz[2 * e + 1] = bfhi(zg[q][e]); }
                if (k < 2) {
#pragma unroll
                    for (int e = 0; e < 4; ++e) { y[2 * e] = (y[2 * e] + bflo(xs[q][e]) * dsk) * silu_f(zz[2 * e]); y[2 * e + 1] = (y[2 * e + 1] + bfhi(xs[q][e]) * dsk) * silu_f(zz[2 * e + 1]); }
#pragma unroll
                    for (int e = 0; e < 8; ++e) { ss = fmaf(y[e], y[e], ss); wn[e] = wn0[e]; }
                    ss = wave_sum(ss) * (1.f / 512.f);
                } else {
#pragma unroll
                    for (int e = 0; e < 8; ++e) ss = fmaf(y[e], y[e], ss);
                    ss += __shfl_xor(ss, 1); ss += __shfl_xor(ss, 2); ss += __shfl_xor(ss, 4); ss += __shfl_xor(ss, 8); ss *= (1.f / 128.f);
#pragma unroll
                    for (int e = 0; e < 8; ++e) wn[e] = wn0[e] * silu_f(zz[e]);
                }
                const float rstd = 1.0f / sqrtf(ss + NEPS);
                *(u32x4*)(F_Y + (size_t)u * 2048 + c0) = (u32x4){pk2(y[0] * rstd * wn[0], y[1] * rstd * wn[1]), pk2(y[2] * rstd * wn[2], y[3] * rstd * wn[3]), pk2(y[4] * rstd * wn[4], y[5] * rstd * wn[5]), pk2(y[6] * rstd * wn[6], y[7] * rstd * wn[7])};
            } }
    }
}
__device__ __forceinline__ void phase_qknorm_rope(Frame& F) {
    const int gw = F.bid * 8 + F.wave, NGW = F.G * 8, lane = F.lane, hl = lane & 15;
    const bool second = hl >= 8, jhi = (hl & 7) >= 4;
    float invf[8], wq[8], wk[8];
    { const f32x4 a0 = *(const f32x4*)(F.in[I_QNORM] + hl * 8), a1 = *(const f32x4*)(F.in[I_QNORM] + hl * 8 + 4), b0 = *(const f32x4*)(F.in[I_KNORM] + hl * 8), b1 = *(const f32x4*)(F.in[I_KNORM] + hl * 8 + 4);
#pragma unroll
      for (int e = 0; e < 4; ++e) { wq[e] = a0[e]; wq[4 + e] = a1[e]; wk[e] = b0[e]; wk[4 + e] = b1[e]; }
#pragma unroll
      for (int e = 0; e < 8; ++e) invf[e] = exp2f(-(float)((hl & 3) * 8 + e) * (13.287712379549449f / 32.f)); }
    for (int r0 = gw; r0 < TT; r0 += 3 * NGW) {
        u32x4 v[3][3];
#pragma unroll
        for (int q = 0; q < 3; ++q) { const int r = r0 + q * NGW; const bool ok = r < TT; const int u = ok ? r % TB : 0; const bool isctx = u < CTXL; const bf16_t* p = F_QKV + (size_t)(ok ? r : 0) * 2048 + lane * 8;
            v[q][2] = ok ? *(const u32x4*)(p + 1024) : (u32x4){0u, 0u, 0u, 0u};
            if (ok && !isctx) { v[q][0] = *(const u32x4*)p; v[q][1] = *(const u32x4*)(p + 512); } else { v[q][0] = (u32x4){0u, 0u, 0u, 0u}; v[q][1] = v[q][0]; } }
#pragma unroll
        for (int q = 0; q < 3; ++q) { const int r = r0 + q * NGW;
            if (r < TT) { const int u = r % TB; const bool isctx = u < CTXL; bf16_t* p = F_QKV + (size_t)r * 2048 + lane * 8;
                float cs[8], sn[8];
                if (!isctx) { const int t = u - CTXL; const float pos = (float)(jhi ? (t & 63) : (t >> 6));
#pragma unroll
                    for (int e = 0; e < 8; ++e) { const float rev = pos * invf[e] * 0.15915494309189535f; const float fr = rev - rintf(rev); cs[e] = __builtin_amdgcn_cosf(fr); sn[e] = __builtin_amdgcn_sinf(fr); } }
                else {
#pragma unroll
                    for (int e = 0; e < 8; ++e) { cs[e] = 1.f; sn[e] = 0.f; } }
#pragma unroll
                for (int part = 0; part < 3; ++part) { if (part < 2 && isctx) continue;
                    float x[8]; float ss = 0.f;
#pragma unroll
                    for (int e = 0; e < 4; ++e) { x[2 * e] = bflo(v[q][part][e]); x[2 * e + 1] = bfhi(v[q][part][e]); }
#pragma unroll
                    for (int e = 0; e < 8; ++e) ss = fmaf(x[e], x[e], ss);
                    ss += __shfl_xor(ss, 1); ss += __shfl_xor(ss, 2); ss += __shfl_xor(ss, 4); ss += __shfl_xor(ss, 8);
                    const float rstd = 1.0f / sqrtf(ss * (1.f / 128.f) + NEPS);
#pragma unroll
                    for (int e = 0; e < 8; ++e) x[e] = x[e] * rstd * (part < 2 ? wq[e] : wk[e]);
                    if (!isctx) {
#pragma unroll
                        for (int e = 0; e < 8; ++e) { const float pr = __shfl_xor(x[e], 8); x[e] = second ? x[e] * cs[e] + pr * sn[e] : x[e] * cs[e] - pr * sn[e]; } }
                    *(u32x4*)(p + part * 512) = (u32x4){pk2(x[0], x[1]), pk2(x[2], x[3]), pk2(x[4], x[5]), pk2(x[6], x[7])};
                } } }
    }
}
__device__ __forceinline__ void phase_attention(Frame& F) {
    const int grp = F.bid & 7, b = grp >> 2, kh = grp & 3;
    for (int idx = F.bid >> 3; idx < 64; idx += (F.G >> 3)) {
        const int hq = kh * 2 + (idx >> 5), qb = idx & 31;
        const bf16_t* Qb = F_QKV + (size_t)(b * TB + CTXL + qb * 256) * 2048 + hq * 128;
        const bf16_t* Kh = F_QKV + (size_t)(b * TB) * 2048 + 1024 + kh * 128;
        const bf16_t* Vh = F_QKV + (size_t)(b * TB) * 2048 + 1536 + kh * 128;
        bf16_t* Ob = F_AO + (size_t)(b * TB + CTXL + qb * 256) * DM + hq * 128;
        att::attn_dense_body(Qb, Kh, Vh, Ob, TB, (char*)F.ldsg, F.tid);
        __syncthreads();
    }
}

struct TailResid { const void* bp; h16* op; const float* gv; bf16_t* hn; float* rsp; const float* gn; const float* scn; bool fuse, in32; float coef;
    __device__ __forceinline__ void operator()(int b, int u, int col, f32x4 v) const { const long o = (long)(b * CTXL + u) * DM + col;
        f32x4 xb; if (in32) xb = *(const f32x4*)((const float*)bp + o); else { const u32x2 w = *(const u32x2*)((const h16*)bp + o); const f32x2_t c0 = unh2(w[0]), c1 = unh2(w[1]); xb = (f32x4){c0[0], c0[1], c1[0], c1[1]}; }
        const f32x4 x = xb + (*(const f32x4*)(gv + col) * coef) * v; *(u32x2*)(op + o) = (u32x2){pkh2(x[0], x[1]), pkh2(x[2], x[3])};
        if (fuse) { const size_t grow = (size_t)b * TB + u; const f32x4 y = x * (*(const f32x4*)(gn + col) * (1.f + *(const f32x4*)(scn + col)));
            *(u32x2*)(hn + grow * DM + col) = (u32x2){pk2(y[0], y[1]), pk2(y[2], y[3])};
            float ss = (x[0] * x[0] + x[1] * x[1]) + (x[2] * x[2] + x[3] * x[3]); ss += __shfl_xor(ss, 1); ss += __shfl_xor(ss, 2); ss += __shfl_xor(ss, 4); ss += __shfl_xor(ss, 8);
            if (((col >> 2) & 15) == 0) rsp[grow * 16 + (col >> 6)] = ss; } } };
struct TailBf16 { bf16_t* O; int ldo, col0; const float* rsp; const float* bias;
    __device__ __forceinline__ void operator()(int b, int u, int col, f32x4 v) const { const float* p = rsp + ((size_t)b * TB + u) * 16; const f32x4 p0 = *(const f32x4*)p, p1 = *(const f32x4*)(p + 4), p2 = *(const f32x4*)(p + 8), p3 = *(const f32x4*)(p + 12);
        const float sq = (((p0[0] + p0[1]) + (p0[2] + p0[3])) + ((p1[0] + p1[1]) + (p1[2] + p1[3]))) + (((p2[0] + p2[1]) + (p2[2] + p2[3])) + ((p3[0] + p3[1]) + (p3[2] + p3[3])));
        const float r = 1.0f / sqrtf(sq * (1.f / DM) + NEPS); v = v * r + *(const f32x4*)(bias + col);
        *(u32x2*)(O + (size_t)(b * TB + u) * ldo + col0 + col) = (u32x2){pk2(v[0], v[1]), pk2(v[2], v[3])}; } };
__device__ __forceinline__ void bias_rows(Frame& F, int l, int first_wave, int nwaves) {
    const int lane = F.lane;
    for (int kk = 1; kk <= 2; ++kk) {
        const bf16_t* Wt = (const bf16_t*)(F.ws + WS_W + (kk == 1 ? W_MIXIN : W_FFIN1)); const int nrows = kk == 1 ? (l == 0 ? 6912 : 2048) : 2 * DFF;
        float sh[3][16];
#pragma unroll
        for (int s_ = 0; s_ < 3; ++s_)
#pragma unroll
            for (int j = 0; j < 4; ++j) { const f32x4 t = *(const f32x4*)(F_MT + ((l * 3 + s_) * 9 + kk * 3) * DM + lane * 16 + 4 * j);
#pragma unroll
                for (int e = 0; e < 4; ++e) sh[s_][4 * j + e] = t[e]; }
        for (int r0 = first_wave; r0 < nrows; r0 += 6 * nwaves) {
            u32x4 w0[6], w1[6];
#pragma unroll
            for (int q = 0; q < 6; ++q) { const int r = r0 + q * nwaves; if (r < nrows) { w0[q] = *(const u32x4*)(Wt + (size_t)r * DM + lane * 16); w1[q] = *(const u32x4*)(Wt + (size_t)r * DM + lane * 16 + 8); } else { w0[q] = (u32x4){0u, 0u, 0u, 0u}; w1[q] = w0[q]; } }
#pragma unroll
            for (int q = 0; q < 6; ++q) { const int r = r0 + q * nwaves; float a[3] = {0.f, 0.f, 0.f};
#pragma unroll
                for (int e = 0; e < 4; ++e)
#pragma unroll
                    for (int s_ = 0; s_ < 3; ++s_) { a[s_] = fmaf(bflo(w0[q][e]), sh[s_][2 * e], a[s_]); a[s_] = fmaf(bfhi(w0[q][e]), sh[s_][2 * e + 1], a[s_]); a[s_] = fmaf(bflo(w1[q][e]), sh[s_][8 + 2 * e], a[s_]); a[s_] = fmaf(bfhi(w1[q][e]), sh[s_][8 + 2 * e + 1], a[s_]); }
#pragma unroll
                for (int s_ = 0; s_ < 3; ++s_) { const float t = wave_sum(a[s_]); if (lane == 0 && r < nrows) F_BIAS[((size_t)(kk - 1) * 3 + s_) * pg8::NB_STRIDE + r] = t; } }
        }
    }
}

template <class Epi>
__device__ __forceinline__ void ctx_gemm(Frame& F, const bf16_t* A, const bf16_t* W, int K, const Epi& E) {
    const int tid = F.tid, lane = tid & 63, w = F.wave, t = lane & 31, kh = lane >> 5, nkt = K >> 6;
    LAS float* red = (LAS float*)F.lds;
    LAS unsigned char* st = F.lds + w * 13824;
    const int lr = lane >> 3, lc = (lane & 7) * 8;
    for (int item = F.bid; item < 256; item += F.G) {
        const int x_ = item & 7, j_ = item >> 3, rb = j_ >> 1, cb = 2 * x_ + (j_ & 1), b = rb >> 3, u0 = (rb & 7) * 32;
        const bf16_t* ap = A + (size_t)(b * TB + u0 + lr) * K + lc;
        const bf16_t* wp = W + (size_t)(cb * 64 + lr) * K + lc; const size_t r8 = (size_t)8 * K;
        f32x16 acc0, acc1;
#pragma unroll
        for (int i = 0; i < 16; ++i) { acc0[i] = 0.f; acc1[i] = 0.f; }
        u32x4 r[12];
        int kt = w;
        if (kt < nkt) {
#pragma unroll
            for (int i = 0; i < 4; ++i) r[i] = *(const u32x4*)(ap + i * r8 + kt * 64);
#pragma unroll
            for (int i = 0; i < 8; ++i) r[4 + i] = *(const u32x4*)(wp + i * r8 + kt * 64);
        }
#pragma unroll 1
        for (; kt < nkt; kt += 8) {
#pragma unroll
            for (int i = 0; i < 12; ++i) *(LAS u32x4*)(st + (i * 8 + lr) * 144 + lc * 2) = r[i];
            const int kn = kt + 8 < nkt ? kt + 8 : kt;
#pragma unroll
            for (int i = 0; i < 4; ++i) r[i] = *(const u32x4*)(ap + i * r8 + kn * 64);
#pragma unroll
            for (int i = 0; i < 8; ++i) r[4 + i] = *(const u32x4*)(wp + i * r8 + kn * 64);
#pragma unroll
            for (int j = 0; j < 4; ++j) {
                const bf16x8 a = *(const LAS bf16x8*)(st + t * 144 + kh * 64 + j * 16), w0 = *(const LAS bf16x8*)(st + (32 + t) * 144 + kh * 64 + j * 16), w1 = *(const LAS bf16x8*)(st + (64 + t) * 144 + kh * 64 + j * 16);
                acc0 = __builtin_amdgcn_mfma_f32_32x32x16_bf16(w0, a, acc0, 0, 0, 0); acc1 = __builtin_amdgcn_mfma_f32_32x32x16_bf16(w1, a, acc1, 0, 0, 0); }
        }
        __syncthreads();
#pragma unroll
        for (int q = 0; q < 4; ++q) {
            *(LAS f32x4*)(red + (w * 32 + t) * 68 + 8 * q + 4 * kh) = (f32x4){acc0[4 * q], acc0[4 * q + 1], acc0[4 * q + 2], acc0[4 * q + 3]};
            *(LAS f32x4*)(red + (w * 32 + t) * 68 + 32 + 8 * q + 4 * kh) = (f32x4){acc1[4 * q], acc1[4 * q + 1], acc1[4 * q + 2], acc1[4 * q + 3]}; }
        __syncthreads();
        { const int tt = tid >> 4, n4 = (tid & 15) * 4; f32x4 sum = *(const LAS f32x4*)(red + tt * 68 + n4);
#pragma unroll
            for (int ww = 1; ww < 8; ++ww) sum += *(const LAS f32x4*)(red + (ww * 32 + tt) * 68 + n4);
            E(b, u0 + tt, cb * 64 + n4, sum); }
        __syncthreads();
    }
}

constexpr int LDS_BYTES = 147456;
constexpr int MISC_OFF = 147456 - 512;

__global__ void __launch_bounds__(NTHREADS, 2) mk_fwd(Args args) {
    extern __shared__ __attribute__((aligned(16))) unsigned char lds_raw[];
    Frame F;
    F.in = (KIN)__builtin_amdgcn_kernarg_segment_ptr(); F.out = args.out; F.ws = args.ws; F.dxc = (float*)(args.ws + WS_XC) - args.out; F.dcin = args.in[I_CTX] - args.in[I_X];
    F.lds = (LAS unsigned char*)lds_raw; F.ldsg = lds_raw;
    F.tid = threadIdx.x; F.lane = F.tid & 63; F.wave = __builtin_amdgcn_readfirstlane(F.tid >> 6); F.G = gridDim.x; F.bid = blockIdx.x;
    volatile LAS unsigned* MISC = (volatile LAS unsigned*)(F.lds + MISC_OFF);
    if (F.tid < 64) MISC[F.tid] = 0u;
    __syncthreads();
    XcdBarrier bar = xcd_barrier_post((unsigned*)(args.ws + WS_CTL), MISC + 8, F.tid);
    const int wave_s = __builtin_amdgcn_readfirstlane(threadIdx.x >> 6);
    const int lo = args.ph_lo, hi = args.ph_hi; int ph = 0;
#define PH_BEGIN if (TIMING && blockIdx.x == 0 && wave_s == 0 && __lane_id() == 0 && ph < 60) ((unsigned long long*)(args.ws + WS_CTL + 32768))[ph] = __builtin_amdgcn_s_memrealtime(); \
    if (ph >= lo && ph < hi) { { int lid_; asm volatile("v_mbcnt_lo_u32_b32 %0, -1, 0\n\tv_mbcnt_hi_u32_b32 %0, -1, %0" : "=v"(lid_)); F.tid = wave_s * 64 + lid_; } F.lane = F.tid & 63; F.wave = __builtin_amdgcn_readfirstlane(F.tid >> 6); \
        LAUNDER_PTR(unsigned char*, 1, F.ws, args.ws); LAUNDER_PTR(float*, 1, F.out, args.out); LAUNDER_PTR(KIN, 4, F.in, __builtin_amdgcn_kernarg_segment_ptr()); F.bid = blockIdx.x; F.G = gridDim.x; asm volatile("" : "+s"(F.bid), "+s"(F.G));
#define PH_END   if (ph + 1 < hi) xcd_barrier(bar, wave_s); } ++ph;

    PH_BEGIN { phase_modtab(F); } PH_END
    unsigned char* wb = F.ws + WS_W;
#define GEMM(EPI, A_, B_, K_, nM_, nN_, pm0_, mode_, NI_) do { pg8::Gemm g_{(const bf16_t*)(A_), (const bf16_t*)(B_), (K_)}; pg8::Order S_; S_.init((nM_), (nN_), F.G, F.bid, (pm0_), (mode_), (K_) / 64); pg8::gemm_phase(F.lds, g_, S_, EPI, F.tid, NI_); } while (0)
#define NI_PLAIN (pg8::NormIn{nullptr, nullptr})
#define NI_FUSED(kk_) (pg8::NormIn{F_RSP, F_BIAS + (size_t)((kk_) - 1) * 3 * pg8::NB_STRIDE})
    for (int l = 0; l < 2; ++l) {
      for (int k = 0; k < 3; ++k) {
        const bool lat_only = (l == 1 && k == 2);
        if (k == 0) {
            PH_BEGIN { if (l == 0) { phase_modtab_reduce(F); LAS float* tab = (LAS float*)(F.lds + 69632);
                           for (int i = F.tid; i < 6 * DM; i += NTHREADS) { const int s_ = i / (2 * DM), r_ = i - s_ * 2 * DM; tab[i] = modtab_sum(F, 0, s_, r_); } }
                       phase_convert(F, l); __syncthreads(); phase_norm(F, l, 0, l == 0, false, l == 0); } PH_END
        }
        const int nrep = (k == 1 && l == 0) ? 2 : 1;
        for (int rep = 0; rep < nrep; ++rep) {
            if (k != 1) {
                for (int rp_ = 0; rp_ < REP_SWIGLU; ++rp_) { PH_BEGIN { pg8::EpiSwigluP E{F_HID}; if (k == 0) GEMM(E, F_HN, wb + W_FFIN0, DM, 66, 22, 0, 0, NI_PLAIN); else GEMM(E, F_HN, wb + W_FFIN1, DM, lat_only ? 64 : 66, 22, 0, lat_only ? 1 : 0, NI_FUSED(2));
                    if (k == 0 && F.bid >= 172) bias_rows(F, l, (F.bid - 172) * 8 + F.wave, (F.G - 172) * 8); } PH_END }
            } else if (l == 0) {
                const int b = rep;
                PH_BEGIN { pg8::EpiABP E{F_ZG, F_RAW, F_ABS, b * TB}; GEMM(E, F_HN, wb + W_MIXIN, DM, 33, 27, b * 33, 0, NI_FUSED(1)); } PH_END
                PH_BEGIN phase_conv(F, b); PH_END
                PH_BEGIN { for (int it_ = F.G - 1 - F.bid; it_ < 132; it_ += F.G) ssd_prep_item(F, it_ / 66, it_ % 66);
                           if (F.G >= 256) { if (F.bid < 256) gdn_prep_round(F, F.bid * 4, 4); __syncthreads(); if (F.bid < 16) gdn_prep_round(F, 1024 + F.bid * 2, 2); }
                           else for (int rd_ = F.bid; rd_ < 264; rd_ += F.G) gdn_prep_round(F, rd_ * 4, 4);
                         } PH_END
                PH_BEGIN { const int x_ = F.bid & 7, j_ = F.bid >> 3;
                    if (F.G == 256 && F.bid < 160) { const int chain = x_ + 8 * (j_ / 10), r = j_ % 10, h_ = chain >> 1, d_ = chain & 1;
                        if (r < 2) gdn_scan(F, h_, d_, r, 0, 33, nullptr, F_GBT + ((size_t)chain * 3 + 0) * 16384 + (size_t)r * 8192, nullptr, true, F_YD, 2048, 1024);
                        else { const int g = 1 + (r - 2) / 4, cb = (r - 2) & 3;
                            gdn_scan(F, h_, d_, cb, 33 * g, 33 * g + 33, nullptr, cb < 2 ? F_GBT + ((size_t)chain * 3 + g) * 16384 + (size_t)cb * 8192 : nullptr, cb >= 2 ? F_GPH + ((size_t)chain * 2 + (g - 1)) * 16384 : nullptr, false, F_YD, 2048, 1024); } }
                    else if (F.G == 256) ssd_items<0>(F, F.bid - 160, 96, nullptr, 0, 0); } PH_END
                PH_BEGIN { if (F.bid < 16) gdn_combine(F, F.bid); else if (F.bid < 48) ssd_state_scan(F, F.bid - 16); } PH_END
                PH_BEGIN { const int x_ = F.bid & 7, j_ = F.bid >> 3;
                    if (F.G == 256 && F.bid < 96) { const int chain = x_ + 8 * (j_ / 6), r = j_ % 6, g = 1 + (r >> 1), eb_ = r & 1;
                        gdn_scan(F, chain >> 1, chain & 1, eb_, 33 * g, 33 * g + 33, F_GSS + ((size_t)chain * 3 + (g - 1)) * 16384 + (size_t)eb_ * 8192, nullptr, nullptr, true, F_YD, 2048, 1024); }
                    else if (F.G == 256) ssd_items<1>(F, F.bid - 96, 160, F_YD, 2048, 0); } PH_END
                PH_BEGIN phase_finish(F, b); PH_END
            } else {
                PH_BEGIN { pg8::EpiBf16P E{F_QKV, 2048}; GEMM(E, F_HN, wb + W_MIXIN, DM, 64, 8, 0, 1, NI_FUSED(1));
                           TailBf16 T{F_QKV, 2048, 1024, F_RSP, F_BIAS + (size_t)2 * pg8::NB_STRIDE + 1024}; ctx_gemm(F, F_HN, (const bf16_t*)(wb + W_MIXIN) + (size_t)1024 * DM, DM, T); } PH_END
                PH_BEGIN phase_qknorm_rope(F); PH_END
                for (int rp_ = 0; rp_ < REP_ATT; ++rp_) { PH_BEGIN phase_attention(F); PH_END }
            }
            PH_BEGIN {
                const bool first = (l == 0 && k == 0);
                const bool fuse = k < 2;
                const bool last = (l == 1 && k == 2), tofin = (l == 1 && k == 1);
                const long dfin = (long)(F_X16F - F_X16L);
                pg8::EpiResidP E{first ? (const void*)F.in[I_X] : (const void*)(F_X16L + (last ? dfin : 0)), first ? F.dcin : F_DXC16, last ? (void*)F.out : (void*)(F_X16L + (tofin ? dfin : 0)), F_DXC16, F_MT + l * 3 * 9216, 3 * k + 2, F.in[I_NORMG] + (l * 3 + k + 1) * DM, k + 1, fuse, first, last, F.ws, k == 1 ? 1.0f : 0.5f};
                const bf16_t* A_ = k != 1 ? F_HID : (l == 0 ? F_Y - (size_t)rep * TB * 2048 : F_AO);
                const size_t wo_ = k == 0 ? W_FFOUT0 : (k == 2 ? W_FFOUT1 : W_MIXOUT); const int K_ = k != 1 ? DFF : (l == 0 ? 2048 : DM);
                const bool lat = lat_only || (l == 1 && k == 1); const bool ctail = (k != 1 && !lat);
                const int nM_ = (k == 1 && l == 0) ? 33 : 64;
                GEMM(E, A_, wb + wo_, K_, nM_, 4, (k == 1 && l == 0) ? rep * 33 : 0, (k == 1 && l == 0) ? 0 : 1, NI_PLAIN);
                { int lid_; asm volatile("v_mbcnt_lo_u32_b32 %0, -1, 0\n\tv_mbcnt_hi_u32_b32 %0, -1, %0" : "=v"(lid_)); F.tid = wave_s * 64 + lid_; F.lane = lid_; }
                if (ctail) { TailResid T{first ? (const void*)(F.in[I_X] + F.dcin) : (const void*)F_X16C, F_X16C, F_MT + l * 3 * 9216 + (2 * 9 + 3 * k + 2) * DM, F_HN, F_RSP, F.in[I_NORMG] + (l * 3 + k + 1) * DM, F_MT + l * 3 * 9216 + (2 * 9 + (k + 1) * 3 + 1) * DM, fuse, first, 0.5f}; ctx_gemm(F, A_, (const bf16_t*)(wb + wo_), K_, T); }
            } PH_END
        }
      }
    }
#undef GEMM
#undef PH_BEGIN
#undef PH_END
}

extern "C" void kernel_launch(void* const* d_in, const int* in_sizes, int n_in, void* d_out, int out_size, void* d_ws, size_t ws_size, hipStream_t stream) {
    static int grid = 0;
    if (grid == 0) {
        if (n_in != 25 || out_size != NBATCH * SEQ * DM || ws_size < WS_END) { fprintf(stderr, "kernel_launch: unexpected shapes (n_in %d out %d ws %zu need %zu)\n", n_in, out_size, ws_size, (size_t)WS_END); grid = -1; return; }
        int dev = 0, cus = 0, per_cu = 0;
        if (hipGetDevice(&dev) != hipSuccess || hipDeviceGetAttribute(&cus, hipDeviceAttributeMultiprocessorCount, dev) != hipSuccess) { grid = -1; return; }
        if (hipFuncSetAttribute((const void*)mk_fwd, hipFuncAttributeMaxDynamicSharedMemorySize, LDS_BYTES) != hipSuccess) { fprintf(stderr, "kernel_launch: hipFuncSetAttribute failed\n"); grid = -1; return; }
        if (hipOccupancyMaxActiveBlocksPerMultiprocessor(&per_cu, (const void*)mk_fwd, NTHREADS, LDS_BYTES) != hipSuccess || per_cu < 1) { fprintf(stderr, "kernel_launch: occupancy query says %d blocks per CU\n", per_cu); grid = -1; (void)hipGetLastError(); return; }
        grid = cus;
    }
    if (grid < 0) return;
    (void)hipMemsetAsync((char*)d_ws + WS_CTL, 0, CTL_BYTES, stream);
    Args a{};
    for (int i = 0; i < 25; ++i) a.in[i] = (const float*)d_in[i];
    a.out = (float*)d_out; a.ws = (unsigned char*)d_ws; a.ph_lo = 0; a.ph_hi = 1000;
    hipLaunchKernelGGL(mk_fwd, dim3(grid), dim3(NTHREADS), LDS_BYTES, stream, a);
    const hipError_t le = hipPeekAtLastError();
    if (le != hipSuccess) fprintf(stderr, "kernel_launch: launch failed: %s\n", hipGetErrorName(le));
}
```

```cpp
#include <hip/hip_runtime.h>
#include <cstdio>
#include <cstdint>

#define LAS __attribute__((address_space(3)))
typedef unsigned short bf16_t;
typedef short bf16x8 __attribute__((ext_vector_type(8)));
typedef short s16x4 __attribute__((ext_vector_type(4)));
typedef float f32x4 __attribute__((ext_vector_type(4)));
typedef float f32x8 __attribute__((ext_vector_type(8)));
typedef float f32x16 __attribute__((ext_vector_type(16)));
typedef unsigned u32x4 __attribute__((ext_vector_type(4)));
typedef unsigned u32x2 __attribute__((ext_vector_type(2)));

#define DEBUG_SSD 0
#define REP_ATT 1
#define REP_SWIGLU 1
#define REP_NORM 1
#define EXTRA_SSD 0
#define EXTRA_GDN 0
#define TIMING 0
#define TA0 28
#define TA1 29
#define TB0 0
#define TB1 0
#define DEBUG_GDN 0
#if DEBUG_SSD || DEBUG_GDN
#define NO_ATT 1
#endif
constexpr int DM = 1024, NBATCH = 2, SEQ = 8192, CTXL = 256, TB = SEQ + CTXL  , TT = NBATCH * TB, DFF = 2816;
constexpr int NTHREADS = 512;
constexpr float NEPS = 1e-6f;

constexpr size_t AL(size_t x) { return (x + 255) / 256 * 256; }
constexpr size_t WS_CTL = 0;
constexpr size_t CTL_BYTES = 65536;
constexpr size_t WS_MT = WS_CTL + CTL_BYTES;
constexpr size_t WS_MTP = WS_MT + AL((size_t)2 * 3 * 9216 * 4);
constexpr size_t WS_XC = WS_MTP + AL((size_t)2 * 16 * 3 * 9216 * 4);
constexpr size_t WS_RSP = WS_XC + AL((size_t)2 * CTXL * DM * 4);
constexpr size_t WS_BIAS = WS_RSP + AL((size_t)TT * 16 * 4);
constexpr size_t WS_HN = WS_BIAS + AL((size_t)2 * 3 * 6912 * 4);
constexpr size_t WS_W  = WS_HN + AL((size_t)TT * DM * 2);
constexpr size_t W_FFIN0 = 0, W_FFOUT0 = W_FFIN0 + (size_t)2 * DFF * DM * 2, W_FFIN1 = W_FFOUT0 + (size_t)DM * DFF * 2, W_FFOUT1 = W_FFIN1 + (size_t)2 * DFF * DM * 2,
                 W_MIXIN = W_FFOUT1 + (size_t)DM * DFF * 2, W_MIXOUT = W_MIXIN + (size_t)6912 * DM * 2, W_BYTES = W_MIXOUT + (size_t)DM * 2048 * 2;
constexpr size_t WS_AR = WS_W + AL(W_BYTES);
constexpr size_t AR_HID = WS_AR;
constexpr size_t AR_ZG  = WS_AR;
constexpr size_t AR_RAW = AR_ZG + AL((size_t)TB * 2048 * 2);
constexpr size_t AR_YD  = AR_RAW;
constexpr size_t AR_Y   = AR_YD;
constexpr size_t AR_GSEG = AR_YD + (size_t)2 * TB * 2048 * 2;
static_assert((size_t)16 * 3 * 65536 * 2 + (size_t)16 * 2 * 32768 <= (size_t)TB * 4608 * 2 - (size_t)2 * TB * 2048 * 2, "segment buffers must fit behind Yd");
constexpr size_t AR_ABS = AR_RAW + AL((size_t)TB * 4608 * 2);
constexpr size_t AR_CV  = AR_ABS + AL((size_t)TB * 64 * 4);
constexpr size_t AR_CB  = AR_CV + AL((size_t)TB * 4608 * 2);
constexpr size_t AR_GT  = AR_CB + AL((size_t)2 * 66 * 128 * 128 * 2);
constexpr size_t GT_STRIDE = 8192 + 8192 + 768;
constexpr size_t AR_SST = AR_GT + AL((size_t)8 * 2 * 132 * GT_STRIDE);
constexpr size_t AR_SEL = AR_SST + AL((size_t)32 * 66 * 8192 * 2);
constexpr size_t AR_END0 = AR_SEL + AL((size_t)32 * 66 * 4);
constexpr size_t WS_DBG = 0;
constexpr size_t AR_QKV = WS_AR;
constexpr size_t AR_AO  = AR_QKV + AL((size_t)TT * 2048 * 2);
constexpr size_t AR_X16F = AR_AO + AL((size_t)TT * DM * 2);
constexpr size_t AR_END1 = AR_X16F + AL((size_t)NBATCH * SEQ * DM * 2);
constexpr size_t WS_END0 = AR_END0 > AR_END1 ? AR_END0 : AR_END1;
constexpr size_t WS_TEST = WS_END0;
constexpr size_t WS_END = WS_END0 + (DEBUG_GDN ? AL((size_t)2 * TB * 1024 * 2) : 0);

typedef float f32x2_t __attribute__((ext_vector_type(2)));
typedef __bf16 bf16x2_t __attribute__((ext_vector_type(2)));
__device__ __forceinline__ unsigned pk2(float lo, float hi) { f32x2_t v = {lo, hi}; bf16x2_t b = __builtin_convertvector(v, bf16x2_t); return *reinterpret_cast<unsigned*>(&b); }
__device__ __forceinline__ bf16_t f2bf(float f) { return (bf16_t)(pk2(f, 0.f) & 0xffffu); }
__device__ __forceinline__ float bf2f(bf16_t b) { return __uint_as_float(((unsigned)b) << 16); }
typedef _Float16 h16;
typedef _Float16 h16x2_t __attribute__((ext_vector_type(2)));
__device__ __forceinline__ unsigned pkh2(float lo, float hi) { f32x2_t v = {lo, hi}; h16x2_t h = __builtin_convertvector(v, h16x2_t); return __builtin_bit_cast(unsigned, h); }
__device__ __forceinline__ f32x2_t unh2(unsigned w) { return __builtin_convertvector(__builtin_bit_cast(h16x2_t, w), f32x2_t); }
__device__ __forceinline__ float bflo(unsigned w) { return __uint_as_float(w << 16); }
__device__ __forceinline__ float bfhi(unsigned w) { return __uint_as_float(w & 0xffff0000u); }
__device__ __forceinline__ float silu_f(float x) { return x * __builtin_amdgcn_rcpf(1.f + __expf(-x)); }
__device__ __forceinline__ float softplus_f(float x) { return fmaxf(x, 0.f) + __logf(1.f + __expf(-fabsf(x))); }
__device__ __forceinline__ float sigmoid_f(float x) { return __builtin_amdgcn_rcpf(1.f + __expf(-x)); }
#define LAUNDER_PTR(T, AS_, dst, src) do { unsigned long long v_ = (unsigned long long)(src); unsigned lo_ = (unsigned)v_, hi_ = (unsigned)(v_ >> 32), lo2_, hi2_; \
        asm volatile("s_mov_b32 %0, %2\n\ts_mov_b32 %1, %3" : "=s"(lo2_), "=s"(hi2_) : "s"(lo_), "s"(hi_)); dst = (T)(__attribute__((address_space(AS_))) char*)(((unsigned long long)hi2_ << 32) | lo2_); } while (0)
__device__ __forceinline__ float wave_sum(float v) {
#pragma unroll
    for (int o = 1; o < 64; o <<= 1) v += __shfl_xor(v, o);
    return v;
}

#define XB_TMO      128
#define XB_XCNT(j)  (256  + 64 * (j))
#define XB_XSUB(j)  (1280 + 64 * (j))
#define XB_XGEN(j)  (2304 + 64 * (j))
#define XB_TOP      3328
#define XB_TOPGEN   3392
#define XCD_BAR_WORDS 3456
#define XB_SPIN_CAP (1u << 24)
__device__ __forceinline__ unsigned xb_ld(unsigned* p)              { return __hip_atomic_load(p, __ATOMIC_RELAXED, __HIP_MEMORY_SCOPE_AGENT); }
__device__ __forceinline__ unsigned xb_add(unsigned* p, unsigned v) { return __hip_atomic_fetch_add(p, v, __ATOMIC_RELAXED, __HIP_MEMORY_SCOPE_AGENT); }
__device__ __forceinline__ unsigned xb_xcc_id() { return (unsigned)__builtin_amdgcn_s_getreg((3 << 11) | 20) & 0xFu; }
#define XB_SPIN(cond, bar) do { unsigned _sp = 0; while (cond) { __builtin_amdgcn_s_sleep(16); \
    if ((++_sp & 255u) == 0u) { if (xb_ld(&(bar)[XB_TMO])) break; if (_sp > XB_SPIN_CAP) { atomicAdd(&(bar)[XB_TMO], 1u); break; } } } } while (0)
struct XcdBarrier { unsigned* bar; unsigned x; volatile LAS unsigned* st; };
__device__ __forceinline__ XcdBarrier xcd_barrier_post(unsigned* bar, volatile LAS unsigned* st, int tid) {
    XcdBarrier b; b.bar = bar; b.x = xb_xcc_id(); b.st = st;
    if (tid == 0) (void)xb_add(&bar[XB_XCNT(b.x)], 1u);
    return b;
}
__device__ __forceinline__ void xcd_barrier_complete(unsigned* bar, unsigned x, unsigned& nloc, unsigned& nx) {
    const unsigned G = gridDim.x * gridDim.y * gridDim.z;
    unsigned sum, cnt, mine, sp = 0u;
    for (;;) {
        sum = 0u; cnt = 0u; mine = 0u;
#pragma unroll
        for (unsigned j = 0; j < 16; ++j) { const unsigned c = xb_ld(&bar[XB_XCNT(j)]); sum += c; cnt += (c > 0u) ? 1u : 0u; mine = (j == x) ? c : mine; }
        if (sum == G) break;
        __builtin_amdgcn_s_sleep(1);
        if ((++sp & 255u) == 0u) { if (xb_ld(&bar[XB_TMO])) break; if (sp > XB_SPIN_CAP) { atomicAdd(&bar[XB_TMO], 1u); break; } }
    }
    nloc = mine > 0u ? mine : 1u; nx = cnt > 0u ? cnt : 1u;
}
__device__ __forceinline__ void xcd_barrier(const XcdBarrier& b, int wave_s) {
    asm volatile("s_waitcnt vmcnt(0)" ::: "memory");
    __syncthreads();
    int lid_; asm volatile("v_mbcnt_lo_u32_b32 %0, -1, 0\n\tv_mbcnt_hi_u32_b32 %0, -1, %0" : "=v"(lid_));
    if (wave_s == 0 && lid_ == 0) {
        unsigned* bar = b.bar;
        __builtin_amdgcn_s_waitcnt(0);
        unsigned nloc = b.st[0], nx = b.st[1];
        if (nloc == 0u) { xcd_barrier_complete(bar, b.x, nloc, nx); b.st[0] = nloc; b.st[1] = nx; }
        const unsigned old = xb_add(&bar[XB_XSUB(b.x)], 1u);
        const unsigned gen = old / nloc;
        if (old + 1u == (gen + 1u) * nloc) {
            __builtin_amdgcn_fence(__ATOMIC_RELEASE, "agent");
            asm volatile("s_waitcnt vmcnt(0)" ::: "memory");
            const unsigned og = xb_add(&bar[XB_TOP], 1u);
            const unsigned tg = og / nx;
            if (og + 1u == (tg + 1u) * nx) xb_add(&bar[XB_TOPGEN], 1u);
            else XB_SPIN(xb_ld(&bar[XB_TOPGEN]) == tg, bar);
            __builtin_amdgcn_fence(__ATOMIC_ACQUIRE, "agent");
            xb_add(&bar[XB_XGEN(b.x)], 1u);
            asm volatile("s_waitcnt vmcnt(0)" ::: "memory");
        } else {
            XB_SPIN(xb_ld(&bar[XB_XGEN(b.x)]) == gen, bar);
            __builtin_amdgcn_fence(__ATOMIC_ACQUIRE, "agent");
            asm volatile("s_waitcnt vmcnt(0)" ::: "memory");
        }
    }
    __syncthreads();
}

struct Args { const float* in[25]; float* out; unsigned char* ws; int ph_lo, ph_hi; };
enum { I_X = 0, I_C, I_CTX, I_CCTX, I_WMOD, I_BMOD, I_NORMG, I_WFFIN, I_WFFOUT, I_ABWIN, I_SCONVW, I_SCONVB, I_SALOG, I_SDTB, I_SD, I_SNORM,
       I_GCONVW, I_GALOG, I_GDTB, I_GNORM, I_ABWOUT, I_WQKV, I_QNORM, I_KNORM, I_WO };

typedef const float* cfp_t;
typedef const __attribute__((address_space(4))) cfp_t* KIN;
struct Frame {
    KIN in; float* out; unsigned char* ws; long dxc, dcin;
    LAS unsigned char* lds; unsigned char* ldsg;
    int tid, lane, wave, G, bid;
};
#define F_MT   ((float*)(F.ws + WS_MT))
#define F_XC   ((float*)(F.ws + WS_XC))
#define F_X16L ((h16*)F.out)
#define F_X16C ((h16*)(F.ws + WS_XC))
#define F_X16F ((h16*)(F.ws + AR_X16F))
#define F_DXC16 ((long)(F_X16C - F_X16L))
#define F_RSP  ((float*)(F.ws + WS_RSP))
#define F_BIAS ((float*)(F.ws + WS_BIAS))
#define F_HN   ((bf16_t*)(F.ws + WS_HN))
#define F_HID  ((bf16_t*)(F.ws + AR_HID))
#define F_ZG   ((bf16_t*)(F.ws + AR_ZG))
#define F_RAW  ((bf16_t*)(F.ws + AR_RAW))
#define F_YD   ((bf16_t*)(F.ws + AR_YD))
#define F_CB   ((bf16_t*)(F.ws + AR_CB))
#define F_GT   ((bf16_t*)(F.ws + AR_GT))
#define F_SST  ((bf16_t*)(F.ws + AR_SST))
#define F_SEL  ((float*)(F.ws + AR_SEL))
#define F_GBT  ((float*)(F.ws + AR_GSEG))
#define F_GPH  ((bf16_t*)(F.ws + AR_GSEG + (size_t)16 * 3 * 65536))
#define F_GSS  ((float*)(F.ws + AR_GSEG + (size_t)16 * 3 * 65536 + (size_t)16 * 2 * 32768))
#define F_ABS  ((float*)(F.ws + AR_ABS))
#define F_CV   ((bf16_t*)(F.ws + AR_CV))
#define F_Y    ((bf16_t*)(F.ws + AR_Y))
#define F_QKV  ((bf16_t*)(F.ws + AR_QKV))
#define F_AO   ((bf16_t*)(F.ws + AR_AO))
__device__ __forceinline__ long xoff(int r, long dctx, bool& isctx) { const int b = r / TB, u = r - b * TB; isctx = u < CTXL; return isctx ? dctx + (long)(b * CTXL + u) * DM : (long)(b * SEQ + u - CTXL) * DM; }

template <bool DUAL, class Epi>
__device__ __forceinline__ void sgemm(Frame& F, const bf16_t* A, int lda, const float* W, int ldw, int dual_off, int row0, int nrows, int N, int K, bool skip_ctx, const Epi& epi) {
    LAS bf16_t* sA = (LAS bf16_t*)F.lds; LAS bf16_t* sB = sA + 128 * 40; LAS bf16_t* sB2 = sB + 64 * 40;
    const int tid = F.tid, lane = F.lane, wid = F.wave;
    const int ntn = N / 64, ntiles = (nrows / 128) * ntn;
    for (int t = F.bid; t < ntiles; t += F.G) {
        const int tm = t / ntn, tn = t - tm * ntn, m0 = row0 + tm * 128, n0 = tn * 64;
        if (skip_ctx && (m0 % TB) < CTXL) continue;
        f32x4 acc[4], acc2[4];
#pragma unroll
        for (int j = 0; j < 4; ++j) { acc[j] = (f32x4){0.f, 0.f, 0.f, 0.f}; acc2[j] = (f32x4){0.f, 0.f, 0.f, 0.f}; }
        for (int k0 = 0; k0 < K; k0 += 32) {
            { const int r = tid >> 2, kq = (tid & 3) * 8; const u32x4 v = *(const u32x4*)(A + (size_t)(m0 + r) * lda + k0 + kq); *(LAS u32x4*)(sA + r * 40 + kq) = v; }
            { const int k = tid >> 4, n4 = (tid & 15) * 4; const f32x4 w = *(const f32x4*)(W + (size_t)(k0 + k) * ldw + n0 + n4);
              sB[(n4 + 0) * 40 + k] = f2bf(w[0]); sB[(n4 + 1) * 40 + k] = f2bf(w[1]); sB[(n4 + 2) * 40 + k] = f2bf(w[2]); sB[(n4 + 3) * 40 + k] = f2bf(w[3]);
              if (DUAL) { const f32x4 w2 = *(const f32x4*)(W + (size_t)(k0 + k) * ldw + n0 + n4 + dual_off);
                  sB2[(n4 + 0) * 40 + k] = f2bf(w2[0]); sB2[(n4 + 1) * 40 + k] = f2bf(w2[1]); sB2[(n4 + 2) * 40 + k] = f2bf(w2[2]); sB2[(n4 + 3) * 40 + k] = f2bf(w2[3]); } }
            __syncthreads();
            const bf16x8 a = *(const LAS bf16x8*)(sA + (16 * wid + (lane & 15)) * 40 + 8 * (lane >> 4));
#pragma unroll
            for (int j = 0; j < 4; ++j) { const bf16x8 b = *(const LAS bf16x8*)(sB + (16 * j + (lane & 15)) * 40 + 8 * (lane >> 4));
                acc[j] = __builtin_amdgcn_mfma_f32_16x16x32_bf16(a, b, acc[j], 0, 0, 0);
                if (DUAL) { const bf16x8 b2 = *(const LAS bf16x8*)(sB2 + (16 * j + (lane & 15)) * 40 + 8 * (lane >> 4)); acc2[j] = __builtin_amdgcn_mfma_f32_16x16x32_bf16(a, b2, acc2[j], 0, 0, 0); } }
            __syncthreads();
        }
#pragma unroll
        for (int j = 0; j < 4; ++j)
#pragma unroll
            for (int r = 0; r < 4; ++r) epi(m0 + 16 * wid + 4 * (lane >> 4) + r, n0 + 16 * j + (lane & 15), acc[j][r], acc2[j][r]);
    }
}
struct EpiSwiglu { bf16_t* hid; __device__ __forceinline__ void operator()(int r, int c, float g, float u) const { hid[(size_t)r * DFF + c] = f2bf(silu_f(g) * u); } };
struct EpiResid {
    const float* base; long dbase; float* out; long dxc; const float* mt; int gidx; float coef;
    __device__ __forceinline__ void operator()(int r, int c, float v, float) const {
        bool isctx; const long ob = xoff(r, dbase, isctx) + c; const long oo = xoff(r, dxc, isctx) + c; const int s = isctx ? 2 : r / TB;
        out[oo] = base[ob] + coef * mt[(s * 9 + gidx) * DM + c] * v;
    }
};
struct EpiAB {
    bf16_t* abp; float* abs_; int row0;
    __device__ __forceinline__ void operator()(int r, int c, float v, float) const {
        const int u = r - row0;
        if (c < 2560) abp[(size_t)u * 6656 + c] = f2bf(v);
        else if (c < 2592) abs_[u * 64 + (c - 2560)] = v;
        else if (c < 6688) abp[(size_t)u * 6656 + (c - 32)] = f2bf(v);
        else abs_[u * 64 + 32 + (c - 6688)] = v;
    }
};
struct EpiBf16Store { bf16_t* o; int ldo; __device__ __forceinline__ void operator()(int r, int c, float v, float) const { o[(size_t)r * ldo + c] = f2bf(v); } };


namespace pg8 {
constexpr int BM = 256, BK = 64, HALF = 128, HTB = HALF * BK * 2, STAGE_BYTES = 8 * HTB, NXCD = 8, WGM = 8;
__host__ __device__ __forceinline__ int lds_byte(int r, int c) { const int st = (r >> 4) * 2 + (c >> 5), rr = r & 15, cc = c & 31, ob = rr * 64 + cc * 2; return st * 1024 + (ob ^ (((ob >> 9) & 1) << 5)); }
__host__ __device__ __forceinline__ void stage_rc(int b, int& R, int& C) { const int st = b / 1024, sb = b % 1024, swz = sb ^ (((sb >> 9) & 1) << 5); R = (st >> 1) * 16 + swz / 64; C = (st & 1) * 32 + (swz % 64) / 2; }
__host__ __device__ __forceinline__ int perm32(int rho) { const int n = rho >> 4, i = rho & 15; return 8 * (i >> 2) + 4 * n + (i & 3); }
struct Unit { int pm, pn, k0, nk; };
struct Gemm { const bf16_t* A; const bf16_t* Bt; int K; };
struct Order {
    int nM, nN, nwg, G, c, pm0, mode, nkfull;
    __device__ __forceinline__ void init(int nM_, int nN_, int G_, int c_, int pm0_, int mode_, int nkfull_) { nM = nM_; nN = nN_; nwg = nM * nN; G = G_; c = c_; pm0 = pm0_; mode = mode_; nkfull = nkfull_; }
    __device__ __forceinline__ bool next(int i, Unit& u) const {
        u.k0 = 0; u.nk = nkfull;
        if (mode == 2 && i >= 1) {
            if (i > 1 || c >= 88) return false;
            const int uc = c / 11; u.pm = (uc >> 2) * 33; u.pn = uc & 3; u.k0 = (c - uc * 11) * 4; u.nk = 4; return true; }
        const long L = (long)i * G + c; if (L >= nwg) return false;
        int wgid = (int)L; { const int q = nwg / NXCD, r = nwg % NXCD, xcd = wgid % NXCD, off = wgid / NXCD; wgid = (xcd < r ? xcd * (q + 1) : r * (q + 1) + (xcd - r) * q) + off; }
        const int nig = WGM * nN, gid = wgid / nig, fm = gid * WGM, gsz = (nM - fm) < WGM ? (nM - fm) : WGM;
        int pm = fm + ((wgid % nig) % gsz); u.pn = (wgid % nig) / gsz;
        u.pm = mode ? (pm / 32) * 33 + 1 + (pm % 32) : pm0 + pm; return true;
    }
};
__device__ __forceinline__ unsigned cvt_pk_bf16(float lo, float hi) { return pk2(lo, hi); }

constexpr int LDS_RS = 131072, LDS_BIAS = LDS_RS + 6 * 256 * 4, NB_STRIDE = 6912;
struct NormIn { const float* rsp; const float* bias; };
__device__ __forceinline__ void norm_prologue(LAS unsigned char* lds, const Order& S, const NormIn& ni, int tid) {
    LAS float* rs = (LAS float*)(lds + LDS_RS); LAS float* bi = (LAS float*)(lds + LDS_BIAS);
    const int row = tid >> 1, h = tid & 1;
    if (ni.rsp) {
        f32x4 a[6], b[6]; float bv[6]; bool ok[6];
#pragma unroll
        for (int ui = 0; ui < 6; ++ui) { Unit u; ok[ui] = S.next(ui, u); a[ui] = (f32x4){0.f, 0.f, 0.f, 0.f}; b[ui] = a[ui]; bv[ui] = 0.f;
            if (ok[ui]) { const float* p = ni.rsp + ((size_t)u.pm * 256 + row) * 16 + h * 8; a[ui] = *(const f32x4*)p; b[ui] = *(const f32x4*)(p + 4);
                if (tid < 256) { const int bq = u.pm / 33, sidx = (u.pm - bq * 33 == 0) ? 2 : bq; bv[ui] = ni.bias[(size_t)sidx * NB_STRIDE + u.pn * 256 + tid]; } } }
#pragma unroll
        for (int ui = 0; ui < 6; ++ui) if (ok[ui]) {
            float sq = ((a[ui][0] + a[ui][1]) + (a[ui][2] + a[ui][3])) + ((b[ui][0] + b[ui][1]) + (b[ui][2] + b[ui][3])); sq += __shfl_xor(sq, 1);
            if (h == 0) rs[ui * 256 + row] = 1.0f / sqrtf(sq * (1.f / DM) + NEPS);
            if (tid < 256) bi[ui * 256 + tid] = bv[ui]; }
    } else {
#pragma unroll
        for (int ui = 0; ui < 6; ++ui) { if (h == 0) rs[ui * 256 + row] = 1.f; if (tid < 256) bi[ui * 256 + tid] = 0.f; }
    }
    __syncthreads();
}
template <class Epi>
__device__ __forceinline__ void gemm_phase(LAS unsigned char* lds, const Gemm g, const Order& S, const Epi& E, int tid, const NormIn ni = NormIn{nullptr, nullptr}) {
    if constexpr (Epi::NORM_IN) norm_prologue(lds, S, ni, tid);
    const int wid = __builtin_amdgcn_readfirstlane(tid >> 6), lane = tid & 63, wr = wid >> 2, wc = wid & 3, fr = lane & 15, fq = lane >> 4;
    const int K = g.K;
    unsigned voffA[2], voffB[2];
#pragma unroll
    for (int i = 0; i < 2; ++i) { int R, C; stage_rc(tid * 16 + i * 8192, R, C); const int Rb = Epi::PERM ? ((R & ~31) + perm32(R & 31)) : R;
        voffA[i] = (unsigned)(R * K + C) * 2u; voffB[i] = (unsigned)(Rb * K + C) * 2u; }
    const size_t kstep = (size_t)(BK * 2);
    const size_t hstep = (size_t)HALF * K * 2;
    const size_t tstep = 2 * hstep;
    const unsigned ldsw = (unsigned)wid * 1024u;
    const int aoff = lds_byte(wr * 64 + fr, fq * 8), boff = lds_byte(wc * 32 + fr, fq * 8);
#define PG8_SA(b, h) (((b) * 2 + (h)) * HTB)
#define PG8_SB(b, h) ((4 + (b) * 2 + (h)) * HTB)
#define PG8_STAGE(bufoff, gbase, voff) do { _Pragma("unroll") for (int _i = 0; _i < 2; ++_i) \
        __builtin_amdgcn_global_load_lds((const unsigned*)((const char*)(gbase) + (voff)[_i]), (LAS unsigned*)(lds + (bufoff) + ldsw + _i * 8192), 16, 0, 0); } while (0)
#define PG8_LDA(dst, b, h) do { _Pragma("unroll") for (int m = 0; m < 4; ++m) _Pragma("unroll") for (int k = 0; k < 2; ++k) dst[m][k] = *(const LAS bf16x8*)(lds + PG8_SA(b, h) + aoff + m * 2048 + k * 1024); } while (0)
#define PG8_LDB(dst, b, h) do { _Pragma("unroll") for (int n = 0; n < 2; ++n) _Pragma("unroll") for (int k = 0; k < 2; ++k) dst[n][k] = *(const LAS bf16x8*)(lds + PG8_SB(b, h) + boff + n * 2048 + k * 1024); } while (0)
#define PG8_MMA(ai, bj, At, Bt) do { __builtin_amdgcn_s_setprio(1); _Pragma("unroll") for (int m = 0; m < 4; ++m) _Pragma("unroll") for (int n = 0; n < 2; ++n) _Pragma("unroll") for (int k = 0; k < 2; ++k) \
        acc[ai][bj][m][n] = __builtin_amdgcn_mfma_f32_16x16x32_bf16(Bt[n][k], At[m][k], acc[ai][bj][m][n], 0, 0, 0); __builtin_amdgcn_s_setprio(0); } while (0)
#define PG8_WAIT_V(n) asm volatile("s_waitcnt vmcnt(" #n ")" ::: "memory")
#define PG8_WAIT_L(n) asm volatile("s_waitcnt lgkmcnt(" #n ")" ::: "memory")
#define PG8_BAR __builtin_amdgcn_s_barrier()
#define PG8_SCHED __builtin_amdgcn_sched_barrier(0)
    Unit cur, nxt; int ui = 0;
    if (!S.next(0, cur)) return;
    f32x4 acc[2][2][4][2];
#pragma unroll
    for (int a = 0; a < 2; ++a)
#pragma unroll
        for (int b = 0; b < 2; ++b)
#pragma unroll
            for (int m = 0; m < 4; ++m)
#pragma unroll
                for (int n = 0; n < 2; ++n) acc[a][b][m][n] = (f32x4){0.f, 0.f, 0.f, 0.f};
    bf16x8 At[4][2], B0[2][2], B1[2][2];
    const char* cA = (const char*)g.A + (size_t)cur.pm * tstep + (size_t)cur.k0 * kstep; const char* cB = (const char*)g.Bt + (size_t)cur.pn * tstep + (size_t)cur.k0 * kstep;
    PG8_STAGE(PG8_SB(0, 0), cB, voffB); PG8_STAGE(PG8_SA(0, 0), cA, voffA); PG8_STAGE(PG8_SB(0, 1), cB + hstep, voffB); PG8_STAGE(PG8_SA(0, 1), cA + hstep, voffA);
    if (wr == 1) PG8_BAR;
    PG8_WAIT_V(4); PG8_BAR;
    PG8_STAGE(PG8_SB(1, 0), cB + kstep, voffB); PG8_STAGE(PG8_SA(1, 0), cA + kstep, voffA); PG8_STAGE(PG8_SB(1, 1), cB + hstep + kstep, voffB);
    PG8_WAIT_V(6); PG8_BAR;
    for (;;) {
        const bool has_next = S.next(ui + 1, nxt);
        const char* nA = has_next ? (const char*)g.A + (size_t)nxt.pm * tstep + (size_t)nxt.k0 * kstep : cA; const char* nB = has_next ? (const char*)g.Bt + (size_t)nxt.pn * tstep + (size_t)nxt.k0 * kstep : cB;
        const int nt = cur.nk;
        for (int t = 0; t < nt; t += 2) {
            const bool last = (t == nt - 2);
            const char* a1 = cA + (size_t)(t + 1) * kstep;
            const char* a2 = last ? nA : cA + (size_t)(t + 2) * kstep; const char* b2 = last ? nB : cB + (size_t)(t + 2) * kstep;
            const char* a3 = a2 + kstep; const char* b3 = b2 + kstep;
            PG8_LDB(B0, 0, 0); PG8_SCHED; PG8_LDA(At, 0, 0); PG8_STAGE(PG8_SA(1, 1), a1 + hstep, voffA);
            PG8_WAIT_L(8); PG8_BAR; PG8_WAIT_L(0); PG8_MMA(0, 0, At, B0); PG8_BAR; PG8_SCHED;
            PG8_LDB(B1, 0, 1); PG8_STAGE(PG8_SB(0, 0), b2, voffB);
            PG8_BAR; PG8_WAIT_L(0); PG8_MMA(0, 1, At, B1); PG8_BAR;
            PG8_LDA(At, 0, 1); PG8_STAGE(PG8_SA(0, 0), a2, voffA);
            PG8_BAR; PG8_WAIT_L(0); PG8_MMA(1, 0, At, B0); PG8_BAR; PG8_SCHED;
            PG8_STAGE(PG8_SB(0, 1), b2 + hstep, voffB);
            PG8_WAIT_V(6); PG8_BAR; PG8_MMA(1, 1, At, B1); PG8_BAR;
            PG8_LDB(B0, 1, 0); PG8_SCHED; PG8_LDA(At, 1, 0); PG8_STAGE(PG8_SA(0, 1), a2 + hstep, voffA);
            PG8_WAIT_L(8); PG8_BAR; PG8_WAIT_L(0); PG8_MMA(0, 0, At, B0); PG8_BAR; PG8_SCHED;
            PG8_LDB(B1, 1, 1); PG8_STAGE(PG8_SB(1, 0), b3, voffB);
            PG8_BAR; PG8_WAIT_L(0); PG8_MMA(0, 1, At, B1); PG8_BAR;
            PG8_LDA(At, 1, 1); PG8_STAGE(PG8_SA(1, 0), a3, voffA);
            PG8_BAR; PG8_WAIT_L(0); PG8_MMA(1, 0, At, B0); PG8_BAR; PG8_SCHED;
            PG8_STAGE(PG8_SB(1, 1), b3 + hstep, voffB);
            PG8_WAIT_V(6); PG8_BAR; PG8_MMA(1, 1, At, B1); PG8_BAR;
        }
        E(acc, cur, wr, wc, fr, fq, ui, lds);
        if (!has_next) break;
#pragma unroll
        for (int a = 0; a < 2; ++a)
#pragma unroll
            for (int b = 0; b < 2; ++b)
#pragma unroll
                for (int m = 0; m < 4; ++m)
#pragma unroll
                    for (int n = 0; n < 2; ++n) acc[a][b][m][n] = (f32x4){0.f, 0.f, 0.f, 0.f};
        cur = nxt; cA = nA; cB = nB; ++ui;
    }
    PG8_WAIT_V(0);
    if (wr == 0) PG8_BAR;
    PG8_BAR;
#undef PG8_SA
#undef PG8_SB
#undef PG8_STAGE
#undef PG8_LDA
#undef PG8_LDB
#undef PG8_MMA
#undef PG8_WAIT_V
#undef PG8_WAIT_L
#undef PG8_BAR
#undef PG8_SCHED
}
struct EpiSwigluP {
    static constexpr bool PERM = true, NORM_IN = true; bf16_t* hid;
    __device__ __forceinline__ void operator()(const f32x4 (&acc)[2][2][4][2], const Unit& u, int wr, int wc, int fr, int fq, int ui, LAS unsigned char* lds) const {
        const int row0 = u.pm * BM + wr * 64 + fr, col0 = u.pn * 128 + wc * 32 + 8 * fq;
        const LAS float* rs = (const LAS float*)(lds + LDS_RS) + ui * 256 + wr * 64 + fr; const LAS float* bi = (const LAS float*)(lds + LDS_BIAS) + ui * 256 + wc * 32 + 8 * fq;
        f32x4 bg[2], bu[2];
#pragma unroll
        for (int n = 0; n < 2; ++n) { bg[n] = *(const LAS f32x4*)(bi + 4 * n); bu[n] = *(const LAS f32x4*)(bi + 128 + 4 * n); }
#pragma unroll
        for (int ai = 0; ai < 2; ++ai)
#pragma unroll
            for (int m = 0; m < 4; ++m) { float h[8]; const float r = rs[ai * HALF + m * 16];
#pragma unroll
                for (int n = 0; n < 2; ++n)
#pragma unroll
                    for (int i = 0; i < 4; ++i) h[n * 4 + i] = silu_f(fmaf(r, acc[ai][0][m][n][i], bg[n][i])) * fmaf(r, acc[ai][1][m][n][i], bu[n][i]);
                u32x4 w; w.x = cvt_pk_bf16(h[0], h[1]); w.y = cvt_pk_bf16(h[2], h[3]); w.z = cvt_pk_bf16(h[4], h[5]); w.w = cvt_pk_bf16(h[6], h[7]);
                *(u32x4*)(hid + (size_t)(row0 + ai * HALF + m * 16) * DFF + col0) = w; }
    }
};
struct EpiResidP {
    static constexpr bool PERM = true, NORM_IN = false; const void* base; long dbase; void* out; long dxc; const float* mt; int gidx; const float* gn; int kn; bool fuse, in32, out32; unsigned char* wsb; float coef;
    __device__ __forceinline__ void operator()(const f32x4 (&acc)[2][2][4][2], const Unit& u, int wr, int wc, int fr, int fq, int, LAS unsigned char*) const {
        asm volatile("" : "+v"(fr), "+v"(fq));
        float cf = coef; asm volatile("" : "+v"(cf));
        const int b = u.pm / 33, j = u.pm - b * 33; const bool isctx = (j == 0); const int s = isctx ? 2 : b;
        const long rb = isctx ? (long)(b * CTXL) * DM : (long)(b * SEQ + (j - 1) * 256) * DM;
        const long bo = rb + (isctx ? dbase : 0), oo = rb + (isctx ? dxc : 0);
        const float* bp32 = (const float*)base + bo; const h16* bp16 = (const h16*)base + bo; float* op32 = (float*)out + oo; h16* op16 = (h16*)out + oo;
        bf16_t* hn = (bf16_t*)(wsb + WS_HN) + (size_t)u.pm * BM * DM; float* rsp = (float*)(wsb + WS_RSP) + (size_t)u.pm * BM * 16 + u.pn * 4 + wc;
        const int col0 = u.pn * BM + wc * 32 + 8 * fq; const float* gv = mt + (s * 9 + gidx) * DM; const float* scn = mt + (s * 9 + kn * 3 + 1) * DM;
        float ss[2][4];
#pragma unroll
        for (int ai = 0; ai < 2; ++ai)
#pragma unroll
            for (int m = 0; m < 4; ++m) ss[ai][m] = 0.f;
#define RESID_ROW(ai_, m_, xb0_, xb1_) do { const unsigned off = (unsigned)((ai_) * HALF + wr * 64 + (m_) * 16 + fr) * DM + col0 + bj * HALF; \
            const f32x4 x0 = (xb0_) + g4[0] * acc[ai_][bj][m_][0], x1 = (xb1_) + g4[1] * acc[ai_][bj][m_][1]; \
            if (out32) { *(f32x4*)(op32 + off) = x0; *(f32x4*)(op32 + (off + 4)) = x1; } \
            else *(u32x4*)(op16 + off) = (u32x4){pkh2(x0[0], x0[1]), pkh2(x0[2], x0[3]), pkh2(x1[0], x1[1]), pkh2(x1[2], x1[3])}; \
            if (fuse) { ss[ai_][m_] += ((x0[0] * x0[0] + x0[1] * x0[1]) + (x0[2] * x0[2] + x0[3] * x0[3])) + ((x1[0] * x1[0] + x1[1] * x1[1]) + (x1[2] * x1[2] + x1[3] * x1[3])); \
                const f32x4 y0 = x0 * a4[0], y1 = x1 * a4[1]; \
                *(u32x4*)(hn + off) = (u32x4){cvt_pk_bf16(y0[0], y0[1]), cvt_pk_bf16(y0[2], y0[3]), cvt_pk_bf16(y1[0], y1[1]), cvt_pk_bf16(y1[2], y1[3])}; } } while (0)
#pragma unroll
        for (int bj = 0; bj < 2; ++bj) {
            f32x4 g4[2], a4[2];
#pragma unroll
            for (int n = 0; n < 2; ++n) { const unsigned c = (unsigned)(col0 + bj * HALF + n * 4); g4[n] = *(const f32x4*)(gv + c) * cf;
                if (fuse) a4[n] = *(const f32x4*)(gn + c) * (1.f + *(const f32x4*)(scn + c)); else a4[n] = (f32x4){0.f, 0.f, 0.f, 0.f}; }
            if (in32) {
#pragma unroll
                for (int ai = 0; ai < 2; ++ai) {
                    f32x4 bs[4][2];
#pragma unroll
                    for (int m = 0; m < 4; ++m) { const unsigned off = (unsigned)(ai * HALF + wr * 64 + m * 16 + fr) * DM + col0 + bj * HALF; bs[m][0] = *(const f32x4*)(bp32 + off); bs[m][1] = *(const f32x4*)(bp32 + (off + 4)); }
#pragma unroll
                    for (int m = 0; m < 4; ++m) RESID_ROW(ai, m, bs[m][0], bs[m][1]);
                    asm volatile("" ::: "memory");
                }
            } else {
                u32x4 bh[2][4];
#pragma unroll
                for (int ai = 0; ai < 2; ++ai)
#pragma unroll
                    for (int m = 0; m < 4; ++m) { const unsigned off = (unsigned)(ai * HALF + wr * 64 + m * 16 + fr) * DM + col0 + bj * HALF; bh[ai][m] = *(const u32x4*)(bp16 + off); }
#pragma unroll
                for (int ai = 0; ai < 2; ++ai)
#pragma unroll
                    for (int m = 0; m < 4; ++m) { const f32x2_t c0 = unh2(bh[ai][m][0]), c1 = unh2(bh[ai][m][1]), c2 = unh2(bh[ai][m][2]), c3 = unh2(bh[ai][m][3]);
                        RESID_ROW(ai, m, ((f32x4){c0[0], c0[1], c1[0], c1[1]}), ((f32x4){c2[0], c2[1], c3[0], c3[1]})); }
                asm volatile("" ::: "memory");
            }
        }
#undef RESID_ROW
        if (fuse) {
#pragma unroll
            for (int ai = 0; ai < 2; ++ai)
#pragma unroll
                for (int m = 0; m < 4; ++m) { float t = ss[ai][m]; t += __shfl_xor(t, 16); t += __shfl_xor(t, 32); if (fq == 0) rsp[(unsigned)(ai * HALF + wr * 64 + m * 16 + fr) * 16] = t; }
        }
    }
};
struct EpiABP {
    static constexpr bool PERM = true, NORM_IN = true; bf16_t* zg; bf16_t* raw; float* abs_; int row0;
    __device__ __forceinline__ void operator()(const f32x4 (&acc)[2][2][4][2], const Unit& u, int wr, int wc, int fr, int fq, int ui, LAS unsigned char* lds) const {
        const int u0 = u.pm * BM - row0 + wr * 64 + fr;
        const LAS float* rs = (const LAS float*)(lds + LDS_RS) + ui * 256 + wr * 64 + fr; const LAS float* bi = (const LAS float*)(lds + LDS_BIAS) + ui * 256 + wc * 32 + 8 * fq;
        f32x4 b4[2][2];
#pragma unroll
        for (int bj = 0; bj < 2; ++bj)
#pragma unroll
            for (int n = 0; n < 2; ++n) b4[bj][n] = *(const LAS f32x4*)(bi + bj * HALF + 4 * n);
        if (u.pn < 26) {
            const bool israw = (u.pn >= 4 && u.pn < 22); const int ld = israw ? 4608 : 2048;
            bf16_t* dst = israw ? raw + (u.pn - 4) * BM : (u.pn < 4 ? zg + u.pn * BM : zg + 1024 + (u.pn - 22) * BM); const int col0 = wc * 32 + 8 * fq;
#pragma unroll
            for (int ai = 0; ai < 2; ++ai)
#pragma unroll
                for (int m = 0; m < 4; ++m) { const float r = rs[ai * HALF + m * 16];
#pragma unroll
                    for (int bj = 0; bj < 2; ++bj) { const f32x4 v0 = acc[ai][bj][m][0] * r + b4[bj][0], v1 = acc[ai][bj][m][1] * r + b4[bj][1];
                        u32x4 w; w.x = cvt_pk_bf16(v0[0], v0[1]); w.y = cvt_pk_bf16(v0[2], v0[3]); w.z = cvt_pk_bf16(v1[0], v1[1]); w.w = cvt_pk_bf16(v1[2], v1[3]);
                        *(u32x4*)(dst + (size_t)(u0 + ai * HALF + m * 16) * ld + col0 + bj * HALF) = w; } }
        } else if (wc < 2) {
#pragma unroll
            for (int ai = 0; ai < 2; ++ai)
#pragma unroll
                for (int m = 0; m < 4; ++m) { float* p = abs_ + (size_t)(u0 + ai * HALF + m * 16) * 64 + wc * 32 + 8 * fq; const float r = rs[ai * HALF + m * 16];
                    *(f32x4*)p = acc[ai][0][m][0] * r + b4[0][0]; *(f32x4*)(p + 4) = acc[ai][0][m][1] * r + b4[0][1]; }
        }
    }
};
struct EpiBf16P {
    static constexpr bool PERM = true, NORM_IN = true; bf16_t* O; int ldc;
    __device__ __forceinline__ void operator()(const f32x4 (&acc)[2][2][4][2], const Unit& u, int wr, int wc, int fr, int fq, int ui, LAS unsigned char* lds) const {
        const int row0 = u.pm * BM + wr * 64 + fr, col0 = u.pn * BM + wc * 32 + 8 * fq;
        const LAS float* rs = (const LAS float*)(lds + LDS_RS) + ui * 256 + wr * 64 + fr; const LAS float* bi = (const LAS float*)(lds + LDS_BIAS) + ui * 256 + wc * 32 + 8 * fq;
        f32x4 b4[2][2];
#pragma unroll
        for (int bj = 0; bj < 2; ++bj)
#pragma unroll
            for (int n = 0; n < 2; ++n) b4[bj][n] = *(const LAS f32x4*)(bi + bj * HALF + 4 * n);
#pragma unroll
        for (int ai = 0; ai < 2; ++ai)
#pragma unroll
            for (int m = 0; m < 4; ++m) { const float r = rs[ai * HALF + m * 16];
#pragma unroll
                for (int bj = 0; bj < 2; ++bj) { const f32x4 v0 = acc[ai][bj][m][0] * r + b4[bj][0], v1 = acc[ai][bj][m][1] * r + b4[bj][1];
                    u32x4 w; w.x = cvt_pk_bf16(v0[0], v0[1]); w.y = cvt_pk_bf16(v0[2], v0[3]); w.z = cvt_pk_bf16(v1[0], v1[1]); w.w = cvt_pk_bf16(v1[2], v1[3]);
                    *(u32x4*)(O + (size_t)(row0 + ai * HALF + m * 16) * ldc + col0 + bj * HALF) = w; } }
    }
};
}

__device__ __forceinline__ void cvt_item(const float* W, int ldw, int K, bf16_t* WT, int dest_row0, int src_col0, int kb, LAS float* scr, int lane) {
    const int k0 = 64 * kb;
    float v[32];
    const float* wp = W + (size_t)(k0 + (lane >> 5)) * ldw + (src_col0 >= 0 ? src_col0 : 0) + (lane & 31);
#pragma unroll
    for (int i = 0; i < 32; ++i) v[i] = __builtin_nontemporal_load(wp + (size_t)(2 * i) * ldw);
#pragma unroll
    for (int i = 0; i < 32; ++i) { const int kk = 2 * i + (lane >> 5); scr[kk * 33 + (lane & 31)] = src_col0 >= 0 ? v[i] : 0.f; }
    asm volatile("s_waitcnt lgkmcnt(0)" ::: "memory");
    const int c = lane & 7;
#pragma unroll
    for (int j = 0; j < 4; ++j) { const int n = (lane >> 3) + 8 * j; const LAS float* sp = scr + (8 * c) * 33 + n;
        u32x4 o; o.x = pg8::cvt_pk_bf16(sp[0 * 33], sp[1 * 33]); o.y = pg8::cvt_pk_bf16(sp[2 * 33], sp[3 * 33]); o.z = pg8::cvt_pk_bf16(sp[4 * 33], sp[5 * 33]); o.w = pg8::cvt_pk_bf16(sp[6 * 33], sp[7 * 33]);
        *(u32x4*)(WT + (size_t)(dest_row0 + n) * K + k0 + 8 * c) = o; }
    asm volatile("s_waitcnt lgkmcnt(0)" ::: "memory");
}
__device__ __forceinline__ int map_ffin(int nb) { const int r0 = nb * 32, pn = r0 >> 8, j = r0 & 255; return j < 128 ? pn * 128 + j : DFF + pn * 128 + (j - 128); }
__device__ __forceinline__ int map_abin(int nb) { const int r0 = nb * 32; return r0 < 2560 ? r0 : (r0 < 6656 ? r0 + 32 : (r0 == 6656 ? 2560 : (r0 == 6688 ? 6688 : -1))); }
__device__ __forceinline__ void phase_convert(Frame& F, int l) {
    LAS float* scr = (LAS float*)(F.lds + F.wave * 8448);
    unsigned char* wb = F.ws + WS_W;
    const int gw = F.bid * 8 + F.wave, NGW = F.G * 8;
    constexpr int I_FFIN = 16 * 176, I_FFOUT = 44 * 32;
    const int n_in = l == 0 ? 216 : 64, I_MIN = 16 * n_in, kb_out = l == 0 ? 32 : 16, I_MOUT = kb_out * 32;
    const int total = 2 * I_FFIN + 2 * I_FFOUT + I_MIN + I_MOUT;
    for (int it = gw; it < total; it += NGW) {
        int r = it;
        if (r < 2 * I_FFIN) { const int w = r / I_FFIN; r -= w * I_FFIN; const int kb = r / 176, nb = r - kb * 176;
            cvt_item(F.in[I_WFFIN] + (size_t)(l * 2 + w) * DM * 2 * DFF, 2 * DFF, DM, (bf16_t*)(wb + (w ? W_FFIN1 : W_FFIN0)), nb * 32, map_ffin(nb), kb, scr, F.lane); continue; }
        r -= 2 * I_FFIN;
        if (r < 2 * I_FFOUT) { const int w = r / I_FFOUT; r -= w * I_FFOUT; const int kb = r / 32, nb = r - kb * 32;
            cvt_item(F.in[I_WFFOUT] + (size_t)(l * 2 + w) * DFF * DM, DM, DFF, (bf16_t*)(wb + (w ? W_FFOUT1 : W_FFOUT0)), nb * 32, nb * 32, kb, scr, F.lane); continue; }
        r -= 2 * I_FFOUT;
        if (r < I_MIN) { const int kb = r / n_in, nb = r - kb * n_in;
            if (l == 0) cvt_item(F.in[I_ABWIN], 6720, DM, (bf16_t*)(wb + W_MIXIN), nb * 32, map_abin(nb), kb, scr, F.lane);
            else cvt_item(F.in[I_WQKV], 2048, DM, (bf16_t*)(wb + W_MIXIN), nb * 32, nb * 32, kb, scr, F.lane);
            continue; }
        r -= I_MIN;
        { const int kb = r / 32, nb = r - kb * 32;
          if (l == 0) cvt_item(F.in[I_ABWOUT], DM, 2048, (bf16_t*)(wb + W_MIXOUT), nb * 32, nb * 32, kb, scr, F.lane);
          else cvt_item(F.in[I_WO], DM, DM, (bf16_t*)(wb + W_MIXOUT), nb * 32, nb * 32, kb, scr, F.lane); }
    }
}

namespace att {
constexpr int D = 128, NW = 8, QBLK = 32, KVBLK = 64;
constexpr float SCALE = 0.088388347648318440f;
constexpr float THR = 8.f;
constexpr int SDEPTH = 1;
constexpr int LDQ = 2048, LDK = 2048, LDO = 1024;
constexpr size_t SHM_V = KVBLK * D * 2, SHM_K = KVBLK * D * 2, SHM_Q = 256 * D * 2, SHM_ATTN = 2 * SHM_V + 2 * SHM_K + NW * 64 * 4 + SHM_Q;
#define KSWZ(row, colB) ((row) * 256 + ((colB) ^ (((row) & 7) << 4)))
#define SBAR() __builtin_amdgcn_sched_barrier(0)
__device__ __forceinline__ int crow(int r, int hi) { return (r & 3) + 8 * (r >> 2) + 4 * hi; }
__device__ __forceinline__ unsigned cvtpk(float lo, float hi) { unsigned r; asm volatile("v_cvt_pk_bf16_f32 %0, %1, %2" : "=v"(r) : "v"(lo), "v"(hi)); return r; }
__device__ __forceinline__ bf16x8 ld8(const bf16_t* p) { return *reinterpret_cast<const bf16x8*>(p); }
__device__ __forceinline__ void partialSM(f32x16& p0, f32x16& p1, float& m_reg, float& mn, float& alpha) {
  constexpr float C = SCALE * 1.4426950408889634f;
  float pmax = p0[0]; for (int r = 1; r < 16; ++r) pmax = fmaxf(pmax, p0[r]); for (int r = 0; r < 16; ++r) pmax = fmaxf(pmax, p1[r]);
  { auto rr = __builtin_amdgcn_permlane32_swap(__float_as_uint(pmax), __float_as_uint(pmax), false, false);
    pmax = fmaxf(__uint_as_float(rr[0]), __uint_as_float(rr[1])); }
  if (__builtin_expect(__all(pmax - m_reg <= THR / SCALE), 1)) { mn = m_reg; alpha = 1.f; }
  else { mn = fmaxf(m_reg, pmax); alpha = __builtin_amdgcn_exp2f((m_reg - mn) * C); m_reg = mn; }
  float mnC = -mn * C;
  for (int r = 0; r < 16; ++r) p0[r] = fmaf(p0[r], C, mnC); for (int r = 0; r < 16; ++r) p1[r] = fmaf(p1[r], C, mnC);
  for (int r = 0; r < 16; ++r) p0[r] = __builtin_amdgcn_exp2f(p0[r]);
}
__device__ __forceinline__ void finishSM(f32x16& p0, f32x16& p1, float alpha, float& l_reg, bf16x8& pa0, bf16x8& pa1, bf16x8& pa2, bf16x8& pa3) {
  for (int r = 0; r < 16; ++r) p1[r] = __builtin_amdgcn_exp2f(p1[r]);
  float ps = 0; for (int r = 0; r < 16; ++r) ps += p0[r]; for (int r = 0; r < 16; ++r) ps += p1[r];
  { auto rr = __builtin_amdgcn_permlane32_swap(__float_as_uint(ps), __float_as_uint(ps), false, false);
    ps = __uint_as_float(rr[0]) + __uint_as_float(rr[1]); }
  l_reg = l_reg * alpha + ps;
#define PK4(P, BASE, OUT) do { unsigned a0 = cvtpk(P[BASE + 0], P[BASE + 1]), a1 = cvtpk(P[BASE + 2], P[BASE + 3]);   \
    unsigned b0 = cvtpk(P[BASE + 4], P[BASE + 5]), b1 = cvtpk(P[BASE + 6], P[BASE + 7]);                              \
    auto r0 = __builtin_amdgcn_permlane32_swap(a0, b0, false, false); auto r1 = __builtin_amdgcn_permlane32_swap(a1, b1, false, false); \
    u32x4 w = {r0[0], r1[0], r0[1], r1[1]}; OUT = *reinterpret_cast<bf16x8*>(&w); } while (0)
  PK4(p0, 0, pa0); PK4(p0, 8, pa1); PK4(p1, 0, pa2); PK4(p1, 8, pa3);
#undef PK4
}
__device__ __forceinline__ void qkt(f32x16& p0, f32x16& p1, const bf16_t* Ks, const bf16x8 (&qreg)[8], int qrow, int r32, int hi) {
  p0 = f32x16{}; p1 = f32x16{};
  for (int d0 = 0; d0 < 8; ++d0) { int cb = (d0 * 16 + hi * 8) * 2; const bf16x8 qf = qreg[d0];
    bf16x8 b0 = *reinterpret_cast<const bf16x8*>((const char*)Ks + KSWZ(r32, cb));
    bf16x8 b1 = *reinterpret_cast<const bf16x8*>((const char*)Ks + KSWZ(32 + r32, cb));
    p0 = __builtin_amdgcn_mfma_f32_32x32x16_bf16(b0, qf, p0, 0, 0, 0);
    p1 = __builtin_amdgcn_mfma_f32_32x32x16_bf16(b1, qf, p1, 0, 0, 0); }
}
__device__ __forceinline__ int v_st(int k, int c) { const int kk = (k & ~0xC) | ((k & 4) << 1) | ((k & 8) >> 1); return ((kk >> 3) * 4 + (c >> 5)) * 512 + ((kk & 7) * 32 + (c & 31)) * 2; }
__device__ __forceinline__ int v_rd_base(int lane) { return ((lane & 3) << 3) | (((lane >> 2) & 3) << 6) | (((lane >> 4) & 1) << 5) | (((lane >> 5) & 1) << 8); }
constexpr int v_rd_off(int d0, int ks, int half) { return d0 * 512 + ks * 4096 + half * 2048; }
template <int OFF> __device__ __forceinline__ s16x4 tr_read(int vb) {
  s16x4 r; asm volatile("ds_read_b64_tr_b16 %0, %1 offset:%2" : "=&v"(r) : "v"(vb), "i"(OFF) : "memory"); return r;
}
template <int D0> __device__ __forceinline__ void pv_one(f32x16& od, int vb, bf16x8 pa0, bf16x8 pa1, bf16x8 pa2, bf16x8 pa3) {
  const s16x4 l0 = tr_read<v_rd_off(D0, 0, 0)>(vb), h0 = tr_read<v_rd_off(D0, 0, 1)>(vb), l1 = tr_read<v_rd_off(D0, 1, 0)>(vb), h1 = tr_read<v_rd_off(D0, 1, 1)>(vb);
  const s16x4 l2 = tr_read<v_rd_off(D0, 2, 0)>(vb), h2 = tr_read<v_rd_off(D0, 2, 1)>(vb), l3 = tr_read<v_rd_off(D0, 3, 0)>(vb), h3 = tr_read<v_rd_off(D0, 3, 1)>(vb);
  asm volatile("s_waitcnt lgkmcnt(0)" ::: "memory"); SBAR();
#define PK(L, H) (bf16x8){L[0], L[1], L[2], L[3], H[0], H[1], H[2], H[3]}
  od = __builtin_amdgcn_mfma_f32_32x32x16_bf16(pa0, PK(l0, h0), od, 0, 0, 0);
  od = __builtin_amdgcn_mfma_f32_32x32x16_bf16(pa1, PK(l1, h1), od, 0, 0, 0);
  od = __builtin_amdgcn_mfma_f32_32x32x16_bf16(pa2, PK(l2, h2), od, 0, 0, 0);
  od = __builtin_amdgcn_mfma_f32_32x32x16_bf16(pa3, PK(l3, h3), od, 0, 0, 0);
#undef PK
}
__device__ __forceinline__ void pv_d0(f32x16* o, int vb, bf16x8 pa0, bf16x8 pa1, bf16x8 pa2, bf16x8 pa3) {
  pv_one<0>(o[0], vb, pa0, pa1, pa2, pa3); pv_one<1>(o[1], vb, pa0, pa1, pa2, pa3); pv_one<2>(o[2], vb, pa0, pa1, pa2, pa3); pv_one<3>(o[3], vb, pa0, pa1, pa2, pa3);
}
__device__ __forceinline__ void attn_dense_body(const bf16_t* __restrict__ Qb, const bf16_t* __restrict__ Kh, const bf16_t* __restrict__ Vh,
                                                bf16_t* __restrict__ Ob, int  , char* lds, int tid) {
  constexpr int seq = TB;
  const int wid = tid >> 6, lane = tid & 63, r32 = lane & 31, hi = lane >> 5;
  bf16_t* V_lds = (bf16_t*)lds; bf16_t* K_lds = (bf16_t*)(lds + 3 * SHM_V);
  float* ws = (float*)(lds + 3 * SHM_V + 3 * SHM_K) + wid * 64; float* li_l = ws; float* al_l = ws + 32;
  float m_reg = -1e30f, l_reg = 0; f32x16 o[4] = {};
  const int qrow = wid * QBLK + r32;
  bf16x8 Qs[8];
  { const bf16_t* Qw = Qb + (long)qrow * LDQ + hi * 8;
#pragma unroll
    for (int d0 = 0; d0 < 8; ++d0) Qs[d0] = ld8(Qw + d0 * 16); }
  const int sr = tid >> 4, sc = (tid & 15) * 8, vst0 = v_st(sr, sc), vst1 = v_st(32 + sr, sc);
  const int vb0 = (int)(uintptr_t)V_lds + v_rd_base(lane);
  static_assert(SDEPTH == 1 && SHM_V == SHM_K, "ring form: K/V register-staged one tile ahead");
  struct { bf16x8 vs0, vs1, ks0, ks1; } sr_;
#define SLOAD(k0) do { sr_.vs0 = ld8(&Vh[(long)((k0) + sr) * LDK + sc]); sr_.vs1 = ld8(&Vh[(long)((k0) + 32 + sr) * LDK + sc]); \
    sr_.ks0 = ld8(&Kh[(long)((k0) + sr) * LDK + sc]); sr_.ks1 = ld8(&Kh[(long)((k0) + 32 + sr) * LDK + sc]); } while (0)
#define SWRITE(bo) do { *(bf16x8*)((char*)V_lds + (bo) + vst0) = sr_.vs0; *(bf16x8*)((char*)V_lds + (bo) + vst1) = sr_.vs1; int kc = sc * 2;               \
    *(bf16x8*)((char*)K_lds + (bo) + KSWZ(sr, kc)) = sr_.ks0; *(bf16x8*)((char*)K_lds + (bo) + KSWZ(32 + sr, kc)) = sr_.ks1; } while (0)
#define SWAIT() asm volatile("s_waitcnt vmcnt(0)" ::: "memory")
#define RESC(a) do { if (__any((a) < 1.f)) { if (hi == 0) al_l[r32] = (a); asm volatile("s_waitcnt lgkmcnt(0)" ::: "memory"); \
    for (int d = 0; d < 4; ++d) for (int r = 0; r < 16; ++r) o[d][r] *= al_l[crow(r, hi)]; } } while (0)
#define ROT() do { bprev = bcur; bcur = bnext; bnext = (bnext == 2 * (int)SHM_V) ? 0 : bnext + (int)SHM_V; } while (0)
  f32x16 pA0, pA1, pB0, pB1; float mnA, mnB, alA, alB; bf16x8 pa0, pa1, pa2, pa3; const int NT = seq / KVBLK;
  int bprev = 0, bcur = (int)SHM_V, bnext = 2 * (int)SHM_V;
  SLOAD(0); asm volatile("s_waitcnt vmcnt(0)" ::: "memory"); SWRITE(0); __syncthreads();
  qkt(pA0, pA1, K_lds, Qs, qrow, r32, hi); partialSM(pA0, pA1, m_reg, mnA, alA);
  SLOAD(KVBLK); SWAIT(); SWRITE((int)SHM_V); __syncthreads();
  for (int j = 1; j + 1 < NT; j += 2) {
    SBAR(); qkt(pB0, pB1, (bf16_t*)((char*)K_lds + bcur), Qs, qrow, r32, hi);
    finishSM(pA0, pA1, alA, l_reg, pa0, pa1, pa2, pa3); SBAR();
    SLOAD((j + 1) * KVBLK); SBAR();
    pv_d0(o, vb0 + bprev, pa0, pa1, pa2, pa3); partialSM(pB0, pB1, m_reg, mnB, alB);
    SWAIT(); SWRITE(bnext);
    RESC(alB); __syncthreads(); ROT();
    SBAR(); qkt(pA0, pA1, (bf16_t*)((char*)K_lds + bcur), Qs, qrow, r32, hi);
    finishSM(pB0, pB1, alB, l_reg, pa0, pa1, pa2, pa3); SBAR();
    SLOAD((j + 2) * KVBLK); SBAR();
    pv_d0(o, vb0 + bprev, pa0, pa1, pa2, pa3); partialSM(pA0, pA1, m_reg, mnA, alA);
    SWAIT(); SWRITE(bnext);
    RESC(alA); __syncthreads(); ROT();
  }
  SBAR(); qkt(pB0, pB1, (bf16_t*)((char*)K_lds + bcur), Qs, qrow, r32, hi);
  finishSM(pA0, pA1, alA, l_reg, pa0, pa1, pa2, pa3); SBAR();
  pv_d0(o, vb0 + bprev, pa0, pa1, pa2, pa3); partialSM(pB0, pB1, m_reg, mnB, alB);
  RESC(alB);
  finishSM(pB0, pB1, alB, l_reg, pa0, pa1, pa2, pa3); SBAR();
  pv_d0(o, vb0 + bcur, pa0, pa1, pa2, pa3);
  if (hi == 0) li_l[r32] = l_reg; asm volatile("s_waitcnt lgkmcnt(0)" ::: "memory");
  float rli[16];
#pragma unroll
  for (int r = 0; r < 16; ++r) rli[r] = __builtin_amdgcn_rcpf(li_l[crow(r, hi)]);
  bf16_t* Ow = Ob + (long)(wid * QBLK) * LDO;
#pragma unroll
  for (int r = 0; r < 16; ++r) { int orow = crow(r, hi);
    for (int d0 = 0; d0 < 4; ++d0) Ow[(long)orow * LDO + d0 * 32 + r32] = f2bf(o[d0][r] * rli[r]); }
#undef SLOAD
#undef SWRITE
#undef SWAIT
#undef RESC
#undef ROT
}
}

__device__ __forceinline__ void phase_modtab(Frame& F) {
    LAS float* sc = (LAS float*)F.lds;
    for (int i = F.tid; i < 3 * DM; i += NTHREADS) { const int s = i / DM, k = i - s * DM; const float c = s < 2 ? F.in[I_C][s * DM + k] : F.in[I_CCTX][k]; sc[i] = silu_f(c); }
    __syncthreads();
    float* mtp = (float*)(F.ws + WS_MTP);
    for (int it = F.bid; it < 2 * 16 * 18; it += F.G) {
        const int l = it / 288, r = it - l * 288, kc = r / 18, nc = r - kc * 18, n = nc * 512 + F.tid;
        const float* w = F.in[I_WMOD] + ((size_t)l * DM + kc * 64) * 9216 + n; float a0 = 0.f, a1 = 0.f, a2 = 0.f;
        float wv[64];
#pragma unroll
        for (int k = 0; k < 64; ++k) wv[k] = __builtin_nontemporal_load(w + (size_t)k * 9216);
#pragma unroll
        for (int k = 0; k < 64; ++k) { a0 = fmaf(sc[kc * 64 + k], wv[k], a0); a1 = fmaf(sc[DM + kc * 64 + k], wv[k], a1); a2 = fmaf(sc[2 * DM + kc * 64 + k], wv[k], a2); }
        float* o = mtp + ((size_t)(l * 16 + kc) * 3) * 9216 + n; o[0] = a0; o[9216] = a1; o[2 * 9216] = a2;
    }
    __syncthreads();
}
__device__ __forceinline__ float modtab_sum(Frame& F, int l, int s, int n) {
    const float* p = (const float*)(F.ws + WS_MTP) + ((size_t)(l * 16) * 3 + s) * 9216 + n; float a = F.in[I_BMOD][l * 9216 + n];
#pragma unroll
    for (int kc = 0; kc < 16; ++kc) a += p[(size_t)kc * 3 * 9216];
    return a;
}
__device__ __forceinline__ void phase_modtab_reduce(Frame& F) {
    for (int i = F.bid * NTHREADS + F.tid; i < 2 * 3 * 9216; i += F.G * NTHREADS) { const int l = i / 27648, r = i - l * 27648, s = r / 9216, n = r - s * 9216; F_MT[i] = modtab_sum(F, l, s, n); }
}
__device__ __forceinline__ void phase_norm(Frame& F, int l, int which, bool from_input, bool skip_ctx, bool lds_tab = false) {
    const float* g = F.in[I_NORMG] + (l * 3 + which) * DM;
    const float* src = F.in[I_X]; const h16* src16 = F_X16L; const long dsrc = from_input ? F.dcin : F_DXC16;
    const int gw = F.bid * 8 + F.wave, NGW = F.G * 8;
    for (int r0 = gw; r0 < TT; r0 += 2 * NGW) {
        f32x4 vv[2][4];
#pragma unroll
        for (int q = 0; q < 2; ++q) { const int r = r0 + q * NGW; bool isctx = false; const long o = r < TT ? xoff(r, dsrc, isctx) : 0; const bool ok = r < TT && !(skip_ctx && isctx);
#pragma unroll
            for (int j = 0; j < 4; ++j) { if (!ok) vv[q][j] = (f32x4){0.f, 0.f, 0.f, 0.f}; else if (from_input) vv[q][j] = *(const f32x4*)(src + o + j * 256 + F.lane * 4);
                else { const u32x2 w = *(const u32x2*)(src16 + o + j * 256 + F.lane * 4); const f32x2_t c0 = unh2(w[0]), c1 = unh2(w[1]); vv[q][j] = (f32x4){c0[0], c0[1], c1[0], c1[1]}; } } }
#pragma unroll
        for (int q = 0; q < 2; ++q) { const int r = r0 + q * NGW; if (r >= TT) continue;
            bool isctx; (void)xoff(r, dsrc, isctx); if (skip_ctx && isctx) continue;
            const int s = isctx ? 2 : r / TB;
            const float* sh = F_MT + ((l * 3 + s) * 9 + which * 3 + 0) * DM; const float* sc = sh + DM; const LAS float* lsh = (const LAS float*)(F.lds + 69632) + s * 2 * DM;
            float ss = 0.f;
#pragma unroll
            for (int j = 0; j < 4; ++j) { const f32x4 v = vv[q][j]; ss += (v[0] * v[0] + v[1] * v[1]) + (v[2] * v[2] + v[3] * v[3]); }
            const float rstd = 1.0f / sqrtf(wave_sum(ss) * (1.f / DM) + NEPS);
#pragma unroll
            for (int j = 0; j < 4; ++j) { const f32x4 v = vv[q][j]; const int c = j * 256 + F.lane * 4; const f32x4 gv = *(const f32x4*)(g + c), shv = lds_tab ? *(const LAS f32x4*)(lsh + c) : *(const f32x4*)(sh + c), scv = lds_tab ? *(const LAS f32x4*)(lsh + DM + c) : *(const f32x4*)(sc + c);
                unsigned w0, w1; { const float a = v[0] * rstd * gv[0] * (1.f + scv[0]) + shv[0], b = v[1] * rstd * gv[1] * (1.f + scv[1]) + shv[1]; w0 = (unsigned)f2bf(a) | ((unsigned)f2bf(b) << 16); }
                { const float a = v[2] * rstd * gv[2] * (1.f + scv[2]) + shv[2], b = v[3] * rstd * gv[3] * (1.f + scv[3]) + shv[3]; w1 = (unsigned)f2bf(a) | ((unsigned)f2bf(b) << 16); }
                *(uint2*)(F_HN + (size_t)r * DM + c) = make_uint2(w0, w1); }
        }
    }
}
__device__ __forceinline__ void phase_conv(Frame& F, int b) {
    const int gw = F.bid * 8 + F.wave, NGW = F.G * 8, lane = F.lane;
    constexpr int NSEG = 224, SEGL = 38;
    for (int it = gw; it < 9 * NSEG; it += NGW) {
        const int cg = it / NSEG, sg = it - cg * NSEG, c0 = cg * 512 + lane * 8;
        const bool ssd = c0 < 1536; const float* cw = ssd ? F.in[I_SCONVW] : F.in[I_GCONVW]; const int cc = ssd ? c0 : c0 - 1536, cn = ssd ? 1536 : 3072;
        float wt[5][8], bias[8];
#pragma unroll
        for (int i = 0; i < 5; ++i) { const f32x4 a = *(const f32x4*)(cw + i * cn + cc), bq = *(const f32x4*)(cw + i * cn + cc + 4);
#pragma unroll
            for (int e = 0; e < 4; ++e) { wt[i][e] = a[e]; wt[i][4 + e] = bq[e]; } }
#pragma unroll
        for (int e = 0; e < 8; ++e) bias[e] = ssd ? F.in[I_SCONVB][cc + e] : 0.f;
        const int norm_kind = (c0 >= 1536 && c0 < 2560) ? 1 : ((c0 >= 2560 && c0 < 3584) ? 2 : 0);
        int t0 = sg * SEGL, t1 = t0 + SEGL; if (t1 > TB) t1 = TB; if (t0 >= TB) continue;
        while (t0 < t1) {
            const int seg_lo = t0 < CTXL ? 0 : CTXL, seg_hi = t0 < CTXL ? CTXL : TB; const int te = t1 < seg_hi ? t1 : seg_hi;
            u32x4 win[4], nw[8];
#pragma unroll
            for (int i = 0; i < 4; ++i) { const int uu = t0 + i - 2; win[i] = (uu >= seg_lo && uu < seg_hi) ? *(const u32x4*)(F_RAW + (size_t)uu * 4608 + c0) : (u32x4){0u, 0u, 0u, 0u}; }
#pragma unroll
            for (int j = 0; j < 8; ++j) { const int uu = t0 + 2 + j; nw[j] = (uu < seg_hi) ? *(const u32x4*)(F_RAW + (size_t)uu * 4608 + c0) : (u32x4){0u, 0u, 0u, 0u}; }
            for (int u = t0; u < te; u += 8) {
                u32x4 cur[8];
#pragma unroll
                for (int j = 0; j < 8; ++j) cur[j] = nw[j];
                if (u + 8 < te) {
#pragma unroll
                    for (int j = 0; j < 8; ++j) { const int uu = u + 10 + j; nw[j] = (uu < seg_hi) ? *(const u32x4*)(F_RAW + (size_t)uu * 4608 + c0) : (u32x4){0u, 0u, 0u, 0u}; } }
#pragma unroll
                for (int j = 0; j < 8; ++j) if (u + j < te) {
                    float acc[8];
#pragma unroll
                    for (int e = 0; e < 8; ++e) acc[e] = bias[e];
#pragma unroll
                    for (int i = 0; i < 5; ++i) { const u32x4 wv = i < 4 ? win[i] : cur[j];
#pragma unroll
                        for (int e = 0; e < 4; ++e) { acc[2 * e] = fmaf(wt[i][2 * e], bflo(wv[e]), acc[2 * e]); acc[2 * e + 1] = fmaf(wt[i][2 * e + 1], bfhi(wv[e]), acc[2 * e + 1]); } }
                    float ss = 0.f;
#pragma unroll
                    for (int e = 0; e < 8; ++e) { acc[e] = silu_f(acc[e]); ss = fmaf(acc[e], acc[e], ss); }
                    if (norm_kind) { ss += __shfl_xor(ss, 1); ss += __shfl_xor(ss, 2); ss += __shfl_xor(ss, 4); ss += __shfl_xor(ss, 8);
                        float sc = 1.0f / sqrtf(ss + NEPS); if (norm_kind == 1) sc *= 0.08838834764831845f;
#pragma unroll
                        for (int e = 0; e < 8; ++e) acc[e] *= sc; }
                    *(u32x4*)(F_CV + (size_t)(u + j) * 4608 + c0) = (u32x4){pk2(acc[0], acc[1]), pk2(acc[2], acc[3]), pk2(acc[4], acc[5]), pk2(acc[6], acc[7])};
                    win[0] = win[1]; win[1] = win[2]; win[2] = win[3]; win[3] = cur[j];
                }
            }
            t0 = te;
        }
    }
    for (int i = F.bid * NTHREADS + F.tid; i < TB * 64; i += F.G * NTHREADS) {
        const int j = i & 63; float v = F_ABS[i];
        if (j < 32) v = softplus_f(v + F.in[I_SDTB][j]);
        else if (j < 48) v = sigmoid_f(v);
        else v = -__expf(F.in[I_GALOG][j - 48]) * softplus_f(v + F.in[I_GDTB][j - 48]);
        F_ABS[i] = v;
    }
}
__device__ __forceinline__ int scan_tok(int dir, int i) { return dir == 0 ? i : (i < CTXL ? CTXL - 1 - i : TB + CTXL - 1 - i); }
__device__ __forceinline__ void ssd_naive(Frame& F, int head) {
    const int p = F.tid >> 3, nq = F.tid & 7, g = head >> 3;
    for (int dir = 0; dir < 2; ++dir) {
        const float a = -__expf(F.in[I_SALOG][dir * 16 + head]);
        float S[16];
#pragma unroll
        for (int j = 0; j < 16; ++j) S[j] = 0.f;
        for (int i = 0; i < TB; ++i) {
            const int u = scan_tok(dir, i); const bf16_t* row = F_CV + (size_t)u * 4608;
            const float x = bf2f(row[head * 64 + p]), dt = F_ABS[u * 64 + dir * 16 + head];
            const u32x4 b0 = *(const u32x4*)(row + 1024 + g * 128 + nq * 16), b1 = *(const u32x4*)(row + 1024 + g * 128 + nq * 16 + 8);
            const u32x4 c0 = *(const u32x4*)(row + 1280 + g * 128 + nq * 16), c1 = *(const u32x4*)(row + 1280 + g * 128 + nq * 16 + 8);
            const float dA = __expf(dt * a), xdt = x * dt; float y = 0.f;
#pragma unroll
            for (int j = 0; j < 4; ++j) {
                S[2 * j] = fmaf(S[2 * j], dA, xdt * bflo(b0[j])); y = fmaf(bflo(c0[j]), S[2 * j], y);
                S[2 * j + 1] = fmaf(S[2 * j + 1], dA, xdt * bfhi(b0[j])); y = fmaf(bfhi(c0[j]), S[2 * j + 1], y);
                S[8 + 2 * j] = fmaf(S[8 + 2 * j], dA, xdt * bflo(b1[j])); y = fmaf(bflo(c1[j]), S[8 + 2 * j], y);
                S[8 + 2 * j + 1] = fmaf(S[8 + 2 * j + 1], dA, xdt * bfhi(b1[j])); y = fmaf(bfhi(c1[j]), S[8 + 2 * j + 1], y); }
            y += __shfl_xor(y, 1); y += __shfl_xor(y, 2); y += __shfl_xor(y, 4);
            if (nq == 0) F_YD[((size_t)dir * TB + u) * 2048 + head * 64 + p] = f2bf(y);
        }
    }
}
__device__ __forceinline__ void gdn_naive(Frame& F, int h) {
    const int e = F.tid >> 2, dq = F.tid & 3;
    for (int dir = 0; dir < 2; ++dir) {
        float S[32];
#pragma unroll
        for (int j = 0; j < 32; ++j) S[j] = 0.f;
        for (int i = 0; i < TB; ++i) {
            const int u = scan_tok(dir, i); const bf16_t* row = F_CV + (size_t)u * 4608;
            const float v = bf2f(row[3584 + h * 128 + e]), beta = F_ABS[u * 64 + 32 + dir * 8 + h], eg = __expf(F_ABS[u * 64 + 48 + dir * 8 + h]);
            u32x4 kk[4], qq[4];
#pragma unroll
            for (int j = 0; j < 4; ++j) { kk[j] = *(const u32x4*)(row + 2560 + h * 128 + dq * 32 + j * 8); qq[j] = *(const u32x4*)(row + 1536 + h * 128 + dq * 32 + j * 8); }
            float ks = 0.f;
#pragma unroll
            for (int j = 0; j < 4; ++j)
#pragma unroll
                for (int w = 0; w < 4; ++w) { ks = fmaf(bflo(kk[j][w]), S[j * 8 + 2 * w], ks); ks = fmaf(bfhi(kk[j][w]), S[j * 8 + 2 * w + 1], ks); }
            ks += __shfl_xor(ks, 1); ks += __shfl_xor(ks, 2);
            const float vn = beta * (v - eg * ks); float o = 0.f;
#pragma unroll
            for (int j = 0; j < 4; ++j)
#pragma unroll
                for (int w = 0; w < 4; ++w) {
                    S[j * 8 + 2 * w] = fmaf(eg, S[j * 8 + 2 * w], bflo(kk[j][w]) * vn); o = fmaf(bflo(qq[j][w]), S[j * 8 + 2 * w], o);
                    S[j * 8 + 2 * w + 1] = fmaf(eg, S[j * 8 + 2 * w + 1], bfhi(kk[j][w]) * vn); o = fmaf(bfhi(qq[j][w]), S[j * 8 + 2 * w + 1], o); }
            o += __shfl_xor(o, 1); o += __shfl_xor(o, 2);
            if (dq == 0) F_YD[((size_t)dir * TB + u) * 2048 + 1024 + h * 128 + e] = f2bf(o);
        }
    }
}

__device__ __forceinline__ int crow32(int r, int hi) { return (r & 3) + 8 * (r >> 2) + 4 * hi; }
__device__ __forceinline__ s16x4 tr_read_b64(unsigned addr) { s16x4 r; asm volatile("ds_read_b64_tr_b16 %0, %1" : "=&v"(r) : "v"(addr) : "memory"); return r; }
#define LGKM_WAIT0() do { asm volatile("s_waitcnt lgkmcnt(0)" ::: "memory"); __builtin_amdgcn_sched_barrier(0); } while (0)
#define PK8(L, H) (bf16x8){L[0], L[1], L[2], L[3], H[0], H[1], H[2], H[3]}
__device__ __forceinline__ void ssd_prep_item(Frame& F, int g, int c) {
    const int w = F.wave, r32 = F.lane & 31, h = F.lane >> 5, jt = w >> 1, it0 = (w & 1) * 2;
    const bf16_t* cv = F_CV + (size_t)(c * 128) * 4608; const bf16_t* Bm = cv + 1024 + g * 128; const bf16_t* Cm = cv + 1280 + g * 128;
    f32x16 acc0 = {}, acc1 = {};
#pragma unroll
    for (int s8 = 0; s8 < 8; ++s8) {
        const bf16x8 a = *(const bf16x8*)(Bm + (size_t)(32 * jt + r32) * 4608 + 16 * s8 + 8 * h);
        const bf16x8 b0 = *(const bf16x8*)(Cm + (size_t)(32 * it0 + r32) * 4608 + 16 * s8 + 8 * h);
        const bf16x8 b1 = *(const bf16x8*)(Cm + (size_t)(32 * it0 + 32 + r32) * 4608 + 16 * s8 + 8 * h);
        acc0 = __builtin_amdgcn_mfma_f32_32x32x16_bf16(a, b0, acc0, 0, 0, 0); acc1 = __builtin_amdgcn_mfma_f32_32x32x16_bf16(a, b1, acc1, 0, 0, 0);
    }
    bf16_t* cb = F_CB + (size_t)(g * 66 + c) * 128 * 128;
#pragma unroll
    for (int q = 0; q < 4; ++q) { const int j0 = 32 * jt + 8 * q + 4 * h;
        *(uint2*)(cb + (32 * it0 + r32) * 128 + j0) = make_uint2(pk2(acc0[4 * q], acc0[4 * q + 1]), pk2(acc0[4 * q + 2], acc0[4 * q + 3]));
        *(uint2*)(cb + (32 * it0 + 32 + r32) * 128 + j0) = make_uint2(pk2(acc1[4 * q], acc1[4 * q + 1]), pk2(acc1[4 * q + 2], acc1[4 * q + 3])); }
}
constexpr int SSD_RX = 144, SSD_RB = 272, SSD_RM = 272, SSD_RS = 272, SSD_RC = 272;
constexpr int SSD_XS = 0, SSD_BW = SSD_XS + 128 * SSD_RX, SSD_MS = SSD_BW + 128 * SSD_RB, SSD_CS = SSD_MS + 128 * SSD_RM, SSD_SS = SSD_CS + 128 * SSD_RC, SSD_VEC = SSD_SS + 64 * SSD_RS, SSD_LDS_END = SSD_VEC + 2560;
static_assert(SSD_LDS_END <= 147456 - 512, "SSD LDS");
__device__ __forceinline__ int ssd_chunk(int dir, int s) { return dir == 0 ? s : (s < 2 ? 1 - s : 67 - s); }
__device__ __forceinline__ void ssd_scan(Frame& F, int head, int dir, bf16_t* ydst, int yld, int ycol0) {
    const int tid = F.tid, lane = F.lane, w = F.wave, r32 = lane & 31, h = lane >> 5, g = head >> 3;
    LAS unsigned char* L = F.lds;
    LAS float* vac = (LAS float*)(L + SSD_VEC); LAS float* veac = vac + 128; LAS float* vw = vac + 256; LAS float* vdt = vac + 384; LAS float* vsc = vac + 512;
    const float a = -__expf(F.in[I_SALOG][dir * 16 + head]);
    const int it = w >> 1, pt = w & 1;
    const int srow = tid >> 2, sq = tid & 3;
    const unsigned trq = (unsigned)(8 * h + ((lane & 15) >> 2)), trc = (unsigned)((16 * ((lane >> 4) & 1) + 4 * (lane & 3)) * 2);
    const unsigned vbX = (unsigned)(uintptr_t)(F.ldsg + SSD_XS) + trq * SSD_RX + (unsigned)(64 * pt) + trc;
    const unsigned vbB = (unsigned)(uintptr_t)(F.ldsg + SSD_BW) + trq * SSD_RB + (unsigned)(64 * it) + trc;
    f32x16 accS = {};
    for (int i = tid; i < 64 * SSD_RS / 4; i += NTHREADS) ((LAS unsigned*)(L + SSD_SS))[i] = 0u;
    u32x4 px[2], pb[4], pcb[4], pcc[4]; float pdt0 = 0.f, pdt1 = 0.f;
#define SSD_ISSUE_MAIN(cc) do { const bf16_t* rowp = F_CV + (size_t)((cc) * 128 + srow) * 4608; \
        px[0] = *(const u32x4*)(rowp + head * 64 + sq * 16); px[1] = *(const u32x4*)(rowp + head * 64 + sq * 16 + 8); \
        _Pragma("unroll") for (int k = 0; k < 4; ++k) { pb[k] = *(const u32x4*)(rowp + 1024 + g * 128 + sq * 32 + 8 * k); pcc[k] = *(const u32x4*)(rowp + 1280 + g * 128 + sq * 32 + 8 * k); \
            pcb[k] = *(const u32x4*)(F_CB + ((size_t)(g * 66 + (cc)) * 128 + srow) * 128 + sq * 32 + 8 * k); } \
        pdt0 = F_ABS[(size_t)((cc) * 128 + 2 * lane) * 64 + dir * 16 + head]; pdt1 = F_ABS[(size_t)((cc) * 128 + 2 * lane + 1) * 64 + dir * 16 + head]; } while (0)
    f32x16 yprev = {}; int cprev = 0;
#define SSD_STORE_Y() do { bf16_t* yp = ydst + ((size_t)dir * TB + cprev * 128 + 32 * it + r32) * yld + ycol0 + head * 64 + 32 * pt + 4 * h; \
        _Pragma("unroll") for (int q_ = 0; q_ < 4; ++q_) *(u32x2*)(yp + 8 * q_) = (u32x2){pk2(yprev[4 * q_], yprev[4 * q_ + 1]), pk2(yprev[4 * q_ + 2], yprev[4 * q_ + 3])}; } while (0)
    { const int c0 = ssd_chunk(dir, 0); SSD_ISSUE_MAIN(c0); }
    __syncthreads();
    for (int s = 0; s < 66; ++s) {
        const int c = ssd_chunk(dir, s);
        {
            const float d0 = pdt0 * a, d1 = pdt1 * a, ps = d0 + d1; float inc = ps;
            if (dir == 0) {
#pragma unroll
                for (int o = 1; o < 64; o <<= 1) { const float t = __shfl_up(inc, o); if (lane >= o) inc += t; }
            } else {
#pragma unroll
                for (int o = 1; o < 64; o <<= 1) { const float t = __shfl_down(inc, o); if (lane + o < 64) inc += t; }
            }
            const float tot = __shfl(inc, dir == 0 ? 63 : 0);
            const float ac0 = dir == 0 ? inc - d1 : inc, ac1 = dir == 0 ? inc : inc - d0;
            vac[2 * lane] = ac0; vac[2 * lane + 1] = ac1; veac[2 * lane] = __expf(ac0); veac[2 * lane + 1] = __expf(ac1);
            vw[2 * lane] = __expf(tot - ac0) * pdt0; vw[2 * lane + 1] = __expf(tot - ac1) * pdt1; vdt[2 * lane] = pdt0; vdt[2 * lane + 1] = pdt1;
            if (lane == 0) vsc[0] = __expf(tot);
            asm volatile("s_waitcnt lgkmcnt(0)" ::: "memory");
        }
        {
            const float wr_ = vw[srow], acr = vac[srow];
            *(LAS u32x4*)(L + SSD_XS + srow * SSD_RX + sq * 32) = px[0]; *(LAS u32x4*)(L + SSD_XS + srow * SSD_RX + sq * 32 + 16) = px[1];
#pragma unroll
            for (int k = 0; k < 4; ++k) {
                u32x4 o;
#pragma unroll
                for (int e = 0; e < 4; ++e) o[e] = pk2(bflo(pb[k][e]) * wr_, bfhi(pb[k][e]) * wr_);
                *(LAS u32x4*)(L + SSD_BW + srow * SSD_RB + sq * 64 + k * 16) = o; *(LAS u32x4*)(L + SSD_CS + srow * SSD_RC + sq * 64 + k * 16) = pcc[k];
                const int j0 = sq * 32 + 8 * k;
                const f32x4 aj0 = *(const LAS f32x4*)(vac + j0), aj1 = *(const LAS f32x4*)(vac + j0 + 4), dj0 = *(const LAS f32x4*)(vdt + j0), dj1 = *(const LAS f32x4*)(vdt + j0 + 4);
                float m[8];
#pragma unroll
                for (int e = 0; e < 8; ++e) { const int j = j0 + e; const bool keep = dir == 0 ? (j <= srow) : (j >= srow);
                    const float aj = e < 4 ? aj0[e & 3] : aj1[e & 3], dj = e < 4 ? dj0[e & 3] : dj1[e & 3]; const unsigned wv = pcb[k][e >> 1]; const float cbv = (e & 1) ? bfhi(wv) : bflo(wv);
                    m[e] = keep ? cbv * __expf(acr - aj) * dj : 0.f;
#if DEBUG_SSD
                    if (!(m[e] == m[e]) || fabsf(m[e]) > 1e30f) atomicOr((unsigned*)(F.ws + WS_CTL) + 203, 16u);
                    if (!(cbv == cbv) || fabsf(cbv) > 1e30f) atomicOr((unsigned*)(F.ws + WS_CTL) + 203, 32u);
                    if (keep && (acr - aj) > 1e-3f) atomicOr((unsigned*)(F.ws + WS_CTL) + 203, 64u);
                    if (!(dj == dj) || fabsf(dj) > 1e30f) atomicOr((unsigned*)(F.ws + WS_CTL) + 203, 128u);
#endif
                    }
                u32x4 mo; mo[0] = pk2(m[0], m[1]); mo[1] = pk2(m[2], m[3]); mo[2] = pk2(m[4], m[5]); mo[3] = pk2(m[6], m[7]);
                *(LAS u32x4*)(L + SSD_MS + srow * SSD_RM + sq * 64 + k * 16) = mo;
            }
        }
        if (s + 1 < 66) { const int cn = ssd_chunk(dir, s + 1); SSD_ISSUE_MAIN(cn); }
        if (s > 0) { SSD_STORE_Y(); }
        __syncthreads();
        f32x16 acc = {};
#pragma unroll
        for (int k = 0; k < 8; ++k) { const bf16x8 bs = *(const LAS bf16x8*)(L + SSD_SS + (32 * pt + r32) * SSD_RS + (16 * k + 8 * h) * 2); const bf16x8 cf = *(const LAS bf16x8*)(L + SSD_CS + (32 * it + r32) * SSD_RC + (16 * k + 8 * h) * 2);
            acc = __builtin_amdgcn_mfma_f32_32x32x16_bf16(bs, cf, acc, 0, 0, 0); }
#if DEBUG_SSD
        { bool bn = false; for (int r = 0; r < 16; ++r) bn |= !(acc[r] == acc[r]) || fabsf(acc[r]) > 1e30f; if (bn) atomicOr((unsigned*)(F.ws + WS_CTL) + 203, 2u);
          bool vn = false; for (int r = 0; r < 2; ++r) { const float t0 = vac[lane + 64 * r], t1 = veac[lane + 64 * r], t2 = vw[lane + 64 * r]; vn |= !(t0 == t0) || !(t1 == t1) || !(t2 == t2) || fabsf(t2) > 1e30f; } if (vn) atomicOr((unsigned*)(F.ws + WS_CTL) + 203, 1u); }
#endif
        { const float ea = veac[32 * it + r32];
#pragma unroll
          for (int r = 0; r < 16; ++r) acc[r] *= ea; }
        { const float el = vsc[0];
#pragma unroll
          for (int r = 0; r < 16; ++r) accS[r] *= el; }
        { const int klo = dir == 0 ? 0 : 2 * it, khi = dir == 0 ? 2 * it + 1 : 7;
#pragma unroll
          for (int half = 0; half < 2; ++half) {
            s16x4 xl[4], xh[4], bl[4], bh[4];
#pragma unroll
            for (int k = 0; k < 4; ++k) { const int kk = 4 * half + k; xl[k] = tr_read_b64(vbX + (unsigned)((16 * kk) * SSD_RX)); xh[k] = tr_read_b64(vbX + (unsigned)((16 * kk + 4) * SSD_RX));
                bl[k] = tr_read_b64(vbB + (unsigned)((16 * kk) * SSD_RB)); bh[k] = tr_read_b64(vbB + (unsigned)((16 * kk + 4) * SSD_RB)); }
            LGKM_WAIT0();
#pragma unroll
            for (int k = 0; k < 4; ++k) { const int kk = 4 * half + k;
                if (kk >= klo && kk <= khi) { const bf16x8 am = *(const LAS bf16x8*)(L + SSD_MS + (32 * it + r32) * SSD_RM + (16 * kk + 8 * h) * 2);
                    acc = __builtin_amdgcn_mfma_f32_32x32x16_bf16(PK8(xl[k], xh[k]), am, acc, 0, 0, 0); }
                accS = __builtin_amdgcn_mfma_f32_32x32x16_bf16(PK8(bl[k], bh[k]), PK8(xl[k], xh[k]), accS, 0, 0, 0); }
          } }
#if DEBUG_SSD
        { bool bn = false, sn = false; for (int r = 0; r < 16; ++r) { bn |= !(acc[r] == acc[r]) || fabsf(acc[r]) > 1e30f; sn |= !(accS[r] == accS[r]) || fabsf(accS[r]) > 1e30f; }
          if (bn) atomicOr((unsigned*)(F.ws + WS_CTL) + 203, 4u); if (sn) atomicOr((unsigned*)(F.ws + WS_CTL) + 203, 8u); }
#endif
        yprev = acc; cprev = c;
        __syncthreads();
#pragma unroll
        for (int q = 0; q < 4; ++q) *(LAS u32x2*)(L + SSD_SS + (32 * pt + r32) * SSD_RS + (32 * it + 8 * q + 4 * h) * 2) = (u32x2){pk2(accS[4 * q], accS[4 * q + 1]), pk2(accS[4 * q + 2], accS[4 * q + 3])};
    }
    SSD_STORE_Y();
    __syncthreads();
#undef SSD_ISSUE_MAIN
#undef SSD_STORE_Y
}


template <int MODE>
__device__ __forceinline__ void ssd_items(Frame& F, int first, int stride, bf16_t* ydst, int yld, int ycol0) {
    LAUNDER_PTR(bf16_t*, 1, ydst, ydst);
    const int tid = F.tid, lane = F.lane, w = F.wave, r32 = lane & 31, h = lane >> 5;
    LAS unsigned char* L = F.lds;
    LAS float* vac = (LAS float*)(L + SSD_VEC); LAS float* veac = vac + 128; LAS float* vw = vac + 256; LAS float* vdt = vac + 384; LAS float* vsc = vac + 512;
    const int it = w >> 1, pt = w & 1, srow = tid >> 2, sq = tid & 3;
    const int mrow = 16 * w + (lane & 15), mcb = lane >> 4;
    const unsigned trq = (unsigned)(8 * h + ((lane & 15) >> 2)), trc = (unsigned)((16 * ((lane >> 4) & 1) + 4 * (lane & 3)) * 2);
    const unsigned vbX = (unsigned)(uintptr_t)(F.ldsg + SSD_XS) + trq * SSD_RX + (unsigned)(64 * pt) + trc;
    const unsigned vbB = (unsigned)(uintptr_t)(F.ldsg + SSD_BW) + trq * SSD_RB + (unsigned)(64 * it) + trc;
    u32x4 px[2], pb[4], pcb[4], pcc[4], psi[2]; float pdt0 = 0.f, pdt1 = 0.f;
#define SSDI_ISSUE(i_) do { const int gs_ = xcd + 8 * ((i_) >> 3), ss_ = gs_ >> 2, dr_ = (gs_ >> 1) & 1, gg_ = gs_ & 1, hd_ = gg_ * 8 + ((i_) & 7), ch_ = hd_ * 2 + dr_, cc_ = ssd_chunk(dr_, ss_); \
        const bf16_t* rowp = F_CV + (size_t)(cc_ * 128 + srow) * 4608; \
        px[0] = *(const u32x4*)(rowp + hd_ * 64 + sq * 16); px[1] = *(const u32x4*)(rowp + hd_ * 64 + sq * 16 + 8); \
        _Pragma("unroll") for (int k = 0; k < 4; ++k) { \
            if (MODE == 0) pb[k] = *(const u32x4*)(rowp + 1024 + gg_ * 128 + sq * 32 + 8 * k); \
            else { pcc[k] = *(const u32x4*)(rowp + 1280 + gg_ * 128 + sq * 32 + 8 * k); pcb[k] = *(const u32x4*)(F_CB + ((size_t)(gg_ * 66 + cc_) * 128 + mrow) * 128 + 32 * k + 8 * mcb); } } \
        if (MODE == 1) { if (ss_ > 0) { const bf16_t* sl = F_SST + ((size_t)ch_ * 66 + ssd_chunk(dr_, ss_ - 1)) * 8192 + (size_t)(tid >> 3) * 128 + (tid & 7) * 16; psi[0] = *(const u32x4*)sl; psi[1] = *(const u32x4*)(sl + 8); } \
                         else { psi[0] = (u32x4){0u, 0u, 0u, 0u}; psi[1] = psi[0]; } } \
        pdt0 = F_ABS[(size_t)(cc_ * 128 + 2 * lane) * 64 + dr_ * 16 + hd_]; pdt1 = F_ABS[(size_t)(cc_ * 128 + 2 * lane + 1) * 64 + dr_ * 16 + hd_]; } while (0)
    const int xcd = first & 7, nq = stride >> 3;
    if ((first >> 3) < 264) { SSDI_ISSUE(first >> 3); }
    for (int i = first >> 3; i < 264; i += nq) {
        const int gs = xcd + 8 * (i >> 3), spos = gs >> 2, dir = (gs >> 1) & 1, head = (gs & 1) * 8 + (i & 7), chain = head * 2 + dir, c = ssd_chunk(dir, spos);
        const float a = -__expf(F.in[I_SALOG][dir * 16 + head]);
        {
            const float d0 = pdt0 * a, d1 = pdt1 * a, ps = d0 + d1; float inc = ps;
            if (dir == 0) {
#pragma unroll
                for (int o = 1; o < 64; o <<= 1) { const float t = __shfl_up(inc, o); if (lane >= o) inc += t; }
            } else {
#pragma unroll
                for (int o = 1; o < 64; o <<= 1) { const float t = __shfl_down(inc, o); if (lane + o < 64) inc += t; }
            }
            const float tot = __shfl(inc, dir == 0 ? 63 : 0);
            const float ac0 = dir == 0 ? inc - d1 : inc, ac1 = dir == 0 ? inc : inc - d0;
            if (MODE == 0) { vw[2 * lane] = __expf(tot - ac0) * pdt0; vw[2 * lane + 1] = __expf(tot - ac1) * pdt1; if (lane == 0) vsc[0] = __expf(tot); }
            else { vac[2 * lane] = ac0 * 1.4426950408889634f; vac[2 * lane + 1] = ac1 * 1.4426950408889634f; veac[2 * lane] = __expf(ac0); veac[2 * lane + 1] = __expf(ac1); vdt[2 * lane] = pdt0; vdt[2 * lane + 1] = pdt1; }
            asm volatile("s_waitcnt lgkmcnt(0)" ::: "memory");
        }
        {
            *(LAS u32x4*)(L + SSD_XS + srow * SSD_RX + sq * 32) = px[0]; *(LAS u32x4*)(L + SSD_XS + srow * SSD_RX + sq * 32 + 16) = px[1];
            if (MODE == 0) { const float wr_ = vw[srow];
#pragma unroll
                for (int k = 0; k < 4; ++k) { u32x4 o;
#pragma unroll
                    for (int e = 0; e < 4; ++e) o[e] = pk2(bflo(pb[k][e]) * wr_, bfhi(pb[k][e]) * wr_);
                    *(LAS u32x4*)(L + SSD_BW + srow * SSD_RB + sq * 64 + k * 16) = o; }
            } else {
                *(LAS u32x4*)(L + SSD_SS + (tid >> 3) * SSD_RS + (tid & 7) * 32) = psi[0]; *(LAS u32x4*)(L + SSD_SS + (tid >> 3) * SSD_RS + (tid & 7) * 32 + 16) = psi[1];
#pragma unroll
                for (int k = 0; k < 4; ++k) *(LAS u32x4*)(L + SSD_CS + srow * SSD_RC + sq * 64 + k * 16) = pcc[k];
                const float acr = vac[mrow]; const int dq_ = w >> 1;
#pragma unroll
                for (int k = 0; k < 4; ++k) {
                    const bool need = dir == 0 ? (k <= dq_) : (k >= dq_);
                    if (need) {
                        const int j0 = 32 * k + 8 * mcb;
                        const f32x4 aj0 = *(const LAS f32x4*)(vac + j0), aj1 = *(const LAS f32x4*)(vac + j0 + 4), dj0 = *(const LAS f32x4*)(vdt + j0), dj1 = *(const LAS f32x4*)(vdt + j0 + 4);
                        float m[8];
#pragma unroll
                        for (int e = 0; e < 8; ++e) { const int j = j0 + e; const bool keep = dir == 0 ? (j <= mrow) : (j >= mrow);
                            const float aj = e < 4 ? aj0[e & 3] : aj1[e & 3], dj = e < 4 ? dj0[e & 3] : dj1[e & 3]; const unsigned wv = pcb[k][e >> 1]; const float cbv = (e & 1) ? bfhi(wv) : bflo(wv);
                            m[e] = keep ? cbv * __builtin_amdgcn_exp2f(acr - aj) * dj : 0.f; }
                        *(LAS u32x4*)(L + SSD_MS + mrow * SSD_RM + j0 * 2) = (u32x4){pk2(m[0], m[1]), pk2(m[2], m[3]), pk2(m[4], m[5]), pk2(m[6], m[7])};
                    }
                }
            }
        }
        if (i + nq < 264) { SSDI_ISSUE(i + nq); }
        __syncthreads();
        if (MODE == 0) {
            f32x16 accS = {};
#pragma unroll
            for (int half = 0; half < 2; ++half) {
                s16x4 xl[4], xh[4], bl[4], bh[4];
#pragma unroll
                for (int k = 0; k < 4; ++k) { const int kk = 4 * half + k; xl[k] = tr_read_b64(vbX + (unsigned)((16 * kk) * SSD_RX)); xh[k] = tr_read_b64(vbX + (unsigned)((16 * kk + 4) * SSD_RX));
                    bl[k] = tr_read_b64(vbB + (unsigned)((16 * kk) * SSD_RB)); bh[k] = tr_read_b64(vbB + (unsigned)((16 * kk + 4) * SSD_RB)); }
                LGKM_WAIT0();
#pragma unroll
                for (int k = 0; k < 4; ++k) accS = __builtin_amdgcn_mfma_f32_32x32x16_bf16(PK8(bl[k], bh[k]), PK8(xl[k], xh[k]), accS, 0, 0, 0);
            }
            bf16_t* slot = F_SST + ((size_t)chain * 66 + c) * 8192 + (size_t)(32 * pt + r32) * 128 + 32 * it + 4 * h;
#pragma unroll
            for (int q = 0; q < 4; ++q) *(u32x2*)(slot + 8 * q) = (u32x2){pk2(accS[4 * q], accS[4 * q + 1]), pk2(accS[4 * q + 2], accS[4 * q + 3])};
            if (tid == 0) F_SEL[chain * 66 + c] = vsc[0];
        } else {
            f32x16 acc = {};
#pragma unroll
            for (int k = 0; k < 8; ++k) { const bf16x8 bs = *(const LAS bf16x8*)(L + SSD_SS + (32 * pt + r32) * SSD_RS + (16 * k + 8 * h) * 2); const bf16x8 cf = *(const LAS bf16x8*)(L + SSD_CS + (32 * it + r32) * SSD_RC + (16 * k + 8 * h) * 2);
                acc = __builtin_amdgcn_mfma_f32_32x32x16_bf16(bs, cf, acc, 0, 0, 0); }
            { const float ea = veac[32 * it + r32];
#pragma unroll
              for (int r = 0; r < 16; ++r) acc[r] *= ea; }
            { const int klo = dir == 0 ? 0 : 2 * it, khi = dir == 0 ? 2 * it + 1 : 7;
#pragma unroll
              for (int half = 0; half < 2; ++half) {
                s16x4 xl[4], xh[4];
#pragma unroll
                for (int k = 0; k < 4; ++k) { const int kk = 4 * half + k; xl[k] = tr_read_b64(vbX + (unsigned)((16 * kk) * SSD_RX)); xh[k] = tr_read_b64(vbX + (unsigned)((16 * kk + 4) * SSD_RX)); }
                LGKM_WAIT0();
#pragma unroll
                for (int k = 0; k < 4; ++k) { const int kk = 4 * half + k;
                    if (kk >= klo && kk <= khi) { const bf16x8 am = *(const LAS bf16x8*)(L + SSD_MS + (32 * it + r32) * SSD_RM + (16 * kk + 8 * h) * 2);
                        acc = __builtin_amdgcn_mfma_f32_32x32x16_bf16(PK8(xl[k], xh[k]), am, acc, 0, 0, 0); } }
              } }
            bf16_t* yp = ydst + ((size_t)dir * TB + c * 128 + 32 * it + r32) * yld + ycol0 + head * 64 + 32 * pt + 4 * h;
#pragma unroll
            for (int q = 0; q < 4; ++q) *(u32x2*)(yp + 8 * q) = (u32x2){pk2(acc[4 * q], acc[4 * q + 1]), pk2(acc[4 * q + 2], acc[4 * q + 3])};
        }
        __syncthreads();
    }
#undef SSDI_ISSUE
}
__device__ __forceinline__ void ssd_state_scan(Frame& F, int chain) {
    const int tid = F.tid, dir = chain & 1;
    float S[16];
#pragma unroll
    for (int i = 0; i < 16; ++i) S[i] = 0.f;
    bf16_t* base = F_SST + (size_t)chain * 66 * 8192 + tid * 16;
    u32x4 r0[6], r1[6]; float rel[6];
#pragma unroll
    for (int j = 0; j < 6; ++j) { const int cn = ssd_chunk(dir, j); r0[j] = *(const u32x4*)(base + (size_t)cn * 8192); r1[j] = *(const u32x4*)(base + (size_t)cn * 8192 + 8); rel[j] = F_SEL[chain * 66 + cn]; }
    for (int s6 = 0; s6 < 66; s6 += 6) {
#pragma unroll
        for (int j = 0; j < 6; ++j) {
            const int s = s6 + j, c = ssd_chunk(dir, s); const u32x4 l0 = r0[j], l1 = r1[j]; const float el = rel[j];
            if (s + 6 < 66) { const int cn = ssd_chunk(dir, s + 6); r0[j] = *(const u32x4*)(base + (size_t)cn * 8192); r1[j] = *(const u32x4*)(base + (size_t)cn * 8192 + 8); rel[j] = F_SEL[chain * 66 + cn]; }
#pragma unroll
            for (int e = 0; e < 4; ++e) { S[2 * e] = fmaf(el, S[2 * e], bflo(l0[e])); S[2 * e + 1] = fmaf(el, S[2 * e + 1], bfhi(l0[e])); S[8 + 2 * e] = fmaf(el, S[8 + 2 * e], bflo(l1[e])); S[8 + 2 * e + 1] = fmaf(el, S[8 + 2 * e + 1], bfhi(l1[e])); }
            *(u32x4*)(base + (size_t)c * 8192) = (u32x4){pk2(S[0], S[1]), pk2(S[2], S[3]), pk2(S[4], S[5]), pk2(S[6], S[7])};
            *(u32x4*)(base + (size_t)c * 8192 + 8) = (u32x4){pk2(S[8], S[9]), pk2(S[10], S[11]), pk2(S[12], S[13]), pk2(S[14], S[15])};
        }
    }
}
__device__ __forceinline__ int gdn_chunk(int dir, int s) { return dir == 0 ? s : (s < 4 ? 3 - s : 135 - s); }
#define GT_PTR(h_, dir_, c_) (F.ws + AR_GT + ((size_t)((h_) * 2 + (dir_)) * 132 + (c_)) * GT_STRIDE)
__device__ __forceinline__ void gdn_prep_round(Frame& F, int item0, int nitems) {
    LAS float* Aw = (LAS float*)F.lds;
    const int w = F.wave, lane = F.lane, r32 = lane & 31, hh = lane >> 5;
    const int kind = w >> 2, it = (w >> 1) & 1, jt = w & 1;
    bf16x8 fa[8], fb[8];
#define GDNP_LOAD(li_) do { const int item_ = item0 + (li_), h_ = item_ / 132, c_ = item_ - h_ * 132; \
        const bf16_t* rowsrc = F_CV + (size_t)(c_ * 64 + 32 * it + r32) * 4608 + (kind ? 1536 : 2560) + h_ * 128 + 8 * hh; \
        const bf16_t* colsrc = F_CV + (size_t)(c_ * 64 + 32 * jt + r32) * 4608 + 2560 + h_ * 128 + 8 * hh; \
        _Pragma("unroll") for (int s8 = 0; s8 < 8; ++s8) { fa[s8] = *(const bf16x8*)(rowsrc + 16 * s8); fb[s8] = *(const bf16x8*)(colsrc + 16 * s8); } } while (0)
    GDNP_LOAD(0);
#pragma unroll 1
    for (int li = 0; li < nitems; ++li) {
        const int item = item0 + li;
        const int h = item / 132, c = item - h * 132;
        const float* ab = F_ABS + (size_t)(c * 64 + lane) * 64;
        const float gf = ab[48 + h], gb = ab[56 + h], btf = ab[32 + h], btb = ab[40 + h];
        float gcf = gf, gcb = gb;
#pragma unroll
        for (int o = 1; o < 64; o <<= 1) { const float t = __shfl_up(gcf, o); if (lane >= o) gcf += t; const float t2 = __shfl_down(gcb, o); if (lane + o < 64) gcb += t2; }
        f32x16 G = {};
#pragma unroll
        for (int s8 = 0; s8 < 8; ++s8) G = __builtin_amdgcn_mfma_f32_32x32x16_bf16(fa[s8], fb[s8], G, 0, 0, 0);
        if (li + 1 < nitems) GDNP_LOAD(li + 1);
        LAS float* vt = (LAS float*)(F.lds + 131072) + w * 256;
        vt[lane] = gcf; vt[64 + lane] = gcb; vt[128 + lane] = btf; vt[192 + lane] = btb;
        asm volatile("s_waitcnt lgkmcnt(0)" ::: "memory");
        const int j = 32 * jt + r32; const float gcf_j = vt[j], gcb_j = vt[64 + j];
        bf16_t* qkf = (bf16_t*)(GT_PTR(h, 0, c) + 8192); bf16_t* qkb = (bf16_t*)(GT_PTR(h, 1, c) + 8192);
        float gfi[16], gbi[16], bfi[16], bbi[16];
#pragma unroll
        for (int r = 0; r < 16; ++r) { const int i = 32 * it + crow32(r, hh); gfi[r] = vt[i]; gbi[r] = vt[64 + i]; bfi[r] = vt[128 + i]; bbi[r] = vt[192 + i]; }
#pragma unroll
        for (int r = 0; r < 16; ++r) {
            const int i = 32 * it + crow32(r, hh); const float g = G[r];
            const float ef = __expf(fminf(gfi[r] - gcf_j, 0.f)), eb = __expf(fminf(gbi[r] - gcb_j, 0.f));
            if (kind == 0) {
                Aw[((li * 2 + 0) * 64 + i) * 64 + j] = (j < i) ? bfi[r] * g * ef : 0.f;
                Aw[((li * 2 + 1) * 64 + (63 - i)) * 64 + (63 - j)] = (j > i) ? bbi[r] * g * eb : 0.f;
            } else {
                qkf[i * 64 + j] = f2bf((j <= i) ? g * ef : 0.f);
                qkb[(63 - i) * 64 + (63 - j)] = f2bf((j >= i) ? g * eb : 0.f);
            }
        }
    }
#undef GDNP_LOAD
    __syncthreads();
    {
        const int li = w >> 1, dir = w & 1, item = item0 + li;
        if (li < nitems) {
            const int h = item / 132, c = item - h * 132; const int tok = dir ? 63 - lane : lane;
            const float* ab = F_ABS + (size_t)(c * 64 + tok) * 64; const float g = ab[48 + dir * 8 + h], bt = ab[32 + dir * 8 + h];
            float gc = g;
#pragma unroll
            for (int o = 1; o < 64; o <<= 1) { const float t = __shfl_up(gc, o); if (lane >= o) gc += t; }
            const float gl = __shfl(gc, 63);
            float* vec = (float*)(GT_PTR(h, dir, c) + 16384);
            vec[lane] = __expf(gc); vec[64 + lane] = __expf(gl - gc); if (lane == 0) vec[128] = __expf(gl);
            const LAS float* A = Aw + (size_t)w * 64 * 64;
            bf16_t* tb = (bf16_t*)GT_PTR(h, dir, c);
            float x[64];
#pragma unroll
            for (int i = 0; i < 64; ++i) {
                int li_ = lane; asm volatile("" : "+v"(li_));
                float xi = (li_ == i) ? 1.f : 0.f, xa = 0.f, xb = 0.f, xc = 0.f;
#pragma unroll
                for (int j4 = 0; j4 < (i + 3) / 4; ++j4) { const f32x4 a4 = *(const LAS f32x4*)(A + i * 64 + 4 * j4);
                    if (4 * j4 + 0 < i) xi = fmaf(-a4[0], x[4 * j4 + 0], xi); if (4 * j4 + 1 < i) xa = fmaf(-a4[1], x[4 * j4 + 1], xa);
                    if (4 * j4 + 2 < i) xb = fmaf(-a4[2], x[4 * j4 + 2], xb); if (4 * j4 + 3 < i) xc = fmaf(-a4[3], x[4 * j4 + 3], xc); }
                xi = (xi + xa) + (xb + xc);
                x[i] = xi;
                tb[i * 64 + lane] = f2bf(xi * bt);
                asm volatile("" ::: "memory");
            }
        }
    }
    __syncthreads();
}

__device__ __forceinline__ void gdn_combine(Frame& F, int chain) {
    const int tid = F.tid, w = F.wave, r32 = F.lane & 31, hh = F.lane >> 5;
    const float* BT = F_GBT + (size_t)chain * 3 * 16384; const bf16_t* PH = F_GPH + (size_t)chain * 2 * 16384; float* SS = F_GSS + (size_t)chain * 3 * 16384;
    for (int i = tid; i < 4096; i += NTHREADS) ((f32x4*)SS)[i] = ((const f32x4*)BT)[i];
    __syncthreads();
    for (int g = 1; g < 3; ++g) {
        const float* So = SS + (size_t)(g - 1) * 16384; const bf16_t* Ph = PH + (size_t)(g - 1) * 16384; const float* Bg = BT + (size_t)g * 16384; float* Sn = SS + (size_t)g * 16384;
        const int dtile = w >> 1;
#pragma unroll
        for (int et = 0; et < 2; ++et) { const int etile = (w & 1) * 2 + et; f32x16 acc;
#pragma unroll
            for (int qd = 0; qd < 4; ++qd) { const f32x4 b4 = *(const f32x4*)(Bg + (size_t)(32 * etile + r32) * 128 + 32 * dtile + 8 * qd + 4 * hh); acc[4 * qd] = b4[0]; acc[4 * qd + 1] = b4[1]; acc[4 * qd + 2] = b4[2]; acc[4 * qd + 3] = b4[3]; }
#pragma unroll
            for (int k = 0; k < 8; ++k) { const bf16x8 a = *(const bf16x8*)(Ph + (size_t)(32 * dtile + r32) * 128 + 16 * k + 8 * hh);
                const f32x4 s0 = *(const f32x4*)(So + (size_t)(32 * etile + r32) * 128 + 16 * k + 8 * hh), s1 = *(const f32x4*)(So + (size_t)(32 * etile + r32) * 128 + 16 * k + 8 * hh + 4);
                u32x4 bw = {pk2(s0[0], s0[1]), pk2(s0[2], s0[3]), pk2(s1[0], s1[1]), pk2(s1[2], s1[3])};
                acc = __builtin_amdgcn_mfma_f32_32x32x16_bf16(a, *reinterpret_cast<bf16x8*>(&bw), acc, 0, 0, 0); }
#pragma unroll
            for (int qd = 0; qd < 4; ++qd) *(f32x4*)(Sn + (size_t)(32 * etile + r32) * 128 + 32 * dtile + 8 * qd + 4 * hh) = (f32x4){acc[4 * qd], acc[4 * qd + 1], acc[4 * qd + 2], acc[4 * qd + 3]};
        }
        __syncthreads();
    }
}
constexpr int GL_K = 0, GL_Q = GL_K + 64 * 272, GL_V = GL_Q + 64 * 272, GL_TB = GL_V + 64 * 144, GL_QK = GL_TB + 64 * 144, GL_VEC = GL_QK + 64 * 144, GL_BUF = GL_VEC + 768;
static_assert(2 * GL_BUF <= 131072, "GDN LDS");
__device__ __forceinline__ bf16x8 ld2x8(const LAS unsigned char* p0, const LAS unsigned char* p1) { const u32x2 a = *(const LAS u32x2*)p0, b = *(const LAS u32x2*)p1; u32x4 w = {a[0], a[1], b[0], b[1]}; return *reinterpret_cast<bf16x8*>(&w); }
__device__ __forceinline__ bf16x8 pack2t(const f32x4 t0, const f32x4 t1) { u32x4 w = {pk2(t0[0], t0[1]), pk2(t0[2], t0[3]), pk2(t1[0], t1[1]), pk2(t1[2], t1[3])}; return *reinterpret_cast<bf16x8*>(&w); }
__device__ __forceinline__ void gdn_scan(Frame& F, int h, int dir, int cb, int s0, int s1, const float* sinit, float* sfin, bf16_t* pfin, bool out_en, bf16_t* ydst, int yld, int ycol0) {
    LAUNDER_PTR(bf16_t*, 1, ydst, ydst);
    const bool phi = cb >= 2; const int eb = cb & 1;
    const int tid = F.tid, lane = F.lane, w = F.wave, m = lane & 15, q = lane >> 4;
    LAS unsigned char* L = F.lds;
    const int st = tid - 256;
#define GDN_TOUCH_HOOK do { asm volatile("" :: "v"(tch0), "v"(tch1)); \
        if (tc3 >= 0) { const int trow = st >> 2, tpart = st & 3; \
            tch0 = *(const unsigned*)(F_CV + (size_t)(tc3 * 64 + trow) * 4608 + h * 128 + ((tpart & 2) ? 1536 : 2560) + (tpart & 1) * 64); \
            if (st < 192) { const int which = st >> 6, r2 = st & 63; const unsigned char* gt3 = GT_PTR(h, dir, tc3); \
                tch1 = *(const unsigned*)(which == 0 ? (const unsigned char*)(F_CV + (size_t)(tc3 * 64 + r2) * 4608 + 3584 + h * 128 + eb * 64) : (gt3 + (which - 1) * 8192 + r2 * 128)); } } } while (0)
#define GDN_STAGE(cc, bufo) do { const int tokb = (cc) * 64; const unsigned char* gt = GT_PTR(h, dir, (cc)); \
        u32x4 rk[4], rq[4], rv[2], rt[2], rqk[2], rvec = {0u, 0u, 0u, 0u}; \
        _Pragma("unroll") for (int i = 0; i < 4; ++i) { const int p = st + 256 * i, row = p >> 4, c16 = p & 15; const bf16_t* src = F_CV + (size_t)(tokb + (dir ? 63 - row : row)) * 4608 + h * 128 + c16 * 8; \
            rk[i] = *(const u32x4*)(src + 2560); rq[i] = *(const u32x4*)(src + 1536); } \
        _Pragma("unroll") for (int i = 0; i < 2; ++i) { const int p = st + 256 * i, row = p >> 3, c16 = p & 7; \
            rv[i] = *(const u32x4*)(F_CV + (size_t)(tokb + (dir ? 63 - row : row)) * 4608 + 3584 + h * 128 + eb * 64 + c16 * 8); \
            rt[i] = *(const u32x4*)(gt + row * 128 + c16 * 16); rqk[i] = *(const u32x4*)(gt + 8192 + row * 128 + c16 * 16); } \
        if (st < 48) rvec = *(const u32x4*)(gt + 16384 + st * 16); \
        GDN_TOUCH_HOOK; \
        _Pragma("unroll") for (int i = 0; i < 4; ++i) { const int p = st + 256 * i, row = p >> 4, c16 = p & 15; \
            *(LAS u32x4*)(L + (bufo) + GL_K + row * 272 + c16 * 16) = rk[i]; *(LAS u32x4*)(L + (bufo) + GL_Q + row * 272 + c16 * 16) = rq[i]; } \
        _Pragma("unroll") for (int i = 0; i < 2; ++i) { const int p = st + 256 * i, row = p >> 3, c16 = p & 7; \
            *(LAS u32x4*)(L + (bufo) + GL_V + row * 144 + c16 * 16) = rv[i]; *(LAS u32x4*)(L + (bufo) + GL_TB + row * 144 + c16 * 16) = rt[i]; *(LAS u32x4*)(L + (bufo) + GL_QK + row * 144 + c16 * 16) = rqk[i]; } \
        if (st < 48) *(LAS u32x4*)(L + (bufo) + GL_VEC + st * 16) = rvec; } while (0)
    f32x4 S[8]; unsigned tch0 = 0u, tch1 = 0u;
#pragma unroll
    for (int i = 0; i < 8; ++i) {
        if (phi) {
#pragma unroll
            for (int r = 0; r < 4; ++r) S[i][r] = (16 * i + 4 * q + r == 64 * (cb - 2) + 16 * (w & 3) + m) ? 1.f : 0.f;
        } else if (sinit) S[i] = *(const f32x4*)(sinit + (size_t)(16 * (w & 3) + m) * 128 + 16 * i + 4 * q);
        else S[i] = (f32x4){0.f, 0.f, 0.f, 0.f};
    }
    int tc3 = -1;
    if (w >= 4) { tc3 = s0 + 2 < s1 ? gdn_chunk(dir, s0 + 2) : -1; GDN_STAGE(gdn_chunk(dir, s0), 0); }
    __syncthreads();
    const int qp = (lane & 15) >> 2, pp = lane & 3;
    for (int s = s0; s < s1; ++s) {
        const int bo = ((s - s0) & 1) * GL_BUF;
        if (w >= 4) {
            tc3 = s + 3 < s1 ? gdn_chunk(dir, s + 3) : -1;
            if (s + 1 < s1) { GDN_STAGE(gdn_chunk(dir, s + 1), GL_BUF - bo); }
        } else {
            const int c = gdn_chunk(dir, s), cw = w;
            const LAS unsigned char* Kp = L + bo + GL_K; const LAS unsigned char* Qp = L + bo + GL_Q; const LAS unsigned char* TBp = L + bo + GL_TB; const LAS unsigned char* QKp = L + bo + GL_QK;
            const LAS float* egc = (const LAS float*)(L + bo + GL_VEC); const LAS float* w2 = egc + 64;
            const float egl = egc[128];
            bf16x8 sb[4];
#pragma unroll
            for (int k = 0; k < 4; ++k) sb[k] = pack2t(S[2 * k], S[2 * k + 1]);
            f32x4 KS[4], QS[4];
#pragma unroll
            for (int it = 0; it < 4; ++it) { KS[it] = (f32x4){0.f, 0.f, 0.f, 0.f}; QS[it] = (f32x4){0.f, 0.f, 0.f, 0.f}; }
#pragma unroll
            for (int ih = 0; ih < 2; ++ih) {
                bf16x8 ak[2][4], aq[2][4];
#pragma unroll
                for (int i2 = 0; i2 < 2; ++i2)
#pragma unroll
                    for (int k = 0; k < 4; ++k) { const int ro = (16 * (2 * ih + i2) + m) * 272 + (32 * k + 4 * q) * 2; ak[i2][k] = ld2x8(Kp + ro, Kp + ro + 32); aq[i2][k] = ld2x8(Qp + ro, Qp + ro + 32); }
#pragma unroll
                for (int i2 = 0; i2 < 2; ++i2)
#pragma unroll
                    for (int k = 0; k < 4; ++k) { KS[2 * ih + i2] = __builtin_amdgcn_mfma_f32_16x16x32_bf16(ak[i2][k], sb[k], KS[2 * ih + i2], 0, 0, 0);
                        if (out_en) QS[2 * ih + i2] = __builtin_amdgcn_mfma_f32_16x16x32_bf16(sb[k], aq[i2][k], QS[2 * ih + i2], 0, 0, 0); }
            }
            f32x4 eg4[4];
#pragma unroll
            for (int it = 0; it < 4; ++it) eg4[it] = *(const LAS f32x4*)(egc + 16 * it + 4 * q);
            bf16x8 ksb[2], vfr[2], tn[4][2], tp[4][2];
            { const unsigned vb = (unsigned)(uintptr_t)(F.ldsg + bo + GL_V) + (unsigned)((8 * q + qp) * 144 + (16 * cw + 4 * pp) * 2);
              const s16x4 a0 = tr_read_b64(vb), a1 = tr_read_b64(vb + 4 * 144), b0 = tr_read_b64(vb + 32 * 144), b1 = tr_read_b64(vb + 36 * 144);
#pragma unroll
              for (int it = 0; it < 4; ++it)
#pragma unroll
                  for (int k = 0; k < 2; ++k) { const int rn = (16 * it + m) * 144 + (32 * k + 8 * q) * 2, rp = (16 * it + m) * 144 + (32 * k + 4 * q) * 2;
                      tn[it][k] = *(const LAS bf16x8*)(TBp + rn); tp[it][k] = ld2x8(TBp + rp, TBp + rp + 32); }
              LGKM_WAIT0(); vfr[0] = PK8(a0, a1); vfr[1] = PK8(b0, b1); }
#pragma unroll
            for (int k = 0; k < 2; ++k) ksb[k] = pack2t(-(eg4[2 * k] * KS[2 * k]), -(eg4[2 * k + 1] * KS[2 * k + 1]));
            f32x4 VN[4];
#pragma unroll
            for (int it = 0; it < 4; ++it) { VN[it] = (f32x4){0.f, 0.f, 0.f, 0.f};
#pragma unroll
                for (int k = 0; k < 2; ++k) {
                    if (!phi) VN[it] = __builtin_amdgcn_mfma_f32_16x16x32_bf16(tn[it][k], vfr[k], VN[it], 0, 0, 0);
                    VN[it] = __builtin_amdgcn_mfma_f32_16x16x32_bf16(tp[it][k], ksb[k], VN[it], 0, 0, 0); } }
            bf16x8 vnb[2], vnw[2];
#pragma unroll
            for (int k = 0; k < 2; ++k) { vnb[k] = pack2t(VN[2 * k], VN[2 * k + 1]);
                const f32x4 wa = *(const LAS f32x4*)(w2 + 32 * k + 4 * q), wb = *(const LAS f32x4*)(w2 + 32 * k + 16 + 4 * q); vnw[k] = pack2t(wa * VN[2 * k], wb * VN[2 * k + 1]); }
            bf16x8 qkf[4][2];
#pragma unroll
            for (int it = 0; it < 4; ++it)
#pragma unroll
                for (int k = 0; k < 2; ++k) { const int rp = (16 * it + m) * 144 + (32 * k + 4 * q) * 2; qkf[it][k] = ld2x8(QKp + rp, QKp + rp + 32); }
            const unsigned kb = (unsigned)(uintptr_t)(F.ldsg + bo + GL_K) + (unsigned)((4 * q + qp) * 272 + (4 * pp) * 2);
            s16x4 ka[4][4];
#pragma unroll
            for (int d4 = 0; d4 < 4; ++d4) { ka[d4][0] = tr_read_b64(kb + d4 * 32); ka[d4][1] = tr_read_b64(kb + d4 * 32 + 16 * 272); ka[d4][2] = tr_read_b64(kb + d4 * 32 + 32 * 272); ka[d4][3] = tr_read_b64(kb + d4 * 32 + 48 * 272); }
            if (out_en)
#pragma unroll
            for (int it = 0; it < 4; ++it) { f32x4 o = QS[it] * egc[16 * it + m];
#pragma unroll
                for (int k = 0; k < 2; ++k) o = __builtin_amdgcn_mfma_f32_16x16x32_bf16(vnb[k], qkf[it][k], o, 0, 0, 0);
                const int ip = 16 * it + m, tok = c * 64 + (dir ? 63 - ip : ip);
                *(u32x2*)(ydst + ((size_t)dir * TB + tok) * yld + ycol0 + h * 128 + eb * 64 + 16 * cw + 4 * q) = (u32x2){pk2(o[0], o[1]), pk2(o[2], o[3])}; }
            LGKM_WAIT0();
#pragma unroll
            for (int d4 = 0; d4 < 4; ++d4) { f32x4 sn = S[d4] * egl;
                sn = __builtin_amdgcn_mfma_f32_16x16x32_bf16(PK8(ka[d4][0], ka[d4][1]), vnw[0], sn, 0, 0, 0);
                sn = __builtin_amdgcn_mfma_f32_16x16x32_bf16(PK8(ka[d4][2], ka[d4][3]), vnw[1], sn, 0, 0, 0); S[d4] = sn; }
#pragma unroll
            for (int d4 = 0; d4 < 4; ++d4) { ka[d4][0] = tr_read_b64(kb + (4 + d4) * 32); ka[d4][1] = tr_read_b64(kb + (4 + d4) * 32 + 16 * 272); ka[d4][2] = tr_read_b64(kb + (4 + d4) * 32 + 32 * 272); ka[d4][3] = tr_read_b64(kb + (4 + d4) * 32 + 48 * 272); }
            LGKM_WAIT0();
#pragma unroll
            for (int d4 = 0; d4 < 4; ++d4) { f32x4 sn = S[4 + d4] * egl;
                sn = __builtin_amdgcn_mfma_f32_16x16x32_bf16(PK8(ka[d4][0], ka[d4][1]), vnw[0], sn, 0, 0, 0);
                sn = __builtin_amdgcn_mfma_f32_16x16x32_bf16(PK8(ka[d4][2], ka[d4][3]), vnw[1], sn, 0, 0, 0); S[4 + d4] = sn; }
        }
        __syncthreads();
    }
    if (w < 4) {
        if (sfin) {
#pragma unroll
            for (int i = 0; i < 8; ++i) *(f32x4*)(sfin + (size_t)(16 * w + m) * 128 + 16 * i + 4 * q) = S[i]; }
        if (pfin) {
#pragma unroll
            for (int i = 0; i < 8; ++i)
#pragma unroll
                for (int r = 0; r < 4; ++r) pfin[(size_t)(16 * i + 4 * q + r) * 128 + 64 * (cb - 2) + 16 * w + m] = f2bf(S[i][r]); }
    }
#undef GDN_STAGE
#undef GDN_TOUCH_HOOK
}
__device__ __forceinline__ void trread_selftest(Frame& F) {
    if (F.bid != 0) return;
    LAS unsigned short* tile = (LAS unsigned short*)(F.lds + 65536);
    for (int i = F.tid; i < 32 * 32; i += NTHREADS) tile[i] = (unsigned short)i;
    __syncthreads();
    if (F.wave == 1) {
        const int lane = F.lane, h = lane >> 5; const unsigned trq = (unsigned)(8 * h + ((lane & 15) >> 2)), trc = (unsigned)((16 * ((lane >> 4) & 1) + 4 * (lane & 3)) * 2);
        const unsigned vb = (unsigned)(uintptr_t)(F.ldsg + 65536) + trq * 64 + trc;
        const s16x4 lo = tr_read_b64(vb), hi = tr_read_b64(vb + 4 * 64);
        LGKM_WAIT0();
        bool bad = false;
#pragma unroll
        for (int e = 0; e < 4; ++e) { bad |= ((unsigned short)lo[e] != (unsigned short)((8 * h + e) * 32 + (lane & 31))); bad |= ((unsigned short)hi[e] != (unsigned short)((8 * h + 4 + e) * 32 + (lane & 31))); }
        if (bad) atomicOr((unsigned*)(F.ws + WS_CTL) + 200, 1u);
    }
    __syncthreads();
}
__device__ __forceinline__ void phase_finish(Frame& F, int b) {
    const int gw = F.bid * 8 + F.wave, NGW = F.G * 8, lane = F.lane;
    const int k = gw & 3, c0 = k * 512 + lane * 8;
    float wn0[8];
    { const float* np = k < 2 ? F.in[I_SNORM] + c0 : F.in[I_GNORM] + (lane & 15) * 8; const f32x4 n0 = *(const f32x4*)np, n1 = *(const f32x4*)(np + 4);
#pragma unroll
      for (int e = 0; e < 4; ++e) { wn0[e] = n0[e]; wn0[4 + e] = n1[e]; } }
    const float dsk = k < 2 ? F.in[I_SD][c0 >> 6] : 0.f;
    for (int it0 = gw; it0 < TB * 4; it0 += 4 * NGW) {
        u32x4 y0[4], y1[4], zg[4], xs[4];
#pragma unroll
        for (int q = 0; q < 4; ++q) { const int it = it0 + q * NGW, u = it >> 2;
            if (it < TB * 4) { y0[q] = *(const u32x4*)(F_YD + (size_t)u * 2048 + c0); y1[q] = *(const u32x4*)(F_YD + ((size_t)TB + u) * 2048 + c0); zg[q] = *(const u32x4*)(F_ZG + (size_t)u * 2048 + c0);
                xs[q] = k < 2 ? *(const u32x4*)(F_CV + (size_t)u * 4608 + c0) : (u32x4){0u, 0u, 0u, 0u}; }
            else { y0[q] = (u32x4){0u, 0u, 0u, 0u}; y1[q] = y0[q]; zg[q] = y0[q]; xs[q] = y0[q]; } }
#pragma unroll
        for (int q = 0; q < 4; ++q) { const int it = it0 + q * NGW, u = it >> 2;
            if (it < TB * 4) {
                float y[8], zz[8], wn[8]; float ss = 0.f;
#pragma unroll
                for (int e = 0; e < 4; ++e) { y[2 * e] = bflo(y0[q][e]) + bflo(y1[q][e]); y[2 * e + 1] = bfhi(y0[q][e]) + bfhi(y1[q][e]); zz[2 * e] = bflo(zg[q][e]); zz[2 * e + 1] = bfhi(zg[q][e]); }
                if (k < 2) {
#pragma unroll
                    for (int e = 0; e < 4; ++e) { y[2 * e] = (y[2 * e] + bflo(xs[q][e]) * dsk) * silu_f(zz[2 * e]); y[2 * e + 1] = (y[2 * e + 1] + bfhi(xs[q][e]) * dsk) * silu_f(zz[2 * e + 1]); }
#pragma unroll
                    for (int e = 0; e < 8; ++e) { ss = fmaf(y[e], y[e], ss); wn[e] = wn0[e]; }
                    ss = wave_sum(ss) * (1.f / 512.f);
                } else {
#pragma unroll
                    for (int e = 0; e < 8; ++e) ss = fmaf(y[e], y[e], ss);
                    ss += __shfl_xor(ss, 1); ss += __shfl_xor(ss, 2); ss += __shfl_xor(ss, 4); ss += __shfl_xor(ss, 8); ss *= (1.f / 128.f);
#pragma unroll
                    for (int e = 0; e < 8; ++e) wn[e] = wn0[e] * silu_f(zz[e]);
                }
                const float rstd = 1.0f / sqrtf(ss + NEPS);
                *(u32x4*)(F_Y + (size_t)u * 2048 + c0) = (u32x4){pk2(y[0] * rstd * wn[0], y[1] * rstd * wn[1]), pk2(y[2] * rstd * wn[2], y[3] * rstd * wn[3]), pk2(y[4] * rstd * wn[4], y[5] * rstd * wn[5]), pk2(y[6] * rstd * wn[6], y[7] * rstd * wn[7])};
            } }
    }
}
__device__ __forceinline__ void phase_qknorm_rope(Frame& F) {
    const int gw = F.bid * 8 + F.wave, NGW = F.G * 8, lane = F.lane, hl = lane & 15;
    const bool second = hl >= 8, jhi = (hl & 7) >= 4;
    float invf[8], wq[8], wk[8];
    { const f32x4 a0 = *(const f32x4*)(F.in[I_QNORM] + hl * 8), a1 = *(const f32x4*)(F.in[I_QNORM] + hl * 8 + 4), b0 = *(const f32x4*)(F.in[I_KNORM] + hl * 8), b1 = *(const f32x4*)(F.in[I_KNORM] + hl * 8 + 4);
#pragma unroll
      for (int e = 0; e < 4; ++e) { wq[e] = a0[e]; wq[4 + e] = a1[e]; wk[e] = b0[e]; wk[4 + e] = b1[e]; }
#pragma unroll
      for (int e = 0; e < 8; ++e) invf[e] = exp2f(-(float)((hl & 3) * 8 + e) * (13.287712379549449f / 32.f)); }
    for (int r0 = gw; r0 < TT; r0 += 3 * NGW) {
        u32x4 v[3][3];
#pragma unroll
        for (int q = 0; q < 3; ++q) { const int r = r0 + q * NGW; const bool ok = r < TT; const int u = ok ? r % TB : 0; const bool isctx = u < CTXL; const bf16_t* p = F_QKV + (size_t)(ok ? r : 0) * 2048 + lane * 8;
            v[q][2] = ok ? *(const u32x4*)(p + 1024) : (u32x4){0u, 0u, 0u, 0u};
            if (ok && !isctx) { v[q][0] = *(const u32x4*)p; v[q][1] = *(const u32x4*)(p + 512); } else { v[q][0] = (u32x4){0u, 0u, 0u, 0u}; v[q][1] = v[q][0]; } }
#pragma unroll
        for (int q = 0; q < 3; ++q) { const int r = r0 + q * NGW;
            if (r < TT) { const int u = r % TB; const bool isctx = u < CTXL; bf16_t* p = F_QKV + (size_t)r * 2048 + lane * 8;
                float cs[8], sn[8];
                if (!isctx) { const int t = u - CTXL; const float pos = (float)(jhi ? (t & 63) : (t >> 6));
#pragma unroll
                    for (int e = 0; e < 8; ++e) { const float rev = pos * invf[e] * 0.15915494309189535f; const float fr = rev - rintf(rev); cs[e] = __builtin_amdgcn_cosf(fr); sn[e] = __builtin_amdgcn_sinf(fr); } }
                else {
#pragma unroll
                    for (int e = 0; e < 8; ++e) { cs[e] = 1.f; sn[e] = 0.f; } }
#pragma unroll
                for (int part = 0; part < 3; ++part) { if (part < 2 && isctx) continue;
                    float x[8]; float ss = 0.f;
#pragma unroll
                    for (int e = 0; e < 4; ++e) { x[2 * e] = bflo(v[q][part][e]); x[2 * e + 1] = bfhi(v[q][part][e]); }
#pragma unroll
                    for (int e = 0; e < 8; ++e) ss = fmaf(x[e], x[e], ss);
                    ss += __shfl_xor(ss, 1); ss += __shfl_xor(ss, 2); ss += __shfl_xor(ss, 4); ss += __shfl_xor(ss, 8);
                    const float rstd = 1.0f / sqrtf(ss * (1.f / 128.f) + NEPS);
#pragma unroll
                    for (int e = 0; e < 8; ++e) x[e] = x[e] * rstd * (part < 2 ? wq[e] : wk[e]);
                    if (!isctx) {
#pragma unroll
                        for (int e = 0; e < 8; ++e) { const float pr = __shfl_xor(x[e], 8); x[e] = second ? x[e] * cs[e] + pr * sn[e] : x[e] * cs[e] - pr * sn[e]; } }
                    *(u32x4*)(p + part * 512) = (u32x4){pk2(x[0], x[1]), pk2(x[2], x[3]), pk2(x[4], x[5]), pk2(x[6], x[7])};
                } } }
    }
}
__device__ __forceinline__ void phase_attention(Frame& F) {
    const int grp = F.bid & 7, b = grp >> 2, kh = grp & 3;
    for (int idx = F.bid >> 3; idx < 64; idx += (F.G >> 3)) {
        const int hq = kh * 2 + (idx >> 5), qb = idx & 31;
        const bf16_t* Qb = F_QKV + (size_t)(b * TB + CTXL + qb * 256) * 2048 + hq * 128;
        const bf16_t* Kh = F_QKV + (size_t)(b * TB) * 2048 + 1024 + kh * 128;
        const bf16_t* Vh = F_QKV + (size_t)(b * TB) * 2048 + 1536 + kh * 128;
        bf16_t* Ob = F_AO + (size_t)(b * TB + CTXL + qb * 256) * DM + hq * 128;
        att::attn_dense_body(Qb, Kh, Vh, Ob, TB, (char*)F.ldsg, F.tid);
        __syncthreads();
    }
}

struct TailResid { const void* bp; h16* op; const float* gv; bf16_t* hn; float* rsp; const float* gn; const float* scn; bool fuse, in32; float coef;
    __device__ __forceinline__ void operator()(int b, int u, int col, f32x4 v) const { const long o = (long)(b * CTXL + u) * DM + col;
        f32x4 xb; if (in32) xb = *(const f32x4*)((const float*)bp + o); else { const u32x2 w = *(const u32x2*)((const h16*)bp + o); const f32x2_t c0 = unh2(w[0]), c1 = unh2(w[1]); xb = (f32x4){c0[0], c0[1], c1[0], c1[1]}; }
        const f32x4 x = xb + (*(const f32x4*)(gv + col) * coef) * v; *(u32x2*)(op + o) = (u32x2){pkh2(x[0], x[1]), pkh2(x[2], x[3])};
        if (fuse) { const size_t grow = (size_t)b * TB + u; const f32x4 y = x * (*(const f32x4*)(gn + col) * (1.f + *(const f32x4*)(scn + col)));
            *(u32x2*)(hn + grow * DM + col) = (u32x2){pk2(y[0], y[1]), pk2(y[2], y[3])};
            float ss = (x[0] * x[0] + x[1] * x[1]) + (x[2] * x[2] + x[3] * x[3]); ss += __shfl_xor(ss, 1); ss += __shfl_xor(ss, 2); ss += __shfl_xor(ss, 4); ss += __shfl_xor(ss, 8);
            if (((col >> 2) & 15) == 0) rsp[grow * 16 + (col >> 6)] = ss; } } };
struct TailBf16 { bf16_t* O; int ldo, col0; const float* rsp; const float* bias;
    __device__ __forceinline__ void operator()(int b, int u, int col, f32x4 v) const { const float* p = rsp + ((size_t)b * TB + u) * 16; const f32x4 p0 = *(const f32x4*)p, p1 = *(const f32x4*)(p + 4), p2 = *(const f32x4*)(p + 8), p3 = *(const f32x4*)(p + 12);
        const float sq = (((p0[0] + p0[1]) + (p0[2] + p0[3])) + ((p1[0] + p1[1]) + (p1[2] + p1[3]))) + (((p2[0] + p2[1]) + (p2[2] + p2[3])) + ((p3[0] + p3[1]) + (p3[2] + p3[3])));
        const float r = 1.0f / sqrtf(sq * (1.f / DM) + NEPS); v = v * r + *(const f32x4*)(bias + col);
        *(u32x2*)(O + (size_t)(b * TB + u) * ldo + col0 + col) = (u32x2){pk2(v[0], v[1]), pk2(v[2], v[3])}; } };
__device__ __forceinline__ void bias_rows(Frame& F, int l, int first_wave, int nwaves) {
    const int lane = F.lane;
    for (int kk = 1; kk <= 2; ++kk) {
        const bf16_t* Wt = (const bf16_t*)(F.ws + WS_W + (kk == 1 ? W_MIXIN : W_FFIN1)); const int nrows = kk == 1 ? (l == 0 ? 6912 : 2048) : 2 * DFF;
        float sh[3][16];
#pragma unroll
        for (int s_ = 0; s_ < 3; ++s_)
#pragma unroll
            for (int j = 0; j < 4; ++j) { const f32x4 t = *(const f32x4*)(F_MT + ((l * 3 + s_) * 9 + kk * 3) * DM + lane * 16 + 4 * j);
#pragma unroll
                for (int e = 0; e < 4; ++e) sh[s_][4 * j + e] = t[e]; }
        for (int r0 = first_wave; r0 < nrows; r0 += 6 * nwaves) {
            u32x4 w0[6], w1[6];
#pragma unroll
            for (int q = 0; q < 6; ++q) { const int r = r0 + q * nwaves; if (r < nrows) { w0[q] = *(const u32x4*)(Wt + (size_t)r * DM + lane * 16); w1[q] = *(const u32x4*)(Wt + (size_t)r * DM + lane * 16 + 8); } else { w0[q] = (u32x4){0u, 0u, 0u, 0u}; w1[q] = w0[q]; } }
#pragma unroll
            for (int q = 0; q < 6; ++q) { const int r = r0 + q * nwaves; float a[3] = {0.f, 0.f, 0.f};
#pragma unroll
                for (int e = 0; e < 4; ++e)
#pragma unroll
                    for (int s_ = 0; s_ < 3; ++s_) { a[s_] = fmaf(bflo(w0[q][e]), sh[s_][2 * e], a[s_]); a[s_] = fmaf(bfhi(w0[q][e]), sh[s_][2 * e + 1], a[s_]); a[s_] = fmaf(bflo(w1[q][e]), sh[s_][8 + 2 * e], a[s_]); a[s_] = fmaf(bfhi(w1[q][e]), sh[s_][8 + 2 * e + 1], a[s_]); }
#pragma unroll
                for (int s_ = 0; s_ < 3; ++s_) { const float t = wave_sum(a[s_]); if (lane == 0 && r < nrows) F_BIAS[((size_t)(kk - 1) * 3 + s_) * pg8::NB_STRIDE + r] = t; } }
        }
    }
}

template <class Epi>
__device__ __forceinline__ void ctx_gemm(Frame& F, const bf16_t* A, const bf16_t* W, int K, const Epi& E) {
    const int tid = F.tid, lane = tid & 63, w = F.wave, t = lane & 31, kh = lane >> 5, nkt = K >> 6;
    LAS float* red = (LAS float*)F.lds;
    LAS unsigned char* st = F.lds + w * 13824;
    const int lr = lane >> 3, lc = (lane & 7) * 8;
    for (int item = F.bid; item < 256; item += F.G) {
        const int x_ = item & 7, j_ = item >> 3, rb = j_ >> 1, cb = 2 * x_ + (j_ & 1), b = rb >> 3, u0 = (rb & 7) * 32;
        const bf16_t* ap = A + (size_t)(b * TB + u0 + lr) * K + lc;
        const bf16_t* wp = W + (size_t)(cb * 64 + lr) * K + lc; const size_t r8 = (size_t)8 * K;
        f32x16 acc0, acc1;
#pragma unroll
        for (int i = 0; i < 16; ++i) { acc0[i] = 0.f; acc1[i] = 0.f; }
        u32x4 r[12];
        int kt = w;
        if (kt < nkt) {
#pragma unroll
            for (int i = 0; i < 4; ++i) r[i] = *(const u32x4*)(ap + i * r8 + kt * 64);
#pragma unroll
            for (int i = 0; i < 8; ++i) r[4 + i] = *(const u32x4*)(wp + i * r8 + kt * 64);
        }
#pragma unroll 1
        for (; kt < nkt; kt += 8) {
#pragma unroll
            for (int i = 0; i < 12; ++i) *(LAS u32x4*)(st + (i * 8 + lr) * 144 + lc * 2) = r[i];
            const int kn = kt + 8 < nkt ? kt + 8 : kt;
#pragma unroll
            for (int i = 0; i < 4; ++i) r[i] = *(const u32x4*)(ap + i * r8 + kn * 64);
#pragma unroll
            for (int i = 0; i < 8; ++i) r[4 + i] = *(const u32x4*)(wp + i * r8 + kn * 64);
#pragma unroll
            for (int j = 0; j < 4; ++j) {
                const bf16x8 a = *(const LAS bf16x8*)(st + t * 144 + kh * 64 + j * 16), w0 = *(const LAS bf16x8*)(st + (32 + t) * 144 + kh * 64 + j * 16), w1 = *(const LAS bf16x8*)(st + (64 + t) * 144 + kh * 64 + j * 16);
                acc0 = __builtin_amdgcn_mfma_f32_32x32x16_bf16(w0, a, acc0, 0, 0, 0); acc1 = __builtin_amdgcn_mfma_f32_32x32x16_bf16(w1, a, acc1, 0, 0, 0); }
        }
        __syncthreads();
#pragma unroll
        for (int q = 0; q < 4; ++q) {
            *(LAS f32x4*)(red + (w * 32 + t) * 68 + 8 * q + 4 * kh) = (f32x4){acc0[4 * q], acc0[4 * q + 1], acc0[4 * q + 2], acc0[4 * q + 3]};
            *(LAS f32x4*)(red + (w * 32 + t) * 68 + 32 + 8 * q + 4 * kh) = (f32x4){acc1[4 * q], acc1[4 * q + 1], acc1[4 * q + 2], acc1[4 * q + 3]}; }
        __syncthreads();
        { const int tt = tid >> 4, n4 = (tid & 15) * 4; f32x4 sum = *(const LAS f32x4*)(red + tt * 68 + n4);
#pragma unroll
            for (int ww = 1; ww < 8; ++ww) sum += *(const LAS f32x4*)(red + (ww * 32 + tt) * 68 + n4);
            E(b, u0 + tt, cb * 64 + n4, sum); }
        __syncthreads();
    }
}

constexpr int LDS_BYTES = 147456;
constexpr int MISC_OFF = 147456 - 512;

__global__ void __launch_bounds__(NTHREADS, 2) mk_fwd(Args args) {
    extern __shared__ __attribute__((aligned(16))) unsigned char lds_raw[];
    Frame F;
    F.in = (KIN)__builtin_amdgcn_kernarg_segment_ptr(); F.out = args.out; F.ws = args.ws; F.dxc = (float*)(args.ws + WS_XC) - args.out; F.dcin = args.in[I_CTX] - args.in[I_X];
    F.lds = (LAS unsigned char*)lds_raw; F.ldsg = lds_raw;
    F.tid = threadIdx.x; F.lane = F.tid & 63; F.wave = __builtin_amdgcn_readfirstlane(F.tid >> 6); F.G = gridDim.x; F.bid = blockIdx.x;
    volatile LAS unsigned* MISC = (volatile LAS unsigned*)(F.lds + MISC_OFF);
    if (F.tid < 64) MISC[F.tid] = 0u;
    __syncthreads();
    XcdBarrier bar = xcd_barrier_post((unsigned*)(args.ws + WS_CTL), MISC + 8, F.tid);
    const int wave_s = __builtin_amdgcn_readfirstlane(threadIdx.x >> 6);
    const int lo = args.ph_lo, hi = args.ph_hi; int ph = 0;
#define PH_BEGIN if (TIMING && blockIdx.x == 0 && wave_s == 0 && __lane_id() == 0 && ph < 60) ((unsigned long long*)(args.ws + WS_CTL + 32768))[ph] = __builtin_amdgcn_s_memrealtime(); \
    if (ph >= lo && ph < hi) { { int lid_; asm volatile("v_mbcnt_lo_u32_b32 %0, -1, 0\n\tv_mbcnt_hi_u32_b32 %0, -1, %0" : "=v"(lid_)); F.tid = wave_s * 64 + lid_; } F.lane = F.tid & 63; F.wave = __builtin_amdgcn_readfirstlane(F.tid >> 6); \
        LAUNDER_PTR(unsigned char*, 1, F.ws, args.ws); LAUNDER_PTR(float*, 1, F.out, args.out); LAUNDER_PTR(KIN, 4, F.in, __builtin_amdgcn_kernarg_segment_ptr()); F.bid = blockIdx.x; F.G = gridDim.x; asm volatile("" : "+s"(F.bid), "+s"(F.G));
#define PH_END   if (ph + 1 < hi) xcd_barrier(bar, wave_s); } ++ph;

    PH_BEGIN { phase_modtab(F); } PH_END
    unsigned char* wb = F.ws + WS_W;
#define GEMM(EPI, A_, B_, K_, nM_, nN_, pm0_, mode_, NI_) do { pg8::Gemm g_{(const bf16_t*)(A_), (const bf16_t*)(B_), (K_)}; pg8::Order S_; S_.init((nM_), (nN_), F.G, F.bid, (pm0_), (mode_), (K_) / 64); pg8::gemm_phase(F.lds, g_, S_, EPI, F.tid, NI_); } while (0)
#define NI_PLAIN (pg8::NormIn{nullptr, nullptr})
#define NI_FUSED(kk_) (pg8::NormIn{F_RSP, F_BIAS + (size_t)((kk_) - 1) * 3 * pg8::NB_STRIDE})
    for (int l = 0; l < 2; ++l) {
      for (int k = 0; k < 3; ++k) {
        const bool lat_only = (l == 1 && k == 2);
        if (k == 0) {
            PH_BEGIN { if (l == 0) { phase_modtab_reduce(F); LAS float* tab = (LAS float*)(F.lds + 69632);
                           for (int i = F.tid; i < 6 * DM; i += NTHREADS) { const int s_ = i / (2 * DM), r_ = i - s_ * 2 * DM; tab[i] = modtab_sum(F, 0, s_, r_); } }
                       phase_convert(F, l); __syncthreads(); phase_norm(F, l, 0, l == 0, false, l == 0); } PH_END
        }
        const int nrep = (k == 1 && l == 0) ? 2 : 1;
        for (int rep = 0; rep < nrep; ++rep) {
            if (k != 1) {
                for (int rp_ = 0; rp_ < REP_SWIGLU; ++rp_) { PH_BEGIN { pg8::EpiSwigluP E{F_HID}; if (k == 0) GEMM(E, F_HN, wb + W_FFIN0, DM, 66, 22, 0, 0, NI_PLAIN); else GEMM(E, F_HN, wb + W_FFIN1, DM, lat_only ? 64 : 66, 22, 0, lat_only ? 1 : 0, NI_FUSED(2));
                    if (k == 0 && F.bid >= 172) bias_rows(F, l, (F.bid - 172) * 8 + F.wave, (F.G - 172) * 8); } PH_END }
            } else if (l == 0) {
                const int b = rep;
                PH_BEGIN { pg8::EpiABP E{F_ZG, F_RAW, F_ABS, b * TB}; GEMM(E, F_HN, wb + W_MIXIN, DM, 33, 27, b * 33, 0, NI_FUSED(1)); } PH_END
                PH_BEGIN phase_conv(F, b); PH_END
                PH_BEGIN { for (int it_ = F.G - 1 - F.bid; it_ < 132; it_ += F.G) ssd_prep_item(F, it_ / 66, it_ % 66);
                           if (F.G >= 256) { if (F.bid < 256) gdn_prep_round(F, F.bid * 4, 4); __syncthreads(); if (F.bid < 16) gdn_prep_round(F, 1024 + F.bid * 2, 2); }
                           else for (int rd_ = F.bid; rd_ < 264; rd_ += F.G) gdn_prep_round(F, rd_ * 4, 4);
                         } PH_END
                PH_BEGIN { const int x_ = F.bid & 7, j_ = F.bid >> 3;
                    if (F.G == 256 && F.bid < 160) { const int chain = x_ + 8 * (j_ / 10), r = j_ % 10, h_ = chain >> 1, d_ = chain & 1;
                        if (r < 2) gdn_scan(F, h_, d_, r, 0, 33, nullptr, F_GBT + ((size_t)chain * 3 + 0) * 16384 + (size_t)r * 8192, nullptr, true, F_YD, 2048, 1024);
                        else { const int g = 1 + (r - 2) / 4, cb = (r - 2) & 3;
                            gdn_scan(F, h_, d_, cb, 33 * g, 33 * g + 33, nullptr, cb < 2 ? F_GBT + ((size_t)chain * 3 + g) * 16384 + (size_t)cb * 8192 : nullptr, cb >= 2 ? F_GPH + ((size_t)chain * 2 + (g - 1)) * 16384 : nullptr, false, F_YD, 2048, 1024); } }
                    else if (F.G == 256) ssd_items<0>(F, F.bid - 160, 96, nullptr, 0, 0); } PH_END
                PH_BEGIN { if (F.bid < 16) gdn_combine(F, F.bid); else if (F.bid < 48) ssd_state_scan(F, F.bid - 16); } PH_END
                PH_BEGIN { const int x_ = F.bid & 7, j_ = F.bid >> 3;
                    if (F.G == 256 && F.bid < 96) { const int chain = x_ + 8 * (j_ / 6), r = j_ % 6, g = 1 + (r >> 1), eb_ = r & 1;
                        gdn_scan(F, chain >> 1, chain & 1, eb_, 33 * g, 33 * g + 33, F_GSS + ((size_t)chain * 3 + (g - 1)) * 16384 + (size_t)eb_ * 8192, nullptr, nullptr, true, F_YD, 2048, 1024); }
                    else if (F.G == 256) ssd_items<1>(F, F.bid - 96, 160, F_YD, 2048, 0); } PH_END
                PH_BEGIN phase_finish(F, b); PH_END
            } else {
                PH_BEGIN { pg8::EpiBf16P E{F_QKV, 2048}; GEMM(E, F_HN, wb + W_MIXIN, DM, 64, 8, 0, 1, NI_FUSED(1));
                           TailBf16 T{F_QKV, 2048, 1024, F_RSP, F_BIAS + (size_t)2 * pg8::NB_STRIDE + 1024}; ctx_gemm(F, F_HN, (const bf16_t*)(wb + W_MIXIN) + (size_t)1024 * DM, DM, T); } PH_END
                PH_BEGIN phase_qknorm_rope(F); PH_END
                for (int rp_ = 0; rp_ < REP_ATT; ++rp_) { PH_BEGIN phase_attention(F); PH_END }
            }
            PH_BEGIN {
                const bool first = (l == 0 && k == 0);
                const bool fuse = k < 2;
                const bool last = (l == 1 && k == 2), tofin = (l == 1 && k == 1);
                const long dfin = (long)(F_X16F - F_X16L);
                pg8::EpiResidP E{first ? (const void*)F.in[I_X] : (const void*)(F_X16L + (last ? dfin : 0)), first ? F.dcin : F_DXC16, last ? (void*)F.out : (void*)(F_X16L + (tofin ? dfin : 0)), F_DXC16, F_MT + l * 3 * 9216, 3 * k + 2, F.in[I_NORMG] + (l * 3 + k + 1) * DM, k + 1, fuse, first, last, F.ws, k == 1 ? 1.0f : 0.5f};
                const bf16_t* A_ = k != 1 ? F_HID : (l == 0 ? F_Y - (size_t)rep * TB * 2048 : F_AO);
                const size_t wo_ = k == 0 ? W_FFOUT0 : (k == 2 ? W_FFOUT1 : W_MIXOUT); const int K_ = k != 1 ? DFF : (l == 0 ? 2048 : DM);
                const bool lat = lat_only || (l == 1 && k == 1); const bool ctail = (k != 1 && !lat);
                const int nM_ = (k == 1 && l == 0) ? 33 : 64;
                GEMM(E, A_, wb + wo_, K_, nM_, 4, (k == 1 && l == 0) ? rep * 33 : 0, (k == 1 && l == 0) ? 0 : 1, NI_PLAIN);
                { int lid_; asm volatile("v_mbcnt_lo_u32_b32 %0, -1, 0\n\tv_mbcnt_hi_u32_b32 %0, -1, %0" : "=v"(lid_)); F.tid = wave_s * 64 + lid_; F.lane = lid_; }
                if (ctail) { TailResid T{first ? (const void*)(F.in[I_X] + F.dcin) : (const void*)F_X16C, F_X16C, F_MT + l * 3 * 9216 + (2 * 9 + 3 * k + 2) * DM, F_HN, F_RSP, F.in[I_NORMG] + (l * 3 + k + 1) * DM, F_MT + l * 3 * 9216 + (2 * 9 + (k + 1) * 3 + 1) * DM, fuse, first, 0.5f}; ctx_gemm(F, A_, (const bf16_t*)(wb + wo_), K_, T); }
            } PH_END
        }
      }
    }
#undef GEMM
#undef PH_BEGIN
#undef PH_END
}

extern "C" void kernel_launch(void* const* d_in, const int* in_sizes, int n_in, void* d_out, int out_size, void* d_ws, size_t ws_size, hipStream_t stream) {
    static int grid = 0;
    if (grid == 0) {
        if (n_in != 25 || out_size != NBATCH * SEQ * DM || ws_size < WS_END) { fprintf(stderr, "kernel_launch: unexpected shapes (n_in %d out %d ws %zu need %zu)\n", n_in, out_size, ws_size, (size_t)WS_END); grid = -1; return; }
        int dev = 0, cus = 0, per_cu = 0;
        if (hipGetDevice(&dev) != hipSuccess || hipDeviceGetAttribute(&cus, hipDeviceAttributeMultiprocessorCount, dev) != hipSuccess) { grid = -1; return; }
        if (hipFuncSetAttribute((const void*)mk_fwd, hipFuncAttributeMaxDynamicSharedMemorySize, LDS_BYTES) != hipSuccess) { fprintf(stderr, "kernel_launch: hipFuncSetAttribute failed\n"); grid = -1; return; }
        if (hipOccupancyMaxActiveBlocksPerMultiprocessor(&per_cu, (const void*)mk_fwd, NTHREADS, LDS_BYTES) != hipSuccess || per_cu < 1) { fprintf(stderr, "kernel_launch: occupancy query says %d blocks per CU\n", per_cu); grid = -1; (void)hipGetLastError(); return; }
        grid = cus;
    }
    if (grid < 0) return;
    (void)hipMemsetAsync((char*)d_ws + WS_CTL, 0, CTL_BYTES, stream);
    Args a{};
    for (int i = 0; i < 25; ++i) a.in[i] = (const float*)d_in[i];
    a.out = (float*)d_out; a.ws = (unsigned char*)d_ws; a.ph_lo = 0; a.ph_hi = 1000;
    hipLaunchKernelGGL(mk_fwd, dim3(grid), dim3(NTHREADS), LDS_BYTES, stream, a);
    const hipError_t le = hipPeekAtLastError();
    if (le != hipSuccess) fprintf(stderr, "kernel_launch: launch failed: %s\n", hipGetErrorName(le));
}
```
